# Optimizing an MI355X kernel written in HIP

```python
import jax, jax.numpy as jnp
from jax import lax
import numpy as np

D_MODEL = 1024
BATCH = 16
SEQ = 2048
DEPTH = 1

CTX_LEN = 256
GRID_W = 64
D_FOURIER = 512
N_FOURIER_GROUPS = 4
FOURIER_GROUP = D_FOURIER // N_FOURIER_GROUPS
D_RET = 512
N_RET_HEADS = 4
RET_HEAD_DIM = D_RET // N_RET_HEADS
D_MIX = D_FOURIER + D_RET
IN_SPLITS = (D_FOURIER, 2 * D_FOURIER, 2 * D_FOURIER + D_RET,
             2 * D_FOURIER + 2 * D_RET, 2 * D_FOURIER + 3 * D_RET)
D_IN = 2 * D_FOURIER + 4 * D_RET
RET_CHUNK = 128
ROPE_BASE = 10000.0
QK_SCALE = RET_HEAD_DIM ** -0.5
EPS = 1e-6

kernel_name = "hymba_fnet_retnet_prefix_dit_block"


def rms_norm(x, gain):
    xf = x.astype(jnp.float32)
    y = xf * lax.rsqrt(jnp.mean(xf * xf, axis=-1, keepdims=True) + EPS)
    return (y * gain.astype(jnp.float32)).astype(x.dtype)


def adaln_params(cvec, w_ada, b_ada):
    m = jax.nn.silu(cvec) @ w_ada + b_ada
    shift, scale, gate = jnp.split(m, 3, axis=-1)
    return shift[:, None, :], scale[:, None, :], gate[:, None, :]


def modulate(h, shift, scale):
    return h * (1.0 + scale) + shift


def split_heads(t):
    return t.reshape(t.shape[0], t.shape[1], N_RET_HEADS, RET_HEAD_DIM)


def axial_rotary(t, row, col):
    half = RET_HEAD_DIM // 2
    n_freq = half // 2
    inv_freq = ROPE_BASE ** (-jnp.arange(n_freq, dtype=jnp.float32) / n_freq)

    def rot(u, pos):
        ang = pos.astype(jnp.float32)[:, None] * inv_freq[None, :]
        cos = jnp.cos(ang)[None, :, None, :]
        sin = jnp.sin(ang)[None, :, None, :]
        u1, u2 = u[..., :n_freq].astype(jnp.float32), u[..., n_freq:].astype(jnp.float32)
        return jnp.concatenate([u1 * cos - u2 * sin, u1 * sin + u2 * cos], axis=-1)

    out = jnp.concatenate([rot(t[..., :half], row), rot(t[..., half:], col)], axis=-1)
    return out.astype(t.dtype)


def retention_scan(q, k, v, log_gamma, init_state, inclusive):
    bsz, length, heads, dh = q.shape
    n_chunks = length // RET_CHUNK

    def to_chunks(t):
        return t.reshape(bsz, n_chunks, RET_CHUNK, heads, dh).transpose(1, 0, 3, 2, 4)

    idx = jnp.arange(RET_CHUNK, dtype=jnp.float32)
    diff = idx[:, None] - idx[None, :]
    mask = (diff >= 0) if inclusive else (diff > 0)
    decay_mat = jnp.where(mask[None], jnp.exp(log_gamma[:, None, None] * jnp.where(mask, diff, 0.0)[None]), 0.0)
    q_decay = jnp.exp(log_gamma[:, None] * (idx[None, :] + 1.0))
    k_decay = jnp.exp(log_gamma[:, None] * (RET_CHUNK - 1.0 - idx[None, :]))
    chunk_decay = jnp.exp(log_gamma * RET_CHUNK)

    def step(state, qkv):
        qc, kc, vc = [t.astype(jnp.float32) for t in qkv]
        scores = jnp.einsum('bhnd,bhmd->bhnm', qc, kc) * decay_mat[None]
        inner = jnp.einsum('bhnm,bhme->bhne', scores, vc)
        cross = jnp.einsum('bhnd,bhde->bhne', qc * q_decay[None, :, :, None], state)
        new_state = chunk_decay[None, :, None, None] * state + jnp.einsum(
            'bhmd,bhme->bhde', kc * k_decay[None, :, :, None], vc)
        return new_state, inner + cross

    final_state, out = lax.scan(step, init_state, (to_chunks(q), to_chunks(k), to_chunks(v)))
    out = out.transpose(1, 0, 3, 2, 4).reshape(bsz, length, heads, dh)
    return out, final_state


def bidirectional_retention(q, k, v, decay_logit, init_fwd, init_bwd):
    log_g = jax.nn.log_sigmoid(decay_logit.astype(jnp.float32))
    out_f, fin_f = retention_scan(q, k, v, log_g[0], init_fwd, inclusive=True)
    out_b, fin_b = retention_scan(q[:, ::-1], k[:, ::-1], v[:, ::-1], log_g[1], init_bwd, inclusive=False)
    return out_f + out_b[:, ::-1], fin_f, fin_b


def gated_retention(o, r_gate, gn_gain):
    mu = jnp.mean(o, axis=-1, keepdims=True)
    var = jnp.mean(jnp.square(o - mu), axis=-1, keepdims=True)
    o = ((o - mu) * lax.rsqrt(var + EPS)).reshape(o.shape[0], o.shape[1], D_RET)
    o = o * gn_gain.astype(jnp.float32) * jax.nn.silu(r_gate.astype(jnp.float32))
    return o.astype(r_gate.dtype)


def fourier_branch(f_in, f_gate, w_fourier):
    bsz, length, _ = f_in.shape
    u = f_in.reshape(bsz, length, N_FOURIER_GROUPS, FOURIER_GROUP).astype(jnp.float32)
    mixed = jnp.real(jnp.fft.fft2(u, axes=(1, 3), norm='ortho')).astype(f_in.dtype)
    y = jnp.einsum('blgc,gcd->blgd', mixed, w_fourier).reshape(bsz, length, D_FOURIER)
    return y * jax.nn.silu(f_gate)


def setup_inputs(seed: int = 0) -> dict:
    key = jax.random.key(seed)
    ks = jax.random.split(key, 16)
    n = jax.random.normal
    base_gamma = 1.0 - 2.0 ** (-5.0 - np.arange(N_RET_HEADS, dtype=np.float32))
    base_logit = jnp.asarray(np.log(base_gamma / (1.0 - base_gamma)), jnp.float32)
    return {
        "x": n(ks[0], (BATCH, SEQ, D_MODEL), jnp.float32),
        "c": n(ks[1], (BATCH, D_MODEL), jnp.float32),
        "ctx": n(ks[2], (BATCH, CTX_LEN, D_MODEL), jnp.float32),
        "c_ctx": n(ks[3], (D_MODEL,), jnp.float32),
        "w_ada": n(ks[4], (DEPTH, D_MODEL, 3 * D_MODEL), jnp.float32) * (0.5 * D_MODEL ** -0.5),
        "b_ada": n(ks[5], (DEPTH, 3 * D_MODEL), jnp.float32) * 0.01,
        "g_pre": 1.0 + 0.02 * n(ks[6], (DEPTH, D_MODEL), jnp.float32),
        "g_post": 1.0 + 0.02 * n(ks[7], (DEPTH, D_MODEL), jnp.float32),
        "w_in": n(ks[8], (DEPTH, D_MODEL, D_IN), jnp.float32) * D_MODEL ** -0.5,
        "w_fourier": n(ks[9], (DEPTH, N_FOURIER_GROUPS, FOURIER_GROUP, FOURIER_GROUP), jnp.float32) * FOURIER_GROUP ** -0.5,
        "decay_logit": base_logit[None, None, :] + 0.05 * n(ks[10], (DEPTH, 2, N_RET_HEADS), jnp.float32),
        "ret_gn_gain": 1.0 + 0.02 * n(ks[11], (DEPTH, D_RET), jnp.float32),
        "w_out": n(ks[12], (DEPTH, D_MIX, D_MODEL), jnp.float32) * D_MIX ** -0.5,
    }


def reference(x, c, ctx, c_ctx, w_ada, b_ada, g_pre, g_post, w_in, w_fourier, decay_logit, ret_gn_gain, w_out):
    bsz, seq_len, _ = x.shape
    rows = seq_len // GRID_W
    row = jnp.repeat(jnp.arange(rows, dtype=jnp.int32), GRID_W)
    col = jnp.tile(jnp.arange(GRID_W, dtype=jnp.int32), rows)
    zero_state = jnp.zeros((bsz, N_RET_HEADS, RET_HEAD_DIM, RET_HEAD_DIM), jnp.float32)

    for layer in range(DEPTH):
        shift, scale, gate = adaln_params(c, w_ada[layer], b_ada[layer])
        shift_c, scale_c, gate_c = adaln_params(c_ctx[None, :], w_ada[layer], b_ada[layer])

        h_c = modulate(rms_norm(ctx, g_pre[layer]), shift_c, scale_c)
        fc_in, fc_gate, qc, kc, vc, rc_gate = jnp.split(h_c @ w_in[layer], IN_SPLITS, axis=-1)
        ret_c, st_fwd, st_bwd = bidirectional_retention(
            split_heads(qc) * QK_SCALE, split_heads(kc), split_heads(vc),
            decay_logit[layer], zero_state, zero_state)

        h = modulate(rms_norm(x, g_pre[layer]), shift, scale)
        f_in, f_gate, q, k, v, r_gate = jnp.split(h @ w_in[layer], IN_SPLITS, axis=-1)
        q = axial_rotary(split_heads(q), row, col) * QK_SCALE
        k = axial_rotary(split_heads(k), row, col)
        ret, _, _ = bidirectional_retention(q, k, split_heads(v), decay_logit[layer], st_fwd, st_bwd)
        y = jnp.concatenate([fourier_branch(f_in, f_gate, w_fourier[layer]),
                             gated_retention(ret, r_gate, ret_gn_gain[layer])], axis=-1) @ w_out[layer]
        x_next = x + gate * rms_norm(y, g_post[layer])

        if layer < DEPTH - 1:
            y_c = jnp.concatenate([fourier_branch(fc_in, fc_gate, w_fourier[layer]),
                                   gated_retention(ret_c, rc_gate, ret_gn_gain[layer])], axis=-1) @ w_out[layer]
            ctx = ctx + gate_c * rms_norm(y_c, g_post[layer])
        x = x_next

    return x
```

```cpp
#include <hip/hip_runtime.h>
#include <hip/hip_cooperative_groups.h>
#include <cstdio>
#include <cstdint>
namespace cg = cooperative_groups;
namespace pg8 {
#define PG8_LAS __attribute__((address_space(3)))
typedef unsigned short bf16_t;
typedef short bf16x8 __attribute__((ext_vector_type(8)));
typedef float f32x4 __attribute__((ext_vector_type(4)));
typedef unsigned u32x4 __attribute__((ext_vector_type(4)));
constexpr int BM = 256, BK = 64, HALF = 128, HTB = HALF * BK * 2  , STAGE_BYTES = 8 * HTB, NXCD = 8, WGM = 8;

__host__ __device__ __forceinline__ int lds_byte(int r, int c) { const int st = (r >> 4) * 2 + (c >> 5), rr = r & 15, cc = c & 31, ob = rr * 64 + cc * 2; return st * 1024 + (ob ^ (((ob >> 9) & 1) << 5)); }
__host__ __device__ __forceinline__ void stage_rc(int b, int& R, int& C) { const int st = b / 1024, sb = b % 1024, swz = sb ^ (((sb >> 9) & 1) << 5); R = (st >> 1) * 16 + swz / 64; C = (st & 1) * 32 + (swz % 64) / 2; }
__host__ __device__ __forceinline__ int perm32(int rho) { const int n = rho >> 4, i = rho & 15; return 8 * (i >> 2) + 4 * n + (i & 3); }

struct Unit { int pm, pn; };
struct Gemm { const bf16_t* A; const bf16_t* Bt; int M, N, K; };

struct StaticOrder {
    int nM, nN, nwg, G, c;
    __host__ __device__ void init(int M, int N, int G_, int c_) { nM = M / BM; nN = N / BM; nwg = nM * nN; G = G_; c = c_; }
    __host__ __device__ bool next(int i, Unit& u) const {
        const long L = (long)i * G + c; if (L >= nwg) return false;
        int wgid = (int)L; { const int q = nwg / NXCD, r = nwg % NXCD, xcd = wgid % NXCD, off = wgid / NXCD; wgid = (xcd < r ? xcd * (q + 1) : r * (q + 1) + (xcd - r) * q) + off; }
        const int nig = WGM * nN, gid = wgid / nig, fm = gid * WGM, gsz = (nM - fm) < WGM ? (nM - fm) : WGM;
        u.pm = fm + ((wgid % nig) % gsz); u.pn = (wgid % nig) / gsz; return true;
    }
    __device__ __forceinline__ void a_ready(const Unit&) const {}
    __device__ __forceinline__ void done(const Unit&) const {}
};

__device__ __forceinline__ unsigned cvt_pk_bf16(float lo, float hi) { unsigned r; asm volatile("v_cvt_pk_bf16_f32 %0, %1, %2" : "=v"(r) : "v"(lo), "v"(hi)); return r; }

template <class Epi, class Sched, bool ALIGN_EPI = false, bool SP2 = false>
__device__ __forceinline__ void gemm_phase(PG8_LAS unsigned char* lds, const Gemm g, const Sched& S, const Epi& E) {
    const int tid = threadIdx.x, wid = __builtin_amdgcn_readfirstlane(tid >> 6), lane = tid & 63, wr = wid >> 2, wc = wid & 3, fr = lane & 15, fq = lane >> 4;
    const int K = g.K, nt = K / BK;
    unsigned voffA[2], voffB[2];
#pragma unroll
    for (int i = 0; i < 2; ++i) { int R, C; stage_rc(tid * 16 + i * 8192, R, C); const int Rb = Epi::PERM ? ((R & ~31) + perm32(R & 31)) : R;
        voffA[i] = (unsigned)(R * K + C) * 2u; voffB[i] = (unsigned)(Rb * K + C) * 2u; }
    const size_t kstep = (size_t)(BK * 2);
    const size_t hstep = (size_t)HALF * K * 2;
    const size_t tstep = 2 * hstep;
    const unsigned ldsw = (unsigned)wid * 1024u;
    const int aoff = lds_byte(wr * 64 + fr, fq * 8), boff = lds_byte(wc * 32 + fr, fq * 8);
#define PG8_SA(b, h) (((b) * 2 + (h)) * HTB)
#define PG8_SB(b, h) ((4 + (b) * 2 + (h)) * HTB)
#define PG8_STAGE(bufoff, gbase, voff) do { _Pragma("unroll") for (int _i = 0; _i < 2; ++_i) \
        __builtin_amdgcn_global_load_lds((const unsigned*)((const char*)(gbase) + (voff)[_i]), (PG8_LAS unsigned*)(lds + (bufoff) + ldsw + _i * 8192), 16, 0, 0); } while (0)
#define PG8_LDA(dst, b, h) do { _Pragma("unroll") for (int m = 0; m < 4; ++m) _Pragma("unroll") for (int k = 0; k < 2; ++k) dst[m][k] = *(const PG8_LAS bf16x8*)(lds + PG8_SA(b, h) + aoff + m * 2048 + k * 1024); } while (0)
#define PG8_LDB(dst, b, h) do { _Pragma("unroll") for (int n = 0; n < 2; ++n) _Pragma("unroll") for (int k = 0; k < 2; ++k) dst[n][k] = *(const PG8_LAS bf16x8*)(lds + PG8_SB(b, h) + boff + n * 2048 + k * 1024); } while (0)
#define PG8_MMA(ai, bj, At, Bt) do { __builtin_amdgcn_s_setprio(1); _Pragma("unroll") for (int m = 0; m < 4; ++m) _Pragma("unroll") for (int n = 0; n < 2; ++n) _Pragma("unroll") for (int k = 0; k < 2; ++k) \
        acc[ai][bj][m][n] = __builtin_amdgcn_mfma_f32_16x16x32_bf16(Bt[n][k], At[m][k], acc[ai][bj][m][n], 0, 0, 0); __builtin_amdgcn_s_setprio(0); } while (0)
#define PG8_WAIT_V(n) asm volatile("s_waitcnt vmcnt(" #n ")" ::: "memory")
#define PG8_WAIT_L(n) asm volatile("s_waitcnt lgkmcnt(" #n ")" ::: "memory")
#define PG8_BAR __builtin_amdgcn_s_barrier()
#define PG8_SCHED __builtin_amdgcn_sched_barrier(0)
    Unit cur, nxt; int ui = 0;
    if (!S.next(0, cur)) return;
    f32x4 acc[2][2][4][2];
#pragma unroll
    for (int a = 0; a < 2; ++a)
#pragma unroll
        for (int b = 0; b < 2; ++b)
#pragma unroll
            for (int m = 0; m < 4; ++m)
#pragma unroll
                for (int n = 0; n < 2; ++n) acc[a][b][m][n] = (f32x4){0.f, 0.f, 0.f, 0.f};
    bf16x8 At[4][2], B0[2][2], B1[2][2];
    const char* cA = (const char*)g.A + (size_t)cur.pm * tstep; const char* cB = (const char*)g.Bt + (size_t)cur.pn * tstep;
    S.a_ready(cur);
    if constexpr (SP2) {
        PG8_STAGE(PG8_SB(0, 0), cB, voffB); PG8_STAGE(PG8_SB(0, 1), cB + hstep, voffB); PG8_STAGE(PG8_SA(0, 0), cA, voffA); PG8_STAGE(PG8_SA(0, 1), cA + hstep, voffA);
        if (wr == 1) PG8_BAR;
        PG8_WAIT_V(2); PG8_BAR;
        PG8_STAGE(PG8_SB(1, 0), cB + kstep, voffB); PG8_STAGE(PG8_SA(1, 0), cA + kstep, voffA); PG8_STAGE(PG8_SB(1, 1), cB + hstep + kstep, voffB);
        PG8_WAIT_V(6); PG8_BAR;
    } else {
        PG8_STAGE(PG8_SB(0, 0), cB, voffB); PG8_STAGE(PG8_SA(0, 0), cA, voffA); PG8_STAGE(PG8_SB(0, 1), cB + hstep, voffB); PG8_STAGE(PG8_SA(0, 1), cA + hstep, voffA);
        if (wr == 1) PG8_BAR;
        PG8_WAIT_V(4); PG8_BAR;
        PG8_STAGE(PG8_SB(1, 0), cB + kstep, voffB); PG8_STAGE(PG8_SA(1, 0), cA + kstep, voffA); PG8_STAGE(PG8_SB(1, 1), cB + hstep + kstep, voffB);
        PG8_WAIT_V(6); PG8_BAR;
    }
    for (;;) {
        const bool has_next = S.next(ui + 1, nxt);
        const char* nA = has_next ? (const char*)g.A + (size_t)nxt.pm * tstep : cA; const char* nB = has_next ? (const char*)g.Bt + (size_t)nxt.pn * tstep : cB;
        for (int t = 0; t < nt; t += 2) {
            const bool last = (t == nt - 2);
            const char* a1 = cA + (size_t)(t + 1) * kstep;
            const char* a2 = last ? nA : cA + (size_t)(t + 2) * kstep; const char* b2 = last ? nB : cB + (size_t)(t + 2) * kstep;
            const char* a3 = a2 + kstep; const char* b3 = b2 + kstep;
            if (last && has_next) S.a_ready(nxt);
            if constexpr (SP2) {
            PG8_LDB(B0, 0, 0); PG8_LDB(B1, 0, 1); PG8_SCHED; PG8_LDA(At, 0, 0); PG8_STAGE(PG8_SA(1, 1), a1 + hstep, voffA);
            PG8_WAIT_V(8); PG8_WAIT_L(0); PG8_BAR; PG8_MMA(0, 0, At, B0); PG8_MMA(0, 1, At, B1); PG8_BAR; PG8_SCHED;
            PG8_LDA(At, 0, 1); PG8_STAGE(PG8_SB(0, 0), b2, voffB); PG8_STAGE(PG8_SB(0, 1), b2 + hstep, voffB); PG8_STAGE(PG8_SA(0, 0), a2, voffA);
            PG8_WAIT_V(8); PG8_WAIT_L(0); PG8_BAR; PG8_MMA(1, 0, At, B0); PG8_MMA(1, 1, At, B1); PG8_BAR; PG8_SCHED;
            PG8_LDB(B0, 1, 0); PG8_LDB(B1, 1, 1); PG8_SCHED; PG8_LDA(At, 1, 0); PG8_STAGE(PG8_SA(0, 1), a2 + hstep, voffA);
            PG8_WAIT_V(8); PG8_WAIT_L(0); PG8_BAR; PG8_MMA(0, 0, At, B0); PG8_MMA(0, 1, At, B1); PG8_BAR; PG8_SCHED;
            PG8_LDA(At, 1, 1); PG8_STAGE(PG8_SB(1, 0), b3, voffB); PG8_STAGE(PG8_SB(1, 1), b3 + hstep, voffB); PG8_STAGE(PG8_SA(1, 0), a3, voffA);
            PG8_WAIT_V(8); PG8_WAIT_L(0); PG8_BAR; PG8_MMA(1, 0, At, B0); PG8_MMA(1, 1, At, B1); PG8_BAR; PG8_SCHED;
            } else {
            PG8_LDB(B0, 0, 0); PG8_SCHED; PG8_LDA(At, 0, 0); PG8_STAGE(PG8_SA(1, 1), a1 + hstep, voffA);
            PG8_WAIT_L(8); PG8_BAR; PG8_WAIT_L(0); PG8_MMA(0, 0, At, B0); PG8_BAR; PG8_SCHED;
            PG8_LDB(B1, 0, 1); PG8_STAGE(PG8_SB(0, 0), b2, voffB);
            PG8_BAR; PG8_WAIT_L(0); PG8_MMA(0, 1, At, B1); PG8_BAR;
            PG8_LDA(At, 0, 1); PG8_STAGE(PG8_SA(0, 0), a2, voffA);
            PG8_BAR; PG8_WAIT_L(0); PG8_MMA(1, 0, At, B0); PG8_BAR; PG8_SCHED;
            PG8_STAGE(PG8_SB(0, 1), b2 + hstep, voffB);
            PG8_WAIT_V(6); PG8_BAR; PG8_MMA(1, 1, At, B1); PG8_BAR;
            PG8_LDB(B0, 1, 0); PG8_SCHED; PG8_LDA(At, 1, 0); PG8_STAGE(PG8_SA(0, 1), a2 + hstep, voffA);
            PG8_WAIT_L(8); PG8_BAR; PG8_WAIT_L(0); PG8_MMA(0, 0, At, B0); PG8_BAR; PG8_SCHED;
            PG8_LDB(B1, 1, 1); PG8_STAGE(PG8_SB(1, 0), b3, voffB);
            PG8_BAR; PG8_WAIT_L(0); PG8_MMA(0, 1, At, B1); PG8_BAR;
            PG8_LDA(At, 1, 1); PG8_STAGE(PG8_SA(1, 0), a3, voffA);
            PG8_BAR; PG8_WAIT_L(0); PG8_MMA(1, 0, At, B0); PG8_BAR; PG8_SCHED;
            PG8_STAGE(PG8_SB(1, 1), b3 + hstep, voffB);
            PG8_WAIT_V(6); PG8_BAR; PG8_MMA(1, 1, At, B1); PG8_BAR;
            }
        }
        if constexpr (ALIGN_EPI) { if (wr == 0) PG8_BAR; }
        if constexpr (!Epi::AFTER_DRAIN) { E(acc, cur, wr, wc, fr, fq); S.done(cur); }
        if (!has_next) break;
#pragma unroll
        for (int a = 0; a < 2; ++a)
#pragma unroll
            for (int b = 0; b < 2; ++b)
#pragma unroll
                for (int m = 0; m < 4; ++m)
#pragma unroll
                    for (int n = 0; n < 2; ++n) acc[a][b][m][n] = (f32x4){0.f, 0.f, 0.f, 0.f};
        cur = nxt; cA = nA; cB = nB; ++ui;
        if constexpr (ALIGN_EPI) { if (wr == 1) PG8_BAR; }
    }
    PG8_WAIT_V(0);
    if constexpr (!ALIGN_EPI) { if (wr == 0) PG8_BAR; }
    PG8_BAR;
    if constexpr (Epi::AFTER_DRAIN) { E.fused(acc, cur, wr, wc, fr, fq, lds, wid, lane); S.done(cur); }
#undef PG8_SA
#undef PG8_SB
#undef PG8_STAGE
#undef PG8_LDA
#undef PG8_LDB
#undef PG8_MMA
#undef PG8_WAIT_V
#undef PG8_WAIT_L
#undef PG8_BAR
#undef PG8_SCHED
}
}

#define LAS __attribute__((address_space(3)))
#define DI __device__ __forceinline__
typedef unsigned short bf16;
typedef unsigned v4u __attribute__((ext_vector_type(4)));
typedef unsigned v2u __attribute__((ext_vector_type(2)));
typedef float f32x4 __attribute__((ext_vector_type(4)));
typedef short bf16x8 __attribute__((ext_vector_type(8)));
typedef short s16x4 __attribute__((ext_vector_type(4)));

constexpr int NB = 16, SEQ = 2048, DM = 1024, MTOK = NB * SEQ, CTXL = 256, MCTX = NB * CTXL;
constexpr int PROJ_LD = 2560;
constexpr int PC_G = 0, PC_Q = 512, PC_K = 1024, PC_V = 1536, PC_R = 2048;
constexpr float EPSV = 1e-6f;
constexpr float QK_SCALE = 0.08838834764831845f;
constexpr int RT_CTX = 128, RT_W = 144, RT_WF = 154, RA_ROWS = 158 * 256;
constexpr int G1_MAIN = 1280, G1_FT = 512, G1_CTX = 64, G1_UNITS = G1_MAIN + G1_FT + G1_CTX;

constexpr size_t MiB = 1u << 20;
constexpr size_t WS_ADA = 1 * MiB;
constexpr size_t WS_ROPE = WS_ADA + 256 * 1024;
constexpr size_t WS_ROWSS = WS_ROPE + 64 * 1024;
constexpr size_t WS_RA = 2 * MiB;
constexpr size_t WS_MIX = WS_RA;
constexpr size_t WS_PROJ = 82 * MiB;
constexpr size_t WS_Y = WS_PROJ;
constexpr size_t WS_KVC = 242 * MiB;
constexpr size_t WS_ZT = 250 * MiB;
constexpr size_t WS_DT = 314 * MiB;
constexpr size_t WS_ST = 330 * MiB;
constexpr size_t WS_WOT = 394 * MiB;
constexpr size_t WS_END = 396 * MiB;
constexpr int LDS_BYTES = 147456;

struct Params {
    const float *x, *c, *ctx, *c_ctx, *w_ada, *b_ada, *g_pre, *g_post, *w_in, *w_fourier, *decay_logit, *gn_gain, *w_out;
    float* out; unsigned char* ws; int ph_lo, ph_hi;
};

DI unsigned f2bf(float f) { unsigned u = __builtin_bit_cast(unsigned, f); return (u + 0x7fffu + ((u >> 16) & 1u)) >> 16; }
DI unsigned pk2(float lo, float hi) { unsigned r; asm("v_cvt_pk_bf16_f32 %0, %1, %2" : "=v"(r) : "v"(lo), "v"(hi)); return r; }
DI float bflo(unsigned u) { return __builtin_bit_cast(float, u << 16); }
DI float bfhi(unsigned u) { return __builtin_bit_cast(float, u & 0xffff0000u); }
DI float silu_f(float v) { return v / (1.f + __expf(-v)); }
DI float wave_sum(float v) {
#pragma unroll
    for (int o = 1; o < 64; o <<= 1) v += __shfl_xor(v, o);
    return v;
}
DI unsigned offb(unsigned row, unsigned ch) { return 256u * row + 16u * (ch ^ (((row & 3) << 2) | ((row >> 2) & 3))); }
DI s16x4 tr_read(LAS unsigned char* p) { return __builtin_amdgcn_ds_read_tr16_b64_v4i16((LAS s16x4*)p); }
DI bf16x8 cat8(s16x4 a, s16x4 b) { bf16x8 r; r[0] = a[0]; r[1] = a[1]; r[2] = a[2]; r[3] = a[3]; r[4] = b[0]; r[5] = b[1]; r[6] = b[2]; r[7] = b[3]; return r; }
#define MFMA16(a, b, c) __builtin_amdgcn_mfma_f32_16x16x32_bf16((a), (b), (c), 0, 0, 0)

struct G1Order {
    int G, c;
    DI bool next(int i, pg8::Unit& u) const {
        const int L = i * G + c; if (L >= G1_UNITS) return false;
        if (L < G1_MAIN) {
            const int wgid = (L & 7) * (G1_MAIN / 8) + (L >> 3);
            const int r80 = wgid % 80;
            u.pm = (wgid / 80) * 8 + (r80 & 7); u.pn = RT_W + (r80 >> 3);
        } else if (L < G1_MAIN + G1_FT) {
            const int l2 = L - G1_MAIN, idx = (l2 & 7) * (G1_FT / 8) + (l2 >> 3);
            u.pm = RT_WF + (idx & 3); u.pn = idx >> 2;
        } else {
            const int l2 = L - G1_MAIN - G1_FT;
            u.pm = RT_CTX + (l2 >> 2); u.pn = RT_W + 4 + (l2 & 3);
        }
        return true;
    }
    DI void a_ready(const pg8::Unit&) const {}
    DI void done(const pg8::Unit&) const {}
};

DI v4u pack8(f32x4 a, f32x4 b) { v4u w; w.x = pk2(a[0], a[1]); w.y = pk2(a[2], a[3]); w.z = pk2(b[0], b[1]); w.w = pk2(b[2], b[3]); return w; }

struct EpiG1 {
    static constexpr bool PERM = true, AFTER_DRAIN = false;
    bf16* PROJ; bf16* ZT; bf16* KVC; const float* rope;
    DI void operator()(const f32x4 (&acc)[2][2][4][2], const pg8::Unit& u, int wr, int wc, int fr, int fq) const {
        const int rl0 = wr * 64 + fr, cl0 = wc * 32 + 8 * fq;
        bf16* base; int ld, mode = 0; float sc = 1.f;
        if (u.pm < RT_CTX) {
            const int wt = u.pn - RT_W, type = wt >> 1;
            base = PROJ + (size_t)(u.pm * 256) * PROJ_LD + wt * 256; ld = PROJ_LD;
            mode = (type == 1 || type == 2) ? 1 : (type == 3 ? 0 : 2); sc = (type == 1) ? QK_SCALE : 1.f;
        } else if (u.pm >= RT_WF) {
            base = ZT + ((size_t)(u.pn >> 3) * 1024 + (u.pm - RT_WF) * 256) * SEQ + (u.pn & 7) * 256; ld = SEQ;
        } else {
            base = KVC + (size_t)((u.pm - RT_CTX) * 256) * 1024 + (u.pn - RT_W - 4) * 256; ld = 1024;
        }
        base += (size_t)rl0 * ld + cl0;
        const int lbase = (u.pm * 256 + rl0) & (SEQ - 1);
        const float* rbase = rope + (16 * (wc & 1) + 4 * fq) * 2;
#pragma unroll
        for (int ai = 0; ai < 2; ++ai)
#pragma unroll
            for (int m = 0; m < 4; ++m) {
                bf16* rowp = base + (size_t)(ai * 128 + m * 16) * ld;
                f32x4 v00 = acc[ai][0][m][0], v01 = acc[ai][0][m][1], v10 = acc[ai][1][m][0], v11 = acc[ai][1][m][1];
                if (mode == 1) {
                    const int l = lbase + ai * 128 + m * 16;
                    const int pos = (wc >> 1) ? (l & 63) : (l >> 6);
                    const f32x4 r0 = *(const f32x4*)(rbase + pos * 64), r1 = *(const f32x4*)(rbase + pos * 64 + 4);
                    f32x4 t;
                    t = v00 * sc; v00[0] = t[0] * r0[0] - t[1] * r0[1]; v00[1] = t[0] * r0[1] + t[1] * r0[0]; v00[2] = t[2] * r0[2] - t[3] * r0[3]; v00[3] = t[2] * r0[3] + t[3] * r0[2];
                    t = v01 * sc; v01[0] = t[0] * r1[0] - t[1] * r1[1]; v01[1] = t[0] * r1[1] + t[1] * r1[0]; v01[2] = t[2] * r1[2] - t[3] * r1[3]; v01[3] = t[2] * r1[3] + t[3] * r1[2];
                    t = v10 * sc; v10[0] = t[0] * r0[0] - t[1] * r0[1]; v10[1] = t[0] * r0[1] + t[1] * r0[0]; v10[2] = t[2] * r0[2] - t[3] * r0[3]; v10[3] = t[2] * r0[3] + t[3] * r0[2];
                    t = v11 * sc; v11[0] = t[0] * r1[0] - t[1] * r1[1]; v11[1] = t[0] * r1[1] + t[1] * r1[0]; v11[2] = t[2] * r1[2] - t[3] * r1[3]; v11[3] = t[2] * r1[3] + t[3] * r1[2];
                } else if (mode == 2) {
#pragma unroll
                    for (int j = 0; j < 4; ++j) { v00[j] = silu_f(v00[j]); v01[j] = silu_f(v01[j]); v10[j] = silu_f(v10[j]); v11[j] = silu_f(v11[j]); }
                }
                *(v4u*)(rowp) = pack8(v00, v01);
                *(v4u*)(rowp + 128) = pack8(v10, v11);
                asm volatile("" ::: "memory");
            }
    }
};

struct EpiDft {
    static constexpr bool PERM = true, AFTER_DRAIN = false;
    const bf16* PROJ; bf16* MIX;
    DI void operator()(const f32x4 (&acc)[2][2][4][2], const pg8::Unit& u, int wr, int wc, int fr, int fq) const {
        const int rl0 = wr * 64 + fr, cl0 = wc * 32 + 8 * fq;
        const int b = u.pn >> 1, chg0 = (u.pn & 1) * 256 + cl0;
#pragma unroll
        for (int ai = 0; ai < 2; ++ai)
#pragma unroll
            for (int m = 0; m < 4; ++m) {
                const size_t tok = (size_t)b * SEQ + u.pm * 256 + rl0 + ai * 128 + m * 16;
#pragma unroll
                for (int bj = 0; bj < 2; ++bj) {
                    const v4u g = *(const v4u*)(PROJ + tok * PROJ_LD + PC_G + chg0 + bj * 128);
                    f32x4 v0 = acc[ai][bj][m][0], v1 = acc[ai][bj][m][1];
                    v0[0] *= bflo(g.x); v0[1] *= bfhi(g.x); v0[2] *= bflo(g.y); v0[3] *= bfhi(g.y);
                    v1[0] *= bflo(g.z); v1[1] *= bfhi(g.z); v1[2] *= bflo(g.w); v1[3] *= bfhi(g.w);
                    *(v4u*)(MIX + tok * 1024 + chg0 + bj * 128) = pack8(v0, v1);
                }
            }
    }
};

struct EpiOut {
    static constexpr bool PERM = true, AFTER_DRAIN = false;
    bf16* Y; float* rowss;
    DI void operator()(const f32x4 (&acc)[2][2][4][2], const pg8::Unit& u, int wr, int wc, int fr, int fq) const {
        const int rl0 = wr * 64 + fr, cl0 = u.pn * 256 + wc * 32 + 8 * fq;
#pragma unroll
        for (int ai = 0; ai < 2; ++ai)
#pragma unroll
            for (int m = 0; m < 4; ++m) {
                const int row = u.pm * 256 + rl0 + ai * 128 + m * 16;
                float ss = 0.f;
#pragma unroll
                for (int bj = 0; bj < 2; ++bj) {
                    const f32x4 v0 = acc[ai][bj][m][0], v1 = acc[ai][bj][m][1];
                    ss += (v0[0] * v0[0] + v0[1] * v0[1]) + (v0[2] * v0[2] + v0[3] * v0[3]) + (v1[0] * v1[0] + v1[1] * v1[1]) + (v1[2] * v1[2] + v1[3] * v1[3]);
                    *(v4u*)(Y + (size_t)row * 1024 + cl0 + bj * 128) = pack8(v0, v1);
                }
                ss += __shfl_xor(ss, 16); ss += __shfl_xor(ss, 32);
                if (fq == 0) atomicAdd(rowss + row, ss);
            }
    }
};

DI int w1_srccol(int n) {
    const int t = n >> 9; int src = 512 + n;
    if (t == 1 || t == 2) { const int p = n & 127, hs = p >> 6, w = p & 63; src = 512 + (n & ~127) + hs * 64 + (w & 1) * 32 + (w >> 1); }
    return src;
}
template <bool MAIN>
DI void transpose_item(const float* W, int N, bf16* WT, int item, LAS float* scr, int lane) {
    const int nblk = MAIN ? 80 : 32, kb = item / nblk, nb = item % nblk, k0 = 64 * kb, n0 = 32 * nb;
    const int nl = lane & 31, sc = MAIN ? w1_srccol(n0 + nl) : (n0 + nl);
#pragma unroll 8
    for (int i = 0; i < 32; ++i) { const int kk = 2 * i + (lane >> 5); scr[kk * 33 + nl] = W[(size_t)(k0 + kk) * N + sc]; }
    asm volatile("s_waitcnt lgkmcnt(0)" ::: "memory");
    const int c = lane & 7;
#pragma unroll
    for (int j = 0; j < 4; ++j) { const int n = (lane >> 3) + 8 * j; const LAS float* s = scr + (8 * c) * 33 + n;
        v4u o; o.x = pk2(s[0 * 33], s[1 * 33]); o.y = pk2(s[2 * 33], s[3 * 33]); o.z = pk2(s[4 * 33], s[5 * 33]); o.w = pk2(s[6 * 33], s[7 * 33]);
        *(v4u*)(WT + (size_t)(n0 + n) * 1024 + k0 + 8 * c) = o; }
    asm volatile("s_waitcnt lgkmcnt(0)" ::: "memory");
}

DI void phase0(const Params& p, LAS unsigned char* lds, int tid, int lane, int wave) {
    float* ADA = (float*)(p.ws + WS_ADA); float* rope = (float*)(p.ws + WS_ROPE); float* rowss = (float*)(p.ws + WS_ROWSS);
    bf16* RA = (bf16*)(p.ws + WS_RA); bf16* DT = (bf16*)(p.ws + WS_DT); bf16* WOT = (bf16*)(p.ws + WS_WOT);
    bf16* W1T = RA + (size_t)RT_W * 256 * 1024; bf16* WFT = RA + (size_t)RT_WF * 256 * 1024;
    LAS float* sl = (LAS float*)lds; LAS float* red = sl + 17 * 1024;
    for (int i = tid; i < 17 * 1024; i += 512) { const int v = i >> 10, k = i & 1023; const float cv = (v < 16) ? p.c[v * 1024 + k] : p.c_ctx[k]; sl[i] = cv / (1.f + expf(-cv)); }
    __syncthreads();
    for (int vw = blockIdx.x; vw < 256; vw += gridDim.x) {
        const int j0 = 12 * vw, col = tid & 15, ks = tid >> 4;
        float acc[17];
#pragma unroll
        for (int v = 0; v < 17; ++v) acc[v] = 0.f;
        if (col < 12) {
            for (int kk = 0; kk < 32; ++kk) { const int k = ks * 32 + kk; const float wv = p.w_ada[(size_t)k * 3072 + j0 + col];
#pragma unroll
                for (int v = 0; v < 17; ++v) acc[v] += sl[v * 1024 + k] * wv; }
#pragma unroll
            for (int v = 0; v < 17; ++v) red[(ks * 17 + v) * 12 + col] = acc[v];
        }
        __syncthreads();
        if (tid < 204) { const int v = tid / 12, cc = tid % 12; float s = p.b_ada[j0 + cc];
            for (int k2 = 0; k2 < 32; ++k2) s += red[(k2 * 17 + v) * 12 + cc];
            ADA[v * 3072 + j0 + cc] = s; }
        __syncthreads();
    }
    {
        LAS float* scr = (LAS float*)(lds + wave * 8448);
        const int gw = blockIdx.x * 8 + wave, NGW = gridDim.x * 8;
        for (int it = gw; it < 1280 + 512; it += NGW) {
            if (it < 1280) transpose_item<true>(p.w_in, 3072, W1T, it, scr, lane);
            else transpose_item<false>(p.w_out, 1024, WOT, it - 1280, scr, lane);
        }
    }
    __syncthreads();
    {
        LAS float* ct = (LAS float*)lds; LAS float* st = ct + 128; LAS float* Tl = st + 128;
        if (tid < 128) { float s, c; sincospif((float)tid * (1.f / 64.f), &s, &c); ct[tid] = c; st[tid] = s; }
        __syncthreads();
        for (int vw = blockIdx.x; vw < 256; vw += gridDim.x) {
            const int g = vw >> 6, d0 = (vw & 63) * 2;
            { const int pq = tid >> 8, dd = (tid >> 7) & 1, c = tid & 127; float a = 0.f;
              for (int j = 0; j < 128; ++j) { const int idx = (j * c) & 127; a += (pq ? st[idx] : ct[idx]) * p.w_fourier[(size_t)(g * 128 + j) * 128 + d0 + dd]; }
              Tl[(dd * 2 + pq) * 128 + c] = a * (1.f / 512.f); }
            __syncthreads();
#pragma unroll 1
            for (int kq = tid; kq < 1024; kq += 512) {
                float a0 = 0.f, a1 = 0.f, a2 = 0.f, a3 = 0.f;
                const f32x4* wp = (const f32x4*)(p.w_in + (size_t)kq * 3072 + g * 128);
                for (int c4 = 0; c4 < 32; ++c4) { const f32x4 wv = wp[c4];
#pragma unroll
                    for (int e = 0; e < 4; ++e) { const int c = c4 * 4 + e; a0 += wv[e] * Tl[c]; a1 += wv[e] * Tl[128 + c]; a2 += wv[e] * Tl[256 + c]; a3 += wv[e] * Tl[384 + c]; } }
                bf16* o = WFT + (size_t)((g * 128 + d0) * 2) * 1024 + kq;
                o[0] = (bf16)f2bf(a0); o[1024] = (bf16)f2bf(a1); o[2048] = (bf16)f2bf(a2); o[3072] = (bf16)f2bf(a3);
            }
            __syncthreads();
        }
    }
    {
        LAS float* ct = (LAS float*)lds;
        for (int i = tid; i < 2048; i += 512) ct[i] = cospif((float)i * (1.f / 1024.f));
        __syncthreads();
        for (int vw = blockIdx.x; vw < 256; vw += gridDim.x)
            for (int idx = tid; idx < 8 * 512; idx += 512) {
                const int row = 8 * vw + (idx >> 9), col0 = (idx & 511) * 8, l0 = col0 & 2047; const bool neg = col0 >= 2048;
                float v[8];
#pragma unroll
                for (int j = 0; j < 8; ++j) { const int ph = (row * (l0 + j)) & 2047; v[j] = neg ? -ct[(ph - 512) & 2047] : ct[ph]; }
                v4u o; o.x = pk2(v[0], v[1]); o.y = pk2(v[2], v[3]); o.z = pk2(v[4], v[5]); o.w = pk2(v[6], v[7]);
                *(v4u*)(DT + (size_t)row * 4096 + col0) = o;
            }
        __syncthreads();
    }
    for (int vw = blockIdx.x; vw < 256; vw += gridDim.x) {
        if (vw < 4) { const int idx = vw * 512 + tid, pos = idx >> 5, i = idx & 31; const float inv = powf(10000.f, -(float)i * (1.f / 32.f)); const float ang = (float)pos * inv;
            rope[idx * 2] = cosf(ang); rope[idx * 2 + 1] = sinf(ang); }
        if (tid < 128) rowss[vw * 128 + tid] = 0.f;
    }
}

DI void phase1(const Params& p, int lane, int wave) {
    const float* ADA = (const float*)(p.ws + WS_ADA); bf16* RA = (bf16*)(p.ws + WS_RA);
    const int gw = blockIdx.x * 8 + wave, NGW = gridDim.x * 8, NR = MTOK + MCTX, rpw = (NR + NGW - 1) / NGW;
    int r0 = gw * rpw, r1 = r0 + rpw; if (r1 > NR) r1 = NR;
    int vcur = -1; f32x4 gs[4], sh[4];
    for (int r = r0; r < r1; ++r) {
        const int v = (r < MTOK) ? (r >> 11) : 16;
        if (v != vcur) { vcur = v;
#pragma unroll
            for (int j = 0; j < 4; ++j) { const int col = lane * 4 + 256 * j; const f32x4 g = *(const f32x4*)(p.g_pre + col), sc = *(const f32x4*)(ADA + v * 3072 + 1024 + col);
                gs[j] = g * (sc + 1.f); sh[j] = *(const f32x4*)(ADA + v * 3072 + col); } }
        const float* xr = (r < MTOK) ? p.x + (size_t)r * 1024 : p.ctx + (size_t)(r - MTOK) * 1024;
        f32x4 xv[4]; float s = 0.f;
#pragma unroll
        for (int j = 0; j < 4; ++j) { xv[j] = *(const f32x4*)(xr + lane * 4 + 256 * j); s += (xv[j][0] * xv[j][0] + xv[j][1] * xv[j][1]) + (xv[j][2] * xv[j][2] + xv[j][3] * xv[j][3]); }
        const float rstd = rsqrtf(wave_sum(s) * (1.f / 1024.f) + EPSV);
        bf16* o = RA + (size_t)r * 1024;
#pragma unroll
        for (int j = 0; j < 4; ++j) { const f32x4 hv = xv[j] * rstd * gs[j] + sh[j]; v2u w; w.x = pk2(hv[0], hv[1]); w.y = pk2(hv[2], hv[3]); *(v2u*)(o + lane * 4 + 256 * j) = w; }
    }
}

DI void state_unit(const Params& p, LAS unsigned char* lds, int unit, int tid, int lane, int wave) {
    const bf16* PROJ = (const bf16*)(p.ws + WS_PROJ); const bf16* KVC = (const bf16*)(p.ws + WS_KVC); bf16* ST = (bf16*)(p.ws + WS_ST);
    const int eh = unit & 1, dir = (unit >> 1) & 1, h = (unit >> 2) & 3, b = unit >> 4;
    const int fr = lane & 15, fq = lane >> 4, q4 = fr >> 2, pp = fr & 3;
    const int et = wave & 3, dtb = (wave >> 2) * 4, cb = 4 * eh + et;
    const float lg = p.decay_logit[dir * 4 + h]; const float l2 = -log1pf(expf(-lg)) * 1.4426950408889634f;
    const float cdec = exp2f(128.f * l2);
    LAS unsigned char* Kimg = lds; LAS unsigned char* Vimg = lds + 32768;
    f32x4 acc[4];
#pragma unroll
    for (int i = 0; i < 4; ++i) acc[i] = (f32x4){0.f, 0.f, 0.f, 0.f};
    v4u kr[4], vr[2];
#define ST_LOAD(s) do { const bf16* Kp; int ld; \
        if ((s) < 2) { const int cc = dir ? 1 - (s) : (s); Kp = KVC + (size_t)(b * 256 + cc * 128) * 1024 + h * 128; ld = 1024; } \
        else { const int c = dir ? 17 - (s) : (s) - 2; Kp = PROJ + (size_t)(b * SEQ + c * 128) * PROJ_LD + PC_K + h * 128; ld = PROJ_LD; } \
        _Pragma("unroll") for (int i = 0; i < 4; ++i) { const int id = tid + 512 * i; kr[i] = *(const v4u*)(Kp + (size_t)(id >> 4) * ld + (id & 15) * 8); } \
        _Pragma("unroll") for (int i = 0; i < 2; ++i) { const int id = tid + 512 * i; vr[i] = *(const v4u*)(Kp + 512 + (size_t)(id >> 3) * ld + (8 * eh + (id & 7)) * 8); } } while (0)
    ST_LOAD(0);
#pragma unroll 1
    for (int s = 0; s < 18; ++s) {
        if (s < 17) {
            if (s) __syncthreads();
#pragma unroll
            for (int i = 0; i < 4; ++i) { const int id = tid + 512 * i; *(LAS v4u*)(Kimg + offb(id >> 4, id & 15)) = kr[i]; }
#pragma unroll
            for (int i = 0; i < 2; ++i) { const int id = tid + 512 * i, m = id >> 3; const float wgt = exp2f((float)(dir ? m : 127 - m) * l2);
                v4u o; o.x = pk2(bflo(vr[i].x) * wgt, bfhi(vr[i].x) * wgt); o.y = pk2(bflo(vr[i].y) * wgt, bfhi(vr[i].y) * wgt);
                o.z = pk2(bflo(vr[i].z) * wgt, bfhi(vr[i].z) * wgt); o.w = pk2(bflo(vr[i].w) * wgt, bfhi(vr[i].w) * wgt);
                *(LAS v4u*)(Vimg + offb(m, 8 * eh + (id & 7))) = o; }
            __syncthreads();
            if (s + 1 < 17) ST_LOAD(s + 1);
        }
        if (s >= 2) {
            const int c = dir ? 17 - s : s - 2;
            bf16* so = ST + ((size_t)(((b * 4 + h) * 16 + c) * 2 + dir)) * 16384 + (size_t)(64 * eh + 16 * et + fr) * 128;
#pragma unroll
            for (int i = 0; i < 4; ++i) { v2u w; w.x = pk2(acc[i][0], acc[i][1]); w.y = pk2(acc[i][2], acc[i][3]); *(v2u*)(so + 16 * (dtb + i) + 4 * fq) = w; }
        }
        if (s < 17) {
#pragma unroll
            for (int i = 0; i < 4; ++i) acc[i] = acc[i] * cdec;
#pragma unroll
            for (int ks = 0; ks < 4; ++ks) {
                const unsigned r0 = 32 * ks + 8 * fq + q4;
                const bf16x8 vb = cat8(tr_read(Vimg + offb(r0, 2 * cb + (pp >> 1)) + 8 * (pp & 1)), tr_read(Vimg + offb(r0 + 4, 2 * cb + (pp >> 1)) + 8 * (pp & 1)));
#pragma unroll
                for (int i = 0; i < 4; ++i) { const int dt = dtb + i;
                    const bf16x8 ka = cat8(tr_read(Kimg + offb(r0, 2 * dt + (pp >> 1)) + 8 * (pp & 1)), tr_read(Kimg + offb(r0 + 4, 2 * dt + (pp >> 1)) + 8 * (pp & 1)));
                    acc[i] = MFMA16(ka, vb, acc[i]); }
            }
        }
    }
#undef ST_LOAD
}

DI void ret_unit(const Params& p, LAS unsigned char* lds, int unit, int tid, int lane, int wave) {
    const bf16* PROJ = (const bf16*)(p.ws + WS_PROJ); const bf16* ST = (const bf16*)(p.ws + WS_ST); bf16* MIX = (bf16*)(p.ws + WS_MIX);
    const int c = unit & 15, h = (unit >> 4) & 3, b = unit >> 6;
    const int fr = lane & 15, fq = lane >> 4, q4 = fr >> 2, pp = fr & 3;
    const size_t tok0 = (size_t)b * SEQ + c * 128;
    const float l2f = -log1pf(expf(-p.decay_logit[h])) * 1.4426950408889634f, l2b = -log1pf(expf(-p.decay_logit[4 + h])) * 1.4426950408889634f;
    LAS unsigned char* Kimg = lds; LAS unsigned char* Vimg = lds + 32768; LAS unsigned char* Simg = lds + 65536; LAS unsigned char* Ost = lds + 98304 + wave * 4352;
    const bf16* Kp = PROJ + tok0 * PROJ_LD + PC_K + h * 128; const bf16* Vp = PROJ + tok0 * PROJ_LD + PC_V + h * 128;
    const bf16* Sf = ST + ((size_t)(((b * 4 + h) * 16 + c) * 2)) * 16384; const bf16* Sb = Sf + 16384;
    v4u kr[4], vr[4], sr[4], sbr[4]; bf16x8 qf[4];
#pragma unroll
    for (int i = 0; i < 4; ++i) { const int id = tid + 512 * i, row = id >> 4, ch = id & 15;
        kr[i] = *(const v4u*)(Kp + (size_t)row * PROJ_LD + ch * 8); vr[i] = *(const v4u*)(Vp + (size_t)row * PROJ_LD + ch * 8);
        sr[i] = *(const v4u*)(Sf + row * 128 + ch * 8); sbr[i] = *(const v4u*)(Sb + row * 128 + ch * 8); }
    { const bf16* Qp = PROJ + (tok0 + 16 * wave + fr) * PROJ_LD + PC_Q + h * 128 + 8 * fq;
#pragma unroll
      for (int ks = 0; ks < 4; ++ks) qf[ks] = *(const bf16x8*)(Qp + 32 * ks); }
    __syncthreads();
#pragma unroll
    for (int i = 0; i < 4; ++i) { const int id = tid + 512 * i; const unsigned o = offb(id >> 4, id & 15);
        *(LAS v4u*)(Kimg + o) = kr[i]; *(LAS v4u*)(Vimg + o) = vr[i]; *(LAS v4u*)(Simg + o) = sr[i]; }
    __syncthreads();
    const int nl = 16 * wave + fr;
    const float sf = exp2f((float)(nl + 1) * l2f), sbv = exp2f((float)(128 - nl) * l2b);
    f32x4 O[8];
#pragma unroll
    for (int et = 0; et < 8; ++et) { f32x4 a = (f32x4){0.f, 0.f, 0.f, 0.f};
#pragma unroll
        for (int ks = 0; ks < 4; ++ks) a = MFMA16(*(const LAS bf16x8*)(Simg + offb(16 * et + fr, 4 * ks + fq)), qf[ks], a);
        O[et] = a * sf; }
    bf16x8 pf[4];
#pragma unroll
    for (int k2 = 0; k2 < 4; ++k2) {
        v4u pw;
#pragma unroll
        for (int hf = 0; hf < 2; ++hf) { const int mt = 2 * k2 + hf; f32x4 sacc = (f32x4){0.f, 0.f, 0.f, 0.f};
#pragma unroll
            for (int ks = 0; ks < 4; ++ks) sacc = MFMA16(*(const LAS bf16x8*)(Kimg + offb(16 * mt + fr, 4 * ks + fq)), qf[ks], sacc);
#pragma unroll
            for (int j = 0; j < 4; ++j) { const int df = nl - (16 * mt + 4 * fq + j); sacc[j] *= (df >= 0) ? exp2f((float)df * l2f) : exp2f((float)(-df) * l2b); }
            if (hf == 0) { pw.x = pk2(sacc[0], sacc[1]); pw.y = pk2(sacc[2], sacc[3]); } else { pw.z = pk2(sacc[0], sacc[1]); pw.w = pk2(sacc[2], sacc[3]); } }
        pf[k2] = __builtin_bit_cast(bf16x8, pw);
    }
#pragma unroll
    for (int et = 0; et < 8; ++et)
#pragma unroll
        for (int ks = 0; ks < 4; ++ks) { const unsigned r0 = 32 * ks + 4 * fq + q4;
            const bf16x8 va = cat8(tr_read(Vimg + offb(r0, 2 * et + (pp >> 1)) + 8 * (pp & 1)), tr_read(Vimg + offb(r0 + 16, 2 * et + (pp >> 1)) + 8 * (pp & 1)));
            O[et] = MFMA16(va, pf[ks], O[et]); }
    __syncthreads();
#pragma unroll
    for (int i = 0; i < 4; ++i) { const int id = tid + 512 * i; *(LAS v4u*)(Simg + offb(id >> 4, id & 15)) = sbr[i]; }
    __syncthreads();
#pragma unroll
    for (int et = 0; et < 8; ++et) { f32x4 a = (f32x4){0.f, 0.f, 0.f, 0.f};
#pragma unroll
        for (int ks = 0; ks < 4; ++ks) a = MFMA16(*(const LAS bf16x8*)(Simg + offb(16 * et + fr, 4 * ks + fq)), qf[ks], a);
        O[et] = O[et] + a * sbv; }
    float s1 = 0.f;
#pragma unroll
    for (int et = 0; et < 8; ++et) s1 += (O[et][0] + O[et][1]) + (O[et][2] + O[et][3]);
    s1 += __shfl_xor(s1, 16); s1 += __shfl_xor(s1, 32);
    const float mu = s1 * (1.f / 128.f); float s2 = 0.f;
#pragma unroll
    for (int et = 0; et < 8; ++et) { O[et] = O[et] - mu; s2 += (O[et][0] * O[et][0] + O[et][1] * O[et][1]) + (O[et][2] * O[et][2] + O[et][3] * O[et][3]); }
    s2 += __shfl_xor(s2, 16); s2 += __shfl_xor(s2, 32);
    const float rstd = rsqrtf(s2 * (1.f / 128.f) + EPSV);
#pragma unroll
    for (int et = 0; et < 8; ++et) { v2u w; w.x = pk2(O[et][0] * rstd, O[et][1] * rstd); w.y = pk2(O[et][2] * rstd, O[et][3] * rstd); *(LAS v2u*)(Ost + fr * 272 + (16 * et + 4 * fq) * 2) = w; }
    asm volatile("s_waitcnt lgkmcnt(0)" ::: "memory");
#pragma unroll
    for (int i = 0; i < 4; ++i) { const int id = lane + 64 * i, row = id >> 4, ch = id & 15;
        const v4u on = *(const LAS v4u*)(Ost + row * 272 + ch * 16);
        const size_t tok = tok0 + 16 * wave + row;
        const v4u g = *(const v4u*)(PROJ + tok * PROJ_LD + PC_R + h * 128 + ch * 8);
        const f32x4 g0 = *(const f32x4*)(p.gn_gain + h * 128 + ch * 8), g1 = *(const f32x4*)(p.gn_gain + h * 128 + ch * 8 + 4);
        v4u o;
        o.x = pk2(bflo(on.x) * g0[0] * bflo(g.x), bfhi(on.x) * g0[1] * bfhi(g.x)); o.y = pk2(bflo(on.y) * g0[2] * bflo(g.y), bfhi(on.y) * g0[3] * bfhi(g.y));
        o.z = pk2(bflo(on.z) * g1[0] * bflo(g.z), bfhi(on.z) * g1[1] * bfhi(g.z)); o.w = pk2(bflo(on.w) * g1[2] * bflo(g.w), bfhi(on.w) * g1[3] * bfhi(g.w));
        *(v4u*)(MIX + tok * 1024 + 512 + h * 128 + ch * 8) = o; }
}

DI void phase6(const Params& p, int lane, int wave) {
    const float* ADA = (const float*)(p.ws + WS_ADA); const float* rowss = (const float*)(p.ws + WS_ROWSS); const bf16* Y = (const bf16*)(p.ws + WS_Y);
    const int gw = blockIdx.x * 8 + wave, NGW = gridDim.x * 8, rpw = (MTOK + NGW - 1) / NGW;
    int r0 = gw * rpw, r1 = r0 + rpw; if (r1 > MTOK) r1 = MTOK;
    int vcur = -1; f32x4 gg[4];
    for (int r = r0; r < r1; ++r) {
        const int v = r >> 11;
        if (v != vcur) { vcur = v;
#pragma unroll
            for (int j = 0; j < 4; ++j) { const int col = lane * 4 + 256 * j; gg[j] = *(const f32x4*)(p.g_post + col) * *(const f32x4*)(ADA + v * 3072 + 2048 + col); } }
        const float rstd = rsqrtf(rowss[r] * (1.f / 1024.f) + EPSV);
#pragma unroll
        for (int j = 0; j < 4; ++j) { const int col = lane * 4 + 256 * j;
            const f32x4 xv = *(const f32x4*)(p.x + (size_t)r * 1024 + col); const v2u yv = *(const v2u*)(Y + (size_t)r * 1024 + col);
            f32x4 o; o[0] = xv[0] + gg[j][0] * (bflo(yv.x) * rstd); o[1] = xv[1] + gg[j][1] * (bfhi(yv.x) * rstd); o[2] = xv[2] + gg[j][2] * (bflo(yv.y) * rstd); o[3] = xv[3] + gg[j][3] * (bfhi(yv.y) * rstd);
            *(f32x4*)(p.out + (size_t)r * 1024 + col) = o; }
    }
}

__global__ void __launch_bounds__(512, 2) hymba_fwd(Params p) {
    extern __shared__ __attribute__((aligned(16))) unsigned char lds_raw[];
    LAS unsigned char* lds = (LAS unsigned char*)lds_raw;
    cg::grid_group grid = cg::this_grid();
    const int tid = threadIdx.x, lane = tid & 63, wave = __builtin_amdgcn_readfirstlane(tid >> 6);
    const int lo = p.ph_lo, hi = p.ph_hi;
#define IN(k) (lo <= (k) && (k) < hi)
#define SEAM(k) do { if (IN(k) && IN((k) + 1)) grid.sync(); } while (0)
    bf16* RA = (bf16*)(p.ws + WS_RA);
    if (IN(0)) phase0(p, lds, tid, lane, wave);
    SEAM(0);
    if (IN(1)) phase1(p, lane, wave);
    SEAM(1);
    if (IN(2)) {
        pg8::Gemm g{RA, RA, RA_ROWS, RA_ROWS, 1024}; G1Order S{(int)gridDim.x, (int)blockIdx.x};
        EpiG1 E{(bf16*)(p.ws + WS_PROJ), (bf16*)(p.ws + WS_ZT), (bf16*)(p.ws + WS_KVC), (const float*)(p.ws + WS_ROPE)};
        pg8::gemm_phase<EpiG1, G1Order, true, true>(lds, g, S, E);
    }
    SEAM(2);
    if (IN(3)) {
        for (int u = blockIdx.x; u < 256; u += gridDim.x) { state_unit(p, lds, u, tid, lane, wave); __syncthreads(); }
        pg8::Gemm g{(const bf16*)(p.ws + WS_DT), (const bf16*)(p.ws + WS_ZT), 2048, 8192, 4096}; pg8::StaticOrder S; S.init(2048, 8192, (int)gridDim.x, (int)blockIdx.x);
        EpiDft E{(const bf16*)(p.ws + WS_PROJ), (bf16*)(p.ws + WS_MIX)};
        pg8::gemm_phase<EpiDft, pg8::StaticOrder, true, true>(lds, g, S, E);
    }
    SEAM(3);
    if (IN(4)) { for (int u = blockIdx.x; u < 1024; u += gridDim.x) ret_unit(p, lds, u, tid, lane, wave); }
    SEAM(4);
    if (IN(5)) {
        __syncthreads();
        pg8::Gemm g{(const bf16*)(p.ws + WS_MIX), (const bf16*)(p.ws + WS_WOT), MTOK, 1024, 1024}; pg8::StaticOrder S; S.init(MTOK, 1024, (int)gridDim.x, (int)blockIdx.x);
        EpiOut E{(bf16*)(p.ws + WS_Y), (float*)(p.ws + WS_ROWSS)};
        pg8::gemm_phase<EpiOut, pg8::StaticOrder, true, true>(lds, g, S, E);
    }
    SEAM(5);
    if (IN(6)) phase6(p, lane, wave);
#undef IN
#undef SEAM
}

#ifndef N_LAUNCHES
#define N_LAUNCHES 1
#endif
extern "C" void kernel_launch(void* const* d_in, const int* in_sizes, int n_in, void* d_out, int out_size, void* d_ws, size_t ws_size, hipStream_t stream) {
    static int grid = 0;
    if (grid == 0) {
        if (n_in != 13 || out_size != MTOK * DM || ws_size < WS_END) { fprintf(stderr, "kernel_launch: unexpected shapes (n_in %d out %d ws %zu)\n", n_in, out_size, ws_size); grid = -1; return; }
        int dev = 0, cus = 0, per_cu = 0;
        hipGetDevice(&dev); hipDeviceGetAttribute(&cus, hipDeviceAttributeMultiprocessorCount, dev);
        if (hipFuncSetAttribute((const void*)hymba_fwd, hipFuncAttributeMaxDynamicSharedMemorySize, LDS_BYTES) != hipSuccess) { fprintf(stderr, "kernel_launch: hipFuncSetAttribute failed\n"); grid = -1; return; }
        if (hipOccupancyMaxActiveBlocksPerMultiprocessor(&per_cu, (const void*)hymba_fwd, 512, LDS_BYTES) != hipSuccess || per_cu < 1) { fprintf(stderr, "kernel_launch: occupancy query says %d\n", per_cu); per_cu = 1; }
        (void)hipGetLastError();
        grid = cus > 256 ? 256 : cus;
    }
    if (grid < 0) return;
    Params p{};
    p.x = (const float*)d_in[0]; p.c = (const float*)d_in[1]; p.ctx = (const float*)d_in[2]; p.c_ctx = (const float*)d_in[3];
    p.w_ada = (const float*)d_in[4]; p.b_ada = (const float*)d_in[5]; p.g_pre = (const float*)d_in[6]; p.g_post = (const float*)d_in[7];
    p.w_in = (const float*)d_in[8]; p.w_fourier = (const float*)d_in[9]; p.decay_logit = (const float*)d_in[10]; p.gn_gain = (const float*)d_in[11]; p.w_out = (const float*)d_in[12];
    p.out = (float*)d_out; p.ws = (unsigned char*)d_ws;
    if (N_LAUNCHES == 1) {
        p.ph_lo = 0; p.ph_hi = 7;
        void* args[] = {&p};
        hipError_t e = hipLaunchCooperativeKernel((const void*)hymba_fwd, dim3(grid), dim3(512), args, LDS_BYTES, stream);
        if (e != hipSuccess) fprintf(stderr, "cooperative launch failed: %s (grid %d)\n", hipGetErrorString(e), grid);
    } else {
        for (int ph = 0; ph < 7; ++ph) { p.ph_lo = ph; p.ph_hi = ph + 1; hipLaunchKernelGGL(hymba_fwd, dim3(grid), dim3(512), LDS_BYTES, stream, p); }
    }
}
```

```cpp
#include <hip/hip_runtime.h>
#include <hip/hip_cooperative_groups.h>
#include <cstdio>
#include <cstdint>
namespace cg = cooperative_groups;
namespace pg8 {
#define PG8_LAS __attribute__((address_space(3)))
typedef unsigned short bf16_t;
typedef short bf16x8 __attribute__((ext_vector_type(8)));
typedef float f32x4 __attribute__((ext_vector_type(4)));
typedef unsigned u32x4 __attribute__((ext_vector_type(4)));
constexpr int BM = 256, BK = 64, HALF = 128, HTB = HALF * BK * 2  , STAGE_BYTES = 8 * HTB, NXCD = 8, WGM = 8;

__host__ __device__ __forceinline__ int lds_byte(int r, int c) { const int st = (r >> 4) * 2 + (c >> 5), rr = r & 15, cc = c & 31, ob = rr * 64 + cc * 2; return st * 1024 + (ob ^ (((ob >> 9) & 1) << 5)); }
__host__ __device__ __forceinline__ void stage_rc(int b, int& R, int& C) { const int st = b / 1024, sb = b % 1024, swz = sb ^ (((sb >> 9) & 1) << 5); R = (st >> 1) * 16 + swz / 64; C = (st & 1) * 32 + (swz % 64) / 2; }
__host__ __device__ __forceinline__ int perm32(int rho) { const int n = rho >> 4, i = rho & 15; return 8 * (i >> 2) + 4 * n + (i & 3); }

struct Unit { int pm, pn; };
struct Gemm { const bf16_t* A; const bf16_t* Bt; int M, N, K; };

struct StaticOrder {
    int nM, nN, nwg, G, c;
    __host__ __device__ void init(int M, int N, int G_, int c_) { nM = M / BM; nN = N / BM; nwg = nM * nN; G = G_; c = c_; }
    __host__ __device__ bool next(int i, Unit& u) const {
        const long L = (long)i * G + c; if (L >= nwg) return false;
        int wgid = (int)L; { const int q = nwg / NXCD, r = nwg % NXCD, xcd = wgid % NXCD, off = wgid / NXCD; wgid = (xcd < r ? xcd * (q + 1) : r * (q + 1) + (xcd - r) * q) + off; }
        const int nig = WGM * nN, gid = wgid / nig, fm = gid * WGM, gsz = (nM - fm) < WGM ? (nM - fm) : WGM;
        u.pm = fm + ((wgid % nig) % gsz); u.pn = (wgid % nig) / gsz; return true;
    }
    __device__ __forceinline__ void a_ready(const Unit&) const {}
    __device__ __forceinline__ void done(const Unit&) const {}
};

__device__ __forceinline__ unsigned cvt_pk_bf16(float lo, float hi) { unsigned r; asm volatile("v_cvt_pk_bf16_f32 %0, %1, %2" : "=v"(r) : "v"(lo), "v"(hi)); return r; }

template <class Epi, class Sched, bool ALIGN_EPI = false, bool SP2 = false>
__device__ __forceinline__ void gemm_phase(PG8_LAS unsigned char* lds, const Gemm g, const Sched& S, const Epi& E) {
    const int tid = threadIdx.x, wid = __builtin_amdgcn_readfirstlane(tid >> 6), lane = tid & 63, wr = wid >> 2, wc = wid & 3, fr = lane & 15, fq = lane >> 4;
    const int K = g.K, nt = K / BK;
    unsigned voffA[2], voffB[2];
#pragma unroll
    for (int i = 0; i < 2; ++i) { int R, C; stage_rc(tid * 16 + i * 8192, R, C); const int Rb = Epi::PERM ? ((R & ~31) + perm32(R & 31)) : R;
        voffA[i] = (unsigned)(R * K + C) * 2u; voffB[i] = (unsigned)(Rb * K + C) * 2u; }
    const size_t kstep = (size_t)(BK * 2);
    const size_t hstep = (size_t)HALF * K * 2;
    const size_t tstep = 2 * hstep;
    const unsigned ldsw = (unsigned)wid * 1024u;
    const int aoff = lds_byte(wr * 64 + fr, fq * 8), boff = lds_byte(wc * 32 + fr, fq * 8);
#define PG8_SA(b, h) (((b) * 2 + (h)) * HTB)
#define PG8_SB(b, h) ((4 + (b) * 2 + (h)) * HTB)
#define PG8_STAGE(bufoff, gbase, voff) do { _Pragma("unroll") for (int _i = 0; _i < 2; ++_i) \
        __builtin_amdgcn_global_load_lds((const unsigned*)((const char*)(gbase) + (voff)[_i]), (PG8_LAS unsigned*)(lds + (bufoff) + ldsw + _i * 8192), 16, 0, 0); } while (0)
#define PG8_LDA(dst, b, h) do { _Pragma("unroll") for (int m = 0; m < 4; ++m) _Pragma("unroll") for (int k = 0; k < 2; ++k) dst[m][k] = *(const PG8_LAS bf16x8*)(lds + PG8_SA(b, h) + aoff + m * 2048 + k * 1024); } while (0)
#define PG8_LDB(dst, b, h) do { _Pragma("unroll") for (int n = 0; n < 2; ++n) _Pragma("unroll") for (int k = 0; k < 2; ++k) dst[n][k] = *(const PG8_LAS bf16x8*)(lds + PG8_SB(b, h) + boff + n * 2048 + k * 1024); } while (0)
#define PG8_MMA(ai, bj, At, Bt) do { __builtin_amdgcn_s_setprio(1); _Pragma("unroll") for (int m = 0; m < 4; ++m) _Pragma("unroll") for (int n = 0; n < 2; ++n) _Pragma("unroll") for (int k = 0; k < 2; ++k) \
        acc[ai][bj][m][n] = __builtin_amdgcn_mfma_f32_16x16x32_bf16(Bt[n][k], At[m][k], acc[ai][bj][m][n], 0, 0, 0); __builtin_amdgcn_s_setprio(0); } while (0)
#define PG8_WAIT_V(n) asm volatile("s_waitcnt vmcnt(" #n ")" ::: "memory")
#define PG8_WAIT_L(n) asm volatile("s_waitcnt lgkmcnt(" #n ")" ::: "memory")
#define PG8_BAR __builtin_amdgcn_s_barrier()
#define PG8_SCHED __builtin_amdgcn_sched_barrier(0)
    Unit cur, nxt; int ui = 0;
    if (!S.next(0, cur)) return;
    f32x4 acc[2][2][4][2];
#pragma unroll
    for (int a = 0; a < 2; ++a)
#pragma unroll
        for (int b = 0; b < 2; ++b)
#pragma unroll
            for (int m = 0; m < 4; ++m)
#pragma unroll
                for (int n = 0; n < 2; ++n) acc[a][b][m][n] = (f32x4){0.f, 0.f, 0.f, 0.f};
    bf16x8 At[4][2], B0[2][2], B1[2][2];
    const char* cA = (const char*)g.A + (size_t)cur.pm * tstep; const char* cB = (const char*)g.Bt + (size_t)cur.pn * tstep;
    S.a_ready(cur);
    if constexpr (SP2) {
        PG8_STAGE(PG8_SB(0, 0), cB, voffB); PG8_STAGE(PG8_SB(0, 1), cB + hstep, voffB); PG8_STAGE(PG8_SA(0, 0), cA, voffA); PG8_STAGE(PG8_SA(0, 1), cA + hstep, voffA);
        if (wr == 1) PG8_BAR;
        PG8_WAIT_V(2); PG8_BAR;
        PG8_STAGE(PG8_SB(1, 0), cB + kstep, voffB); PG8_STAGE(PG8_SA(1, 0), cA + kstep, voffA); PG8_STAGE(PG8_SB(1, 1), cB + hstep + kstep, voffB);
        PG8_WAIT_V(6); PG8_BAR;
    } else {
        PG8_STAGE(PG8_SB(0, 0), cB, voffB); PG8_STAGE(PG8_SA(0, 0), cA, voffA); PG8_STAGE(PG8_SB(0, 1), cB + hstep, voffB); PG8_STAGE(PG8_SA(0, 1), cA + hstep, voffA);
        if (wr == 1) PG8_BAR;
        PG8_WAIT_V(4); PG8_BAR;
        PG8_STAGE(PG8_SB(1, 0), cB + kstep, voffB); PG8_STAGE(PG8_SA(1, 0), cA + kstep, voffA); PG8_STAGE(PG8_SB(1, 1), cB + hstep + kstep, voffB);
        PG8_WAIT_V(6); PG8_BAR;
    }
    for (;;) {
        const bool has_next = S.next(ui + 1, nxt);
        const char* nA = has_next ? (const char*)g.A + (size_t)nxt.pm * tstep : cA; const char* nB = has_next ? (const char*)g.Bt + (size_t)nxt.pn * tstep : cB;
        for (int t = 0; t < nt; t += 2) {
            const bool last = (t == nt - 2);
            const char* a1 = cA + (size_t)(t + 1) * kstep;
            const char* a2 = last ? nA : cA + (size_t)(t + 2) * kstep; const char* b2 = last ? nB : cB + (size_t)(t + 2) * kstep;
            const char* a3 = a2 + kstep; const char* b3 = b2 + kstep;
            if (last && has_next) S.a_ready(nxt);
            if constexpr (SP2) {
            PG8_LDB(B0, 0, 0); PG8_LDB(B1, 0, 1); PG8_SCHED; PG8_LDA(At, 0, 0); PG8_STAGE(PG8_SA(1, 1), a1 + hstep, voffA);
            PG8_WAIT_V(8); PG8_WAIT_L(0); PG8_BAR; PG8_MMA(0, 0, At, B0); PG8_MMA(0, 1, At, B1); PG8_BAR; PG8_SCHED;
            PG8_LDA(At, 0, 1); PG8_STAGE(PG8_SB(0, 0), b2, voffB); PG8_STAGE(PG8_SB(0, 1), b2 + hstep, voffB); PG8_STAGE(PG8_SA(0, 0), a2, voffA);
            PG8_WAIT_V(8); PG8_WAIT_L(0); PG8_BAR; PG8_MMA(1, 0, At, B0); PG8_MMA(1, 1, At, B1); PG8_BAR; PG8_SCHED;
            PG8_LDB(B0, 1, 0); PG8_LDB(B1, 1, 1); PG8_SCHED; PG8_LDA(At, 1, 0); PG8_STAGE(PG8_SA(0, 1), a2 + hstep, voffA);
            PG8_WAIT_V(8); PG8_WAIT_L(0); PG8_BAR; PG8_MMA(0, 0, At, B0); PG8_MMA(0, 1, At, B1); PG8_BAR; PG8_SCHED;
            PG8_LDA(At, 1, 1); PG8_STAGE(PG8_SB(1, 0), b3, voffB); PG8_STAGE(PG8_SB(1, 1), b3 + hstep, voffB); PG8_STAGE(PG8_SA(1, 0), a3, voffA);
            PG8_WAIT_V(8); PG8_WAIT_L(0); PG8_BAR; PG8_MMA(1, 0, At, B0); PG8_MMA(1, 1, At, B1); PG8_BAR; PG8_SCHED;
            } else {
            PG8_LDB(B0, 0, 0); PG8_SCHED; PG8_LDA(At, 0, 0); PG8_STAGE(PG8_SA(1, 1), a1 + hstep, voffA);
            PG8_WAIT_L(8); PG8_BAR; PG8_WAIT_L(0); PG8_MMA(0, 0, At, B0); PG8_BAR; PG8_SCHED;
            PG8_LDB(B1, 0, 1); PG8_STAGE(PG8_SB(0, 0), b2, voffB);
            PG8_BAR; PG8_WAIT_L(0); PG8_MMA(0, 1, At, B1); PG8_BAR;
            PG8_LDA(At, 0, 1); PG8_STAGE(PG8_SA(0, 0), a2, voffA);
            PG8_BAR; PG8_WAIT_L(0); PG8_MMA(1, 0, At, B0); PG8_BAR; PG8_SCHED;
            PG8_STAGE(PG8_SB(0, 1), b2 + hstep, voffB);
            PG8_WAIT_V(6); PG8_BAR; PG8_MMA(1, 1, At, B1); PG8_BAR;
            PG8_LDB(B0, 1, 0); PG8_SCHED; PG8_LDA(At, 1, 0); PG8_STAGE(PG8_SA(0, 1), a2 + hstep, voffA);
            PG8_WAIT_L(8); PG8_BAR; PG8_WAIT_L(0); PG8_MMA(0, 0, At, B0); PG8_BAR; PG8_SCHED;
            PG8_LDB(B1, 1, 1); PG8_STAGE(PG8_SB(1, 0), b3, voffB);
            PG8_BAR; PG8_WAIT_L(0); PG8_MMA(0, 1, At, B1); PG8_BAR;
            PG8_LDA(At, 1, 1); PG8_STAGE(PG8_SA(1, 0), a3, voffA);
            PG8_BAR; PG8_WAIT_L(0); PG8_MMA(1, 0, At, B0); PG8_BAR; PG8_SCHED;
            PG8_STAGE(PG8_SB(1, 1), b3 + hstep, voffB);
            PG8_WAIT_V(6); PG8_BAR; PG8_MMA(1, 1, At, B1); PG8_BAR;
            }
        }
        if constexpr (ALIGN_EPI) { if (wr == 0) PG8_BAR; }
        if constexpr (!Epi::AFTER_DRAIN) { E(acc, cur, wr, wc, fr, fq); S.done(cur); }
        if (!has_next) break;
#pragma unroll
        for (int a = 0; a < 2; ++a)
#pragma unroll
            for (int b = 0; b < 2; ++b)
#pragma unroll
                for (int m = 0; m < 4; ++m)
#pragma unroll
                    for (int n = 0; n < 2; ++n) acc[a][b][m][n] = (f32x4){0.f, 0.f, 0.f, 0.f};
        cur = nxt; cA = nA; cB = nB; ++ui;
        if constexpr (ALIGN_EPI) { if (wr == 1) PG8_BAR; }
    }
    PG8_WAIT_V(0);
    if constexpr (!ALIGN_EPI) { if (wr == 0) PG8_BAR; }
    PG8_BAR;
    if constexpr (Epi::AFTER_DRAIN) { E.fused(acc, cur, wr, wc, fr, fq, lds, wid, lane); S.done(cur); }
#undef PG8_SA
#undef PG8_SB
#undef PG8_STAGE
#undef PG8_LDA
#undef PG8_LDB
#undef PG8_MMA
#undef PG8_WAIT_V
#undef PG8_WAIT_L
#undef PG8_BAR
#undef PG8_SCHED
}
}

#define LAS __attribute__((address_space(3)))
#define DI __device__ __forceinline__
typedef unsigned short bf16;
typedef unsigned v4u __attribute__((ext_vector_type(4)));
typedef unsigned v2u __attribute__((ext_vector_type(2)));
typedef float f32x4 __attribute__((ext_vector_type(4)));
typedef short bf16x8 __attribute__((ext_vector_type(8)));
typedef short s16x4 __attribute__((ext_vector_type(4)));

constexpr int NB = 16, SEQ = 2048, DM = 1024, MTOK = NB * SEQ, CTXL = 256, MCTX = NB * CTXL;
constexpr int PROJ_LD = 2560;
constexpr int PC_G = 0, PC_Q = 512, PC_K = 1024, PC_V = 1536, PC_R = 2048;
constexpr float EPSV = 1e-6f;
constexpr float QK_SCALE = 0.08838834764831845f;
constexpr int RT_CTX = 128, RT_W = 144, RT_WF = 154, RA_ROWS = 158 * 256;
constexpr int G1_MAIN = 1280, G1_FT = 512, G1_CTX = 64, G1_UNITS = G1_MAIN + G1_FT + G1_CTX;

constexpr size_t MiB = 1u << 20;
constexpr size_t WS_ADA = 1 * MiB;
constexpr size_t WS_ROPE = WS_ADA + 256 * 1024;
constexpr size_t WS_ROWSS = 396 * MiB;
constexpr size_t WS_RA = 2 * MiB;
constexpr size_t WS_MIX = WS_RA;
constexpr size_t WS_PROJ = 82 * MiB;
constexpr size_t WS_Y = WS_PROJ;
constexpr size_t WS_KVC = 242 * MiB;
constexpr size_t WS_ZT = 250 * MiB;
constexpr size_t WS_DT = 314 * MiB;
constexpr size_t WS_ST = 330 * MiB;
constexpr size_t WS_WOT = 394 * MiB;
constexpr size_t WS_END = 398 * MiB;
constexpr int LDS_BYTES = 147456, LDS_MISC = 139264;

struct Params {
    const float *x, *c, *ctx, *c_ctx, *w_ada, *b_ada, *g_pre, *g_post, *w_in, *w_fourier, *decay_logit, *gn_gain, *w_out;
    float* out; unsigned char* ws; int ph_lo, ph_hi, use_cg, pad;
};

DI unsigned f2bf(float f) { unsigned u = __builtin_bit_cast(unsigned, f); return (u + 0x7fffu + ((u >> 16) & 1u)) >> 16; }
DI unsigned pk2(float lo, float hi) { unsigned r; asm("v_cvt_pk_bf16_f32 %0, %1, %2" : "=v"(r) : "v"(lo), "v"(hi)); return r; }
DI float bflo(unsigned u) { return __builtin_bit_cast(float, u << 16); }
DI float bfhi(unsigned u) { return __builtin_bit_cast(float, u & 0xffff0000u); }
DI float silu_f(float v) { return v / (1.f + __expf(-v)); }
DI float wave_sum(float v) {
#pragma unroll
    for (int o = 1; o < 64; o <<= 1) v += __shfl_xor(v, o);
    return v;
}
DI unsigned offb(unsigned row, unsigned ch) { return 256u * row + 16u * (ch ^ (((row & 3) << 2) | ((row >> 2) & 3))); }
DI s16x4 tr_read(LAS unsigned char* p) { return __builtin_amdgcn_ds_read_tr16_b64_v4i16((LAS s16x4*)p); }
DI bf16x8 cat8(s16x4 a, s16x4 b) { bf16x8 r; r[0] = a[0]; r[1] = a[1]; r[2] = a[2]; r[3] = a[3]; r[4] = b[0]; r[5] = b[1]; r[6] = b[2]; r[7] = b[3]; return r; }
#define MFMA16(a, b, c) __builtin_amdgcn_mfma_f32_16x16x32_bf16((a), (b), (c), 0, 0, 0)

struct G1Order {
    int G, c;
    DI bool next(int i, pg8::Unit& u) const {
        const int L = i * G + c; if (L >= G1_UNITS) return false;
        if (L < G1_MAIN) {
            const int wgid = (L & 7) * (G1_MAIN / 8) + (L >> 3);
            const int r80 = wgid % 80;
            u.pm = (wgid / 80) * 8 + (r80 & 7); u.pn = RT_W + (r80 >> 3);
        } else if (L < G1_MAIN + G1_FT) {
            const int l2 = L - G1_MAIN, idx = (l2 & 7) * (G1_FT / 8) + (l2 >> 3);
            u.pm = RT_WF + (idx & 3); u.pn = idx >> 2;
        } else {
            const int l2 = L - G1_MAIN - G1_FT;
            u.pm = RT_CTX + (l2 >> 2); u.pn = RT_W + 4 + (l2 & 3);
        }
        return true;
    }
    DI void a_ready(const pg8::Unit&) const {}
    DI void done(const pg8::Unit&) const {}
};

DI v4u pack8(f32x4 a, f32x4 b) { v4u w; w.x = pk2(a[0], a[1]); w.y = pk2(a[2], a[3]); w.z = pk2(b[0], b[1]); w.w = pk2(b[2], b[3]); return w; }

struct EpiG1 {
    static constexpr bool PERM = true, AFTER_DRAIN = false;
    bf16* PROJ; bf16* ZT; bf16* KVC; const float* rope;
    DI void operator()(const f32x4 (&acc)[2][2][4][2], const pg8::Unit& u, int wr, int wc, int fr, int fq) const {
        const int rl0 = wr * 64 + fr, cl0 = wc * 32 + 8 * fq;
        bf16* base; int ld, mode = 0; float sc = 1.f;
        if (u.pm < RT_CTX) {
            const int wt = u.pn - RT_W, type = wt >> 1;
            base = PROJ + (size_t)(u.pm * 256) * PROJ_LD + wt * 256; ld = PROJ_LD;
            mode = (type == 1 || type == 2) ? 1 : (type == 3 ? 0 : 2); sc = (type == 1) ? QK_SCALE : 1.f;
        } else if (u.pm >= RT_WF) {
            base = ZT + ((size_t)(u.pn >> 3) * 1024 + (u.pm - RT_WF) * 256) * SEQ + (u.pn & 7) * 256; ld = SEQ;
        } else {
            base = KVC + (size_t)((u.pm - RT_CTX) * 256) * 1024 + (u.pn - RT_W - 4) * 256; ld = 1024;
        }
        base += (size_t)rl0 * ld + cl0;
        const int lbase = (u.pm * 256 + rl0) & (SEQ - 1);
        const float* rbase = rope + (16 * (wc & 1) + 4 * fq) * 2;
#pragma unroll
        for (int ai = 0; ai < 2; ++ai)
#pragma unroll
            for (int m = 0; m < 4; ++m) {
                bf16* rowp = base + (size_t)(ai * 128 + m * 16) * ld;
                f32x4 v00 = acc[ai][0][m][0], v01 = acc[ai][0][m][1], v10 = acc[ai][1][m][0], v11 = acc[ai][1][m][1];
                if (mode == 1) {
                    const int l = lbase + ai * 128 + m * 16;
                    const int pos = (wc >> 1) ? (l & 63) : (l >> 6);
                    const f32x4 r0 = *(const f32x4*)(rbase + pos * 64), r1 = *(const f32x4*)(rbase + pos * 64 + 4);
                    f32x4 t;
                    t = v00 * sc; v00[0] = t[0] * r0[0] - t[1] * r0[1]; v00[1] = t[0] * r0[1] + t[1] * r0[0]; v00[2] = t[2] * r0[2] - t[3] * r0[3]; v00[3] = t[2] * r0[3] + t[3] * r0[2];
                    t = v01 * sc; v01[0] = t[0] * r1[0] - t[1] * r1[1]; v01[1] = t[0] * r1[1] + t[1] * r1[0]; v01[2] = t[2] * r1[2] - t[3] * r1[3]; v01[3] = t[2] * r1[3] + t[3] * r1[2];
                    t = v10 * sc; v10[0] = t[0] * r0[0] - t[1] * r0[1]; v10[1] = t[0] * r0[1] + t[1] * r0[0]; v10[2] = t[2] * r0[2] - t[3] * r0[3]; v10[3] = t[2] * r0[3] + t[3] * r0[2];
                    t = v11 * sc; v11[0] = t[0] * r1[0] - t[1] * r1[1]; v11[1] = t[0] * r1[1] + t[1] * r1[0]; v11[2] = t[2] * r1[2] - t[3] * r1[3]; v11[3] = t[2] * r1[3] + t[3] * r1[2];
                } else if (mode == 2) {
#pragma unroll
                    for (int j = 0; j < 4; ++j) { v00[j] = silu_f(v00[j]); v01[j] = silu_f(v01[j]); v10[j] = silu_f(v10[j]); v11[j] = silu_f(v11[j]); }
                }
                *(v4u*)(rowp) = pack8(v00, v01);
                *(v4u*)(rowp + 128) = pack8(v10, v11);
                asm volatile("" ::: "memory");
            }
    }
};

struct EpiDft {
    static constexpr bool PERM = true, AFTER_DRAIN = false;
    const bf16* PROJ; bf16* MIX;
    DI void operator()(const f32x4 (&acc)[2][2][4][2], const pg8::Unit& u, int wr, int wc, int fr, int fq) const {
        const int rl0 = wr * 64 + fr, cl0 = wc * 32 + 8 * fq;
        const int b = u.pn >> 1, chg0 = (u.pn & 1) * 256 + cl0;
#pragma unroll
        for (int ai = 0; ai < 2; ++ai)
#pragma unroll
            for (int m = 0; m < 4; ++m) {
                const size_t tok = (size_t)b * SEQ + u.pm * 256 + rl0 + ai * 128 + m * 16;
#pragma unroll
                for (int bj = 0; bj < 2; ++bj) {
                    const v4u g = *(const v4u*)(PROJ + tok * PROJ_LD + PC_G + chg0 + bj * 128);
                    f32x4 v0 = acc[ai][bj][m][0], v1 = acc[ai][bj][m][1];
                    v0[0] *= bflo(g.x); v0[1] *= bfhi(g.x); v0[2] *= bflo(g.y); v0[3] *= bfhi(g.y);
                    v1[0] *= bflo(g.z); v1[1] *= bfhi(g.z); v1[2] *= bflo(g.w); v1[3] *= bfhi(g.w);
                    *(v4u*)(MIX + tok * 1024 + chg0 + bj * 128) = pack8(v0, v1);
                }
            }
    }
};

struct EpiOut {
    static constexpr bool PERM = true, AFTER_DRAIN = false;
    bf16* Y; float* rowss;
    DI void operator()(const f32x4 (&acc)[2][2][4][2], const pg8::Unit& u, int wr, int wc, int fr, int fq) const {
        const int rl0 = wr * 64 + fr, cl0 = u.pn * 256 + wc * 32 + 8 * fq;
#pragma unroll
        for (int ai = 0; ai < 2; ++ai)
#pragma unroll
            for (int m = 0; m < 4; ++m) {
                const int row = u.pm * 256 + rl0 + ai * 128 + m * 16;
                float ss = 0.f;
#pragma unroll
                for (int bj = 0; bj < 2; ++bj) {
                    const f32x4 v0 = acc[ai][bj][m][0], v1 = acc[ai][bj][m][1];
                    ss += (v0[0] * v0[0] + v0[1] * v0[1]) + (v0[2] * v0[2] + v0[3] * v0[3]) + (v1[0] * v1[0] + v1[1] * v1[1]) + (v1[2] * v1[2] + v1[3] * v1[3]);
                    *(v4u*)(Y + (size_t)row * 1024 + cl0 + bj * 128) = pack8(v0, v1);
                }
                ss += __shfl_xor(ss, 16); ss += __shfl_xor(ss, 32);
                if (fq == 0) rowss[(size_t)row * 16 + u.pn * 4 + wc] = ss;
            }
    }
};

DI int w1_srccol(int n) {
    const int t = n >> 9; int src = 512 + n;
    if (t == 1 || t == 2) { const int p = n & 127, hs = p >> 6, w = p & 63; src = 512 + (n & ~127) + hs * 64 + (w & 1) * 32 + (w >> 1); }
    return src;
}
template <bool MAIN>
DI void transpose_item(const float* W, int N, bf16* WT, int item, LAS float* scr, int lane) {
    const int nblk = MAIN ? 80 : 32, kb = item / nblk, nb = item % nblk, k0 = 64 * kb, n0 = 32 * nb;
    const int nl = lane & 31, sc = MAIN ? w1_srccol(n0 + nl) : (n0 + nl);
#pragma unroll 8
    for (int i = 0; i < 32; ++i) { const int kk = 2 * i + (lane >> 5); scr[kk * 33 + nl] = W[(size_t)(k0 + kk) * N + sc]; }
    asm volatile("s_waitcnt lgkmcnt(0)" ::: "memory");
    const int c = lane & 7;
#pragma unroll
    for (int j = 0; j < 4; ++j) { const int n = (lane >> 3) + 8 * j; const LAS float* s = scr + (8 * c) * 33 + n;
        v4u o; o.x = pk2(s[0 * 33], s[1 * 33]); o.y = pk2(s[2 * 33], s[3 * 33]); o.z = pk2(s[4 * 33], s[5 * 33]); o.w = pk2(s[6 * 33], s[7 * 33]);
        *(v4u*)(WT + (size_t)(n0 + n) * 1024 + k0 + 8 * c) = o; }
    asm volatile("s_waitcnt lgkmcnt(0)" ::: "memory");
}

DI void phase0(const Params& p, LAS unsigned char* lds, int tid, int lane, int wave) {
    float* ADA = (float*)(p.ws + WS_ADA); float* rope = (float*)(p.ws + WS_ROPE);
    bf16* RA = (bf16*)(p.ws + WS_RA); bf16* WOT = (bf16*)(p.ws + WS_WOT);
    bf16* W1T = RA + (size_t)RT_W * 256 * 1024; bf16* WFT = RA + (size_t)RT_WF * 256 * 1024;
    LAS float* sl = (LAS float*)lds; LAS float* red = sl + 17 * 1024;
    for (int i = tid; i < 17 * 1024; i += 512) { const int v = i >> 10, k = i & 1023; const float cv = (v < 16) ? p.c[v * 1024 + k] : p.c_ctx[k]; sl[i] = cv / (1.f + expf(-cv)); }
    __syncthreads();
    for (int vw = blockIdx.x; vw < 256; vw += gridDim.x) {
        const int j0 = 12 * vw, col = tid & 15, ks = tid >> 4;
        float acc[17];
#pragma unroll
        for (int v = 0; v < 17; ++v) acc[v] = 0.f;
        if (col < 12) {
            for (int kk = 0; kk < 32; ++kk) { const int k = ks * 32 + kk; const float wv = p.w_ada[(size_t)k * 3072 + j0 + col];
#pragma unroll
                for (int v = 0; v < 17; ++v) acc[v] += sl[v * 1024 + k] * wv; }
#pragma unroll
            for (int v = 0; v < 17; ++v) red[(ks * 17 + v) * 12 + col] = acc[v];
        }
        __syncthreads();
        if (tid < 204) { const int v = tid / 12, cc = tid % 12; float s = p.b_ada[j0 + cc];
            for (int k2 = 0; k2 < 32; ++k2) s += red[(k2 * 17 + v) * 12 + cc];
            ADA[v * 3072 + j0 + cc] = s; }
        __syncthreads();
    }
    {
        LAS float* scr = (LAS float*)(lds + wave * 8448);
        const int gw = blockIdx.x * 8 + wave, NGW = gridDim.x * 8;
        for (int it = gw; it < 1280 + 512; it += NGW) {
            if (it < 1280) transpose_item<true>(p.w_in, 3072, W1T, it, scr, lane);
            else transpose_item<false>(p.w_out, 1024, WOT, it - 1280, scr, lane);
        }
    }
    __syncthreads();
    {
        LAS float* ct = (LAS float*)lds; LAS float* st = ct + 128; LAS float* Tl = st + 128;
        if (tid < 128) { float s, c; sincospif((float)tid * (1.f / 64.f), &s, &c); ct[tid] = c; st[tid] = s; }
        __syncthreads();
        for (int vw = blockIdx.x; vw < 256; vw += gridDim.x) {
            const int g = vw >> 6, d0 = (vw & 63) * 2;
            { const int pq = tid >> 8, dd = (tid >> 7) & 1, c = tid & 127; float a = 0.f;
              for (int j = 0; j < 128; ++j) { const int idx = (j * c) & 127; a += (pq ? st[idx] : ct[idx]) * p.w_fourier[(size_t)(g * 128 + j) * 128 + d0 + dd]; }
              Tl[(dd * 2 + pq) * 128 + c] = a * (1.f / 512.f); }
            __syncthreads();
#pragma unroll 1
            for (int kq = tid; kq < 1024; kq += 512) {
                float a0 = 0.f, a1 = 0.f, a2 = 0.f, a3 = 0.f;
                const f32x4* wp = (const f32x4*)(p.w_in + (size_t)kq * 3072 + g * 128);
                for (int c4 = 0; c4 < 32; ++c4) { const f32x4 wv = wp[c4];
#pragma unroll
                    for (int e = 0; e < 4; ++e) { const int c = c4 * 4 + e; a0 += wv[e] * Tl[c]; a1 += wv[e] * Tl[128 + c]; a2 += wv[e] * Tl[256 + c]; a3 += wv[e] * Tl[384 + c]; } }
                bf16* o = WFT + (size_t)((g * 128 + d0) * 2) * 1024 + kq;
                o[0] = (bf16)f2bf(a0); o[1024] = (bf16)f2bf(a1); o[2048] = (bf16)f2bf(a2); o[3072] = (bf16)f2bf(a3);
            }
            __syncthreads();
        }
    }
    for (int vw = blockIdx.x; vw < 256; vw += gridDim.x) {
        if (vw < 4) { const int idx = vw * 512 + tid, pos = idx >> 5, i = idx & 31; const float inv = powf(10000.f, -(float)i * (1.f / 32.f)); const float ang = (float)pos * inv;
            rope[idx * 2] = cosf(ang); rope[idx * 2 + 1] = sinf(ang); }
    }
}

DI void phase1(const Params& p, int lane, int wave) {
    const float* ADA = (const float*)(p.ws + WS_ADA); bf16* RA = (bf16*)(p.ws + WS_RA);
    const int gw = blockIdx.x * 8 + wave, NGW = gridDim.x * 8, NR = MTOK + MCTX, rpw = (NR + NGW - 1) / NGW;
    int r0 = gw * rpw, r1 = r0 + rpw; if (r1 > NR) r1 = NR;
    int vcur = -1; f32x4 gs[4], sh[4];
    for (int r = r0; r < r1; ++r) {
        const int v = (r < MTOK) ? (r >> 11) : 16;
        if (v != vcur) { vcur = v;
#pragma unroll
            for (int j = 0; j < 4; ++j) { const int col = lane * 4 + 256 * j; const f32x4 g = *(const f32x4*)(p.g_pre + col), sc = *(const f32x4*)(ADA + v * 3072 + 1024 + col);
                gs[j] = g * (sc + 1.f); sh[j] = *(const f32x4*)(ADA + v * 3072 + col); } }
        const float* xr = (r < MTOK) ? p.x + (size_t)r * 1024 : p.ctx + (size_t)(r - MTOK) * 1024;
        f32x4 xv[4]; float s = 0.f;
#pragma unroll
        for (int j = 0; j < 4; ++j) { xv[j] = *(const f32x4*)(xr + lane * 4 + 256 * j); s += (xv[j][0] * xv[j][0] + xv[j][1] * xv[j][1]) + (xv[j][2] * xv[j][2] + xv[j][3] * xv[j][3]); }
        const float rstd = rsqrtf(wave_sum(s) * (1.f / 1024.f) + EPSV);
        bf16* o = RA + (size_t)r * 1024;
#pragma unroll
        for (int j = 0; j < 4; ++j) { const f32x4 hv = xv[j] * rstd * gs[j] + sh[j]; v2u w; w.x = pk2(hv[0], hv[1]); w.y = pk2(hv[2], hv[3]); *(v2u*)(o + lane * 4 + 256 * j) = w; }
    }
}

DI void state_unit(const Params& p, LAS unsigned char* lds, int unit, int tid, int lane, int wave) {
    const bf16* PROJ = (const bf16*)(p.ws + WS_PROJ); const bf16* KVC = (const bf16*)(p.ws + WS_KVC); bf16* ST = (bf16*)(p.ws + WS_ST);
    const int eh = unit & 1, dir = (unit >> 1) & 1, h = (unit >> 2) & 3, b = unit >> 4;
    const int fr = lane & 15, fq = lane >> 4, q4 = fr >> 2, pp = fr & 3;
    const int et = wave & 3, dtb = (wave >> 2) * 4, cb = 4 * eh + et;
    const float lg = p.decay_logit[dir * 4 + h]; const float l2 = -log1pf(expf(-lg)) * 1.4426950408889634f;
    const float cdec = exp2f(128.f * l2);
    LAS unsigned char* Kimg = lds; LAS unsigned char* Vimg = lds + 32768;
    f32x4 acc[4];
#pragma unroll
    for (int i = 0; i < 4; ++i) acc[i] = (f32x4){0.f, 0.f, 0.f, 0.f};
    v4u kr[4], vr[2];
#define ST_LOAD(s) do { const bf16* Kp; int ld; \
        if ((s) < 2) { const int cc = dir ? 1 - (s) : (s); Kp = KVC + (size_t)(b * 256 + cc * 128) * 1024 + h * 128; ld = 1024; } \
        else { const int c = dir ? 17 - (s) : (s) - 2; Kp = PROJ + (size_t)(b * SEQ + c * 128) * PROJ_LD + PC_K + h * 128; ld = PROJ_LD; } \
        _Pragma("unroll") for (int i = 0; i < 4; ++i) { const int id = tid + 512 * i; kr[i] = *(const v4u*)(Kp + (size_t)(id >> 4) * ld + (id & 15) * 8); } \
        _Pragma("unroll") for (int i = 0; i < 2; ++i) { const int id = tid + 512 * i; vr[i] = *(const v4u*)(Kp + 512 + (size_t)(id >> 3) * ld + (8 * eh + (id & 7)) * 8); } } while (0)
    ST_LOAD(0);
#pragma unroll 1
    for (int s = 0; s < 18; ++s) {
        if (s < 17) {
            if (s) __syncthreads();
#pragma unroll
            for (int i = 0; i < 4; ++i) { const int id = tid + 512 * i; *(LAS v4u*)(Kimg + offb(id >> 4, id & 15)) = kr[i]; }
#pragma unroll
            for (int i = 0; i < 2; ++i) { const int id = tid + 512 * i, m = id >> 3; const float wgt = exp2f((float)(dir ? m : 127 - m) * l2);
                v4u o; o.x = pk2(bflo(vr[i].x) * wgt, bfhi(vr[i].x) * wgt); o.y = pk2(bflo(vr[i].y) * wgt, bfhi(vr[i].y) * wgt);
                o.z = pk2(bflo(vr[i].z) * wgt, bfhi(vr[i].z) * wgt); o.w = pk2(bflo(vr[i].w) * wgt, bfhi(vr[i].w) * wgt);
                *(LAS v4u*)(Vimg + offb(m, 8 * eh + (id & 7))) = o; }
            __syncthreads();
            if (s + 1 < 17) ST_LOAD(s + 1);
        }
        if (s >= 2) {
            const int c = dir ? 17 - s : s - 2;
            bf16* so = ST + ((size_t)(((b * 4 + h) * 16 + c) * 2 + dir)) * 16384 + (size_t)(64 * eh + 16 * et + fr) * 128;
#pragma unroll
            for (int i = 0; i < 4; ++i) { v2u w; w.x = pk2(acc[i][0], acc[i][1]); w.y = pk2(acc[i][2], acc[i][3]); *(v2u*)(so + 16 * (dtb + i) + 4 * fq) = w; }
        }
        if (s < 17) {
#pragma unroll
            for (int i = 0; i < 4; ++i) acc[i] = acc[i] * cdec;
#pragma unroll
            for (int ks = 0; ks < 4; ++ks) {
                const unsigned r0 = 32 * ks + 8 * fq + q4;
                const bf16x8 vb = cat8(tr_read(Vimg + offb(r0, 2 * cb + (pp >> 1)) + 8 * (pp & 1)), tr_read(Vimg + offb(r0 + 4, 2 * cb + (pp >> 1)) + 8 * (pp & 1)));
#pragma unroll
                for (int i = 0; i < 4; ++i) { const int dt = dtb + i;
                    const bf16x8 ka = cat8(tr_read(Kimg + offb(r0, 2 * dt + (pp >> 1)) + 8 * (pp & 1)), tr_read(Kimg + offb(r0 + 4, 2 * dt + (pp >> 1)) + 8 * (pp & 1)));
                    acc[i] = MFMA16(ka, vb, acc[i]); }
            }
        }
    }
#undef ST_LOAD
}

DI void ret_unit(const Params& p, LAS unsigned char* lds, int unit, int tid, int lane, int wave) {
    const bf16* PROJ = (const bf16*)(p.ws + WS_PROJ); const bf16* ST = (const bf16*)(p.ws + WS_ST); bf16* MIX = (bf16*)(p.ws + WS_MIX);
    const int c = unit & 15, h = (unit >> 4) & 3, b = unit >> 6;
    const int fr = lane & 15, fq = lane >> 4, q4 = fr >> 2, pp = fr & 3;
    const size_t tok0 = (size_t)b * SEQ + c * 128;
    const float l2f = -log1pf(expf(-p.decay_logit[h])) * 1.4426950408889634f, l2b = -log1pf(expf(-p.decay_logit[4 + h])) * 1.4426950408889634f;
    LAS unsigned char* Kimg = lds; LAS unsigned char* Vimg = lds + 32768; LAS unsigned char* Simg = lds + 65536; LAS unsigned char* Ost = lds + 98304 + wave * 4352;
    const bf16* Kp = PROJ + tok0 * PROJ_LD + PC_K + h * 128; const bf16* Vp = PROJ + tok0 * PROJ_LD + PC_V + h * 128;
    const bf16* Sf = ST + ((size_t)(((b * 4 + h) * 16 + c) * 2)) * 16384; const bf16* Sb = Sf + 16384;
    v4u kr[4], vr[4], sr[4], sbr[4]; bf16x8 qf[4];
#pragma unroll
    for (int i = 0; i < 4; ++i) { const int id = tid + 512 * i, row = id >> 4, ch = id & 15;
        kr[i] = *(const v4u*)(Kp + (size_t)row * PROJ_LD + ch * 8); vr[i] = *(const v4u*)(Vp + (size_t)row * PROJ_LD + ch * 8);
        sr[i] = *(const v4u*)(Sf + row * 128 + ch * 8); sbr[i] = *(const v4u*)(Sb + row * 128 + ch * 8); }
    { const bf16* Qp = PROJ + (tok0 + 16 * wave + fr) * PROJ_LD + PC_Q + h * 128 + 8 * fq;
#pragma unroll
      for (int ks = 0; ks < 4; ++ks) qf[ks] = *(const bf16x8*)(Qp + 32 * ks); }
    __syncthreads();
#pragma unroll
    for (int i = 0; i < 4; ++i) { const int id = tid + 512 * i; const unsigned o = offb(id >> 4, id & 15);
        *(LAS v4u*)(Kimg + o) = kr[i]; *(LAS v4u*)(Vimg + o) = vr[i]; *(LAS v4u*)(Simg + o) = sr[i]; }
    __syncthreads();
    const int nl = 16 * wave + fr;
    const float sf = exp2f((float)(nl + 1) * l2f), sbv = exp2f((float)(128 - nl) * l2b);
    f32x4 O[8];
#pragma unroll
    for (int et = 0; et < 8; ++et) { f32x4 a = (f32x4){0.f, 0.f, 0.f, 0.f};
#pragma unroll
        for (int ks = 0; ks < 4; ++ks) a = MFMA16(*(const LAS bf16x8*)(Simg + offb(16 * et + fr, 4 * ks + fq)), qf[ks], a);
        O[et] = a * sf; }
    bf16x8 pf[4];
#pragma unroll
    for (int k2 = 0; k2 < 4; ++k2) {
        v4u pw;
#pragma unroll
        for (int hf = 0; hf < 2; ++hf) { const int mt = 2 * k2 + hf; f32x4 sacc = (f32x4){0.f, 0.f, 0.f, 0.f};
#pragma unroll
            for (int ks = 0; ks < 4; ++ks) sacc = MFMA16(*(const LAS bf16x8*)(Kimg + offb(16 * mt + fr, 4 * ks + fq)), qf[ks], sacc);
#pragma unroll
            for (int j = 0; j < 4; ++j) { const int df = nl - (16 * mt + 4 * fq + j); sacc[j] *= (df >= 0) ? exp2f((float)df * l2f) : exp2f((float)(-df) * l2b); }
            if (hf == 0) { pw.x = pk2(sacc[0], sacc[1]); pw.y = pk2(sacc[2], sacc[3]); } else { pw.z = pk2(sacc[0], sacc[1]); pw.w = pk2(sacc[2], sacc[3]); } }
        pf[k2] = __builtin_bit_cast(bf16x8, pw);
    }
#pragma unroll
    for (int et = 0; et < 8; ++et)
#pragma unroll
        for (int ks = 0; ks < 4; ++ks) { const unsigned r0 = 32 * ks + 4 * fq + q4;
            const bf16x8 va = cat8(tr_read(Vimg + offb(r0, 2 * et + (pp >> 1)) + 8 * (pp & 1)), tr_read(Vimg + offb(r0 + 16, 2 * et + (pp >> 1)) + 8 * (pp & 1)));
            O[et] = MFMA16(va, pf[ks], O[et]); }
    __syncthreads();
#pragma unroll
    for (int i = 0; i < 4; ++i) { const int id = tid + 512 * i; *(LAS v4u*)(Simg + offb(id >> 4, id & 15)) = sbr[i]; }
    __syncthreads();
#pragma unroll
    for (int et = 0; et < 8; ++et) { f32x4 a = (f32x4){0.f, 0.f, 0.f, 0.f};
#pragma unroll
        for (int ks = 0; ks < 4; ++ks) a = MFMA16(*(const LAS bf16x8*)(Simg + offb(16 * et + fr, 4 * ks + fq)), qf[ks], a);
        O[et] = O[et] + a * sbv; }
    float s1 = 0.f;
#pragma unroll
    for (int et = 0; et < 8; ++et) s1 += (O[et][0] + O[et][1]) + (O[et][2] + O[et][3]);
    s1 += __shfl_xor(s1, 16); s1 += __shfl_xor(s1, 32);
    const float mu = s1 * (1.f / 128.f); float s2 = 0.f;
#pragma unroll
    for (int et = 0; et < 8; ++et) { O[et] = O[et] - mu; s2 += (O[et][0] * O[et][0] + O[et][1] * O[et][1]) + (O[et][2] * O[et][2] + O[et][3] * O[et][3]); }
    s2 += __shfl_xor(s2, 16); s2 += __shfl_xor(s2, 32);
    const float rstd = rsqrtf(s2 * (1.f / 128.f) + EPSV);
#pragma unroll
    for (int et = 0; et < 8; ++et) { v2u w; w.x = pk2(O[et][0] * rstd, O[et][1] * rstd); w.y = pk2(O[et][2] * rstd, O[et][3] * rstd); *(LAS v2u*)(Ost + fr * 272 + (16 * et + 4 * fq) * 2) = w; }
    asm volatile("s_waitcnt lgkmcnt(0)" ::: "memory");
#pragma unroll
    for (int i = 0; i < 4; ++i) { const int id = lane + 64 * i, row = id >> 4, ch = id & 15;
        const v4u on = *(const LAS v4u*)(Ost + row * 272 + ch * 16);
        const size_t tok = tok0 + 16 * wave + row;
        const v4u g = *(const v4u*)(PROJ + tok * PROJ_LD + PC_R + h * 128 + ch * 8);
        const f32x4 g0 = *(const f32x4*)(p.gn_gain + h * 128 + ch * 8), g1 = *(const f32x4*)(p.gn_gain + h * 128 + ch * 8 + 4);
        v4u o;
        o.x = pk2(bflo(on.x) * g0[0] * bflo(g.x), bfhi(on.x) * g0[1] * bfhi(g.x)); o.y = pk2(bflo(on.y) * g0[2] * bflo(g.y), bfhi(on.y) * g0[3] * bfhi(g.y));
        o.z = pk2(bflo(on.z) * g1[0] * bflo(g.z), bfhi(on.z) * g1[1] * bfhi(g.z)); o.w = pk2(bflo(on.w) * g1[2] * bflo(g.w), bfhi(on.w) * g1[3] * bfhi(g.w));
        *(v4u*)(MIX + tok * 1024 + 512 + h * 128 + ch * 8) = o; }
}

constexpr int FFT_IN = 0, FFT_STG = 65536, FFT_A2 = 98304, FFT_CT = 114688;
DI void fft_setup(LAS unsigned char* lds, int tid, int lane, bf16x8 (&m1)[2][4]) {
    LAS float* ct = (LAS float*)(lds + FFT_CT);
    for (int i = tid; i < 2048; i += 512) ct[i] = cospif((float)i * (1.f / 1024.f));
    __syncthreads();
    const int fr = lane & 15, fq = lane >> 4;
#pragma unroll
    for (int pq = 0; pq < 2; ++pq)
#pragma unroll
        for (int c4 = 0; c4 < 4; ++c4) { const int ri = c4 >> 1, k1 = 16 * (c4 & 1) + fr; float v[8];
#pragma unroll
            for (int i = 0; i < 8; ++i) { const int l1 = 8 * fq + i, idx = ((k1 * l1) & 31) * 64; const float C = ct[idx], S = ct[(idx - 512) & 2047];
                v[i] = (pq == 0 && ri == 0) ? C : ((pq == 1 && ri == 1) ? -C : -S); }
            v4u w; w.x = pk2(v[0], v[1]); w.y = pk2(v[2], v[3]); w.z = pk2(v[4], v[5]); w.w = pk2(v[6], v[7]); m1[pq][c4] = __builtin_bit_cast(bf16x8, w); }
    for (int e = tid; e < 1024; e += 512) { const int ln = e & 63, fr2 = ln & 15, fq2 = ln >> 4, ks2 = (e >> 6) & 3, mt = e >> 8, ri = ks2 >> 1, base = 32 * (ks2 & 1), k2 = 16 * mt + fr2; float v[8];
#pragma unroll
        for (int i = 0; i < 8; ++i) { const int l2 = base + ((i < 4) ? 4 * fq2 + i : 16 + 4 * fq2 + (i - 4)), idx = ((k2 * l2) & 63) * 32; v[i] = ri ? ct[(idx - 512) & 2047] : ct[idx]; }
        v4u w; w.x = pk2(v[0], v[1]); w.y = pk2(v[2], v[3]); w.z = pk2(v[4], v[5]); w.w = pk2(v[6], v[7]); *(LAS v4u*)(lds + FFT_A2 + e * 16) = w; }
    __syncthreads();
}
DI void fft_unit(const Params& p, LAS unsigned char* lds, int unit, int tid, int lane, int wave, const bf16x8 (&m1)[2][4]) {
    const bf16* PROJ = (const bf16*)(p.ws + WS_PROJ); const bf16* ZT = (const bf16*)(p.ws + WS_ZT); bf16* MIX = (bf16*)(p.ws + WS_MIX);
    const int s8 = unit & 15, g = (unit >> 4) & 3, b = unit >> 6;
    const int fr = lane & 15, fq = lane >> 4, q4 = fr >> 2, pp = fr & 3;
    const bf16* src = ZT + ((size_t)b * 1024 + (g * 128 + 8 * s8) * 2) * SEQ;
    v4u ld[8];
#pragma unroll
    for (int i = 0; i < 8; ++i) ld[i] = *(const v4u*)(src + (size_t)(tid + 512 * i) * 8);
    __syncthreads();
#pragma unroll
    for (int i = 0; i < 8; ++i) *(LAS v4u*)(lds + FFT_IN + (tid + 512 * i) * 16) = ld[i];
    __syncthreads();
    LAS unsigned char* img = lds + FFT_IN + wave * 8192;
    const LAS float* ct = (const LAS float*)(lds + FFT_CT);
    f32x4 D1[4][4];
#pragma unroll
    for (int rt = 0; rt < 4; ++rt) {
        LAS unsigned char* a0 = img + (8 * fq + q4) * 128 + (16 * rt + 4 * pp) * 2;
        const bf16x8 ap = cat8(tr_read(a0), tr_read(a0 + 512)), aq = cat8(tr_read(a0 + 4096), tr_read(a0 + 4096 + 512));
#pragma unroll
        for (int c4 = 0; c4 < 4; ++c4) { f32x4 d = (f32x4){0.f, 0.f, 0.f, 0.f}; d = MFMA16(ap, m1[0][c4], d); d = MFMA16(aq, m1[1][c4], d); D1[rt][c4] = d; }
    }
    bf16x8 b2[4][2];
#pragma unroll
    for (int kt = 0; kt < 2; ++kt)
#pragma unroll
        for (int hf = 0; hf < 2; ++hf) { v4u wre, wim;
#pragma unroll
            for (int hh = 0; hh < 2; ++hh) { const int rt = 2 * hf + hh; float re[4], im[4];
#pragma unroll
                for (int j = 0; j < 4; ++j) { const int idx = (16 * kt + fr) * (16 * rt + 4 * fq + j); const float c = ct[idx], sn = ct[(idx - 512) & 2047];
                    const float tr = D1[rt][kt][j], ti = D1[rt][2 + kt][j]; re[j] = tr * c + ti * sn; im[j] = ti * c - tr * sn; }
                if (hh == 0) { wre.x = pk2(re[0], re[1]); wre.y = pk2(re[2], re[3]); wim.x = pk2(im[0], im[1]); wim.y = pk2(im[2], im[3]); }
                else { wre.z = pk2(re[0], re[1]); wre.w = pk2(re[2], re[3]); wim.z = pk2(im[0], im[1]); wim.w = pk2(im[2], im[3]); } }
            b2[hf][kt] = __builtin_bit_cast(bf16x8, wre); b2[2 + hf][kt] = __builtin_bit_cast(bf16x8, wim); }
    LAS unsigned char* stg = lds + FFT_STG;
#pragma unroll
    for (int mt = 0; mt < 4; ++mt) {
        bf16x8 a2[4];
#pragma unroll
        for (int ks2 = 0; ks2 < 4; ++ks2) a2[ks2] = *(const LAS bf16x8*)(lds + FFT_A2 + ((mt * 4 + ks2) * 64 + lane) * 16);
#pragma unroll
        for (int kt = 0; kt < 2; ++kt) { f32x4 d = (f32x4){0.f, 0.f, 0.f, 0.f};
#pragma unroll
            for (int ks2 = 0; ks2 < 4; ++ks2) d = MFMA16(a2[ks2], b2[ks2][kt], d);
#pragma unroll
            for (int j = 0; j < 4; ++j) { const int k = (16 * kt + fr) + 32 * (16 * mt + 4 * fq + j); *(LAS unsigned short*)(stg + k * 16 + wave * 2) = (unsigned short)f2bf(d[j]); } }
    }
    __syncthreads();
#pragma unroll
    for (int i = 0; i < 4; ++i) { const int k = tid + 512 * i; const size_t tok = (size_t)b * SEQ + k;
        const v4u y = *(const LAS v4u*)(stg + k * 16); const v4u gt = *(const v4u*)(PROJ + tok * PROJ_LD + PC_G + g * 128 + 8 * s8);
        v4u o; o.x = pk2(bflo(y.x) * bflo(gt.x), bfhi(y.x) * bfhi(gt.x)); o.y = pk2(bflo(y.y) * bflo(gt.y), bfhi(y.y) * bfhi(gt.y));
        o.z = pk2(bflo(y.z) * bflo(gt.z), bfhi(y.z) * bfhi(gt.z)); o.w = pk2(bflo(y.w) * bflo(gt.w), bfhi(y.w) * bfhi(gt.w));
        *(v4u*)(MIX + tok * 1024 + g * 128 + 8 * s8) = o; }
}

DI void phase6(const Params& p, int lane, int wave) {
    const float* ADA = (const float*)(p.ws + WS_ADA); const float* rowss = (const float*)(p.ws + WS_ROWSS); const bf16* Y = (const bf16*)(p.ws + WS_Y);
    const int gw = blockIdx.x * 8 + wave, NGW = gridDim.x * 8, rpw = (MTOK + NGW - 1) / NGW;
    int r0 = gw * rpw, r1 = r0 + rpw; if (r1 > MTOK) r1 = MTOK;
    int vcur = -1; f32x4 gg[4];
    for (int r = r0; r < r1; ++r) {
        const int v = r >> 11;
        if (v != vcur) { vcur = v;
#pragma unroll
            for (int j = 0; j < 4; ++j) { const int col = lane * 4 + 256 * j; gg[j] = *(const f32x4*)(p.g_post + col) * *(const f32x4*)(ADA + v * 3072 + 2048 + col); } }
        float ssum = (lane < 16) ? rowss[(size_t)r * 16 + lane] : 0.f;
#pragma unroll
        for (int o = 1; o < 16; o <<= 1) ssum += __shfl_xor(ssum, o);
        ssum = __shfl(ssum, 0);
        const float rstd = rsqrtf(ssum * (1.f / 1024.f) + EPSV);
#pragma unroll
        for (int j = 0; j < 4; ++j) { const int col = lane * 4 + 256 * j;
            const f32x4 xv = *(const f32x4*)(p.x + (size_t)r * 1024 + col); const v2u yv = *(const v2u*)(Y + (size_t)r * 1024 + col);
            f32x4 o; o[0] = xv[0] + gg[j][0] * (bflo(yv.x) * rstd); o[1] = xv[1] + gg[j][1] * (bfhi(yv.x) * rstd); o[2] = xv[2] + gg[j][2] * (bflo(yv.y) * rstd); o[3] = xv[3] + gg[j][3] * (bfhi(yv.y) * rstd);
            *(f32x4*)(p.out + (size_t)r * 1024 + col) = o; }
    }
}

#define XB_TMO      128
#define XB_XCNT(j)  (256  + 64 * (j))
#define XB_XSUB(j)  (1280 + 64 * (j))
#define XB_XGEN(j)  (2304 + 64 * (j))
#define XB_TOP      3328
#define XB_TOPGEN   3392
#define XCD_BAR_WORDS 3456
#define XB_SPIN_CAP (1u << 18)

__device__ __forceinline__ unsigned xb_ld(unsigned* p)              { return __hip_atomic_load(p, __ATOMIC_RELAXED, __HIP_MEMORY_SCOPE_AGENT); }
__device__ __forceinline__ unsigned xb_add(unsigned* p, unsigned v) { return __hip_atomic_fetch_add(p, v, __ATOMIC_RELAXED, __HIP_MEMORY_SCOPE_AGENT); }
__device__ __forceinline__ unsigned xb_xcc_id() { return (unsigned)__builtin_amdgcn_s_getreg((3 << 11) | 20) & 0xFu; }
#define XB_SPIN(cond, bar) do { unsigned _sp = 0; while (cond) { __builtin_amdgcn_s_sleep(1); \
    if ((++_sp & 255u) == 0u) { if (xb_ld(&(bar)[XB_TMO])) break; if (_sp > XB_SPIN_CAP) { atomicAdd(&(bar)[XB_TMO], 1u); break; } } } } while (0)

struct XcdBarrier {
    unsigned* bar; unsigned x;
    volatile LAS unsigned* st;
};

__device__ __forceinline__ XcdBarrier xcd_barrier_post(unsigned* bar, volatile LAS unsigned* st) {
    XcdBarrier b; b.bar = bar; b.x = xb_xcc_id(); b.st = st;
    if (threadIdx.x == 0) (void)xb_add(&bar[XB_XCNT(b.x)], 1u);
    return b;
}
__device__ __forceinline__ void xcd_barrier_complete(unsigned* bar, unsigned x, unsigned& nloc, unsigned& nx) {
    const unsigned G = gridDim.x * gridDim.y * gridDim.z;
    unsigned sum, cnt, mine, sp = 0u;
    for (;;) {
        sum = 0u; cnt = 0u; mine = 0u;
#pragma unroll
        for (unsigned j = 0; j < 16; ++j) { const unsigned c = xb_ld(&bar[XB_XCNT(j)]); sum += c; cnt += (c > 0u) ? 1u : 0u; mine = (j == x) ? c : mine; }
        if (sum == G) break;
        __builtin_amdgcn_s_sleep(1);
        if ((++sp & 255u) == 0u) { if (xb_ld(&bar[XB_TMO])) break; if (sp > XB_SPIN_CAP) { atomicAdd(&bar[XB_TMO], 1u); break; } }
    }
    nloc = mine > 0u ? mine : 1u; nx = cnt > 0u ? cnt : 1u;
}

__device__ __forceinline__ void xcd_barrier(const XcdBarrier& b) {
    asm volatile("s_waitcnt vmcnt(0)" ::: "memory");
    __syncthreads();
    if (threadIdx.x == 0) {
        unsigned* bar = b.bar;
        __builtin_amdgcn_s_waitcnt(0);
        unsigned nloc = b.st[0], nx = b.st[1];
        if (nloc == 0u) { xcd_barrier_complete(bar, b.x, nloc, nx); b.st[0] = nloc; b.st[1] = nx; }
        const unsigned old = xb_add(&bar[XB_XSUB(b.x)], 1u);
        const unsigned gen = old / nloc;
        if (old + 1u == (gen + 1u) * nloc) {
            __builtin_amdgcn_fence(__ATOMIC_RELEASE, "agent");
            asm volatile("s_waitcnt vmcnt(0)" ::: "memory");
            const unsigned og = xb_add(&bar[XB_TOP], 1u);
            const unsigned tg = og / nx;
            if (og + 1u == (tg + 1u) * nx) xb_add(&bar[XB_TOPGEN], 1u);
            else XB_SPIN(xb_ld(&bar[XB_TOPGEN]) == tg, bar);
            __builtin_amdgcn_fence(__ATOMIC_ACQUIRE, "agent");
            xb_add(&bar[XB_XGEN(b.x)], 1u);
            asm volatile("s_waitcnt vmcnt(0)" ::: "memory");
        } else {
            XB_SPIN(xb_ld(&bar[XB_XGEN(b.x)]) == gen, bar);
            __builtin_amdgcn_fence(__ATOMIC_ACQUIRE, "agent");
            asm volatile("s_waitcnt vmcnt(0)" ::: "memory");
        }
    }
    __syncthreads();
}


__global__ void __launch_bounds__(512, 2) hymba_fwd(Params p) {
    extern __shared__ __attribute__((aligned(16))) unsigned char lds_raw[];
    LAS unsigned char* lds = (LAS unsigned char*)lds_raw;
    cg::grid_group grid = cg::this_grid();
    const int tid = threadIdx.x, lane = tid & 63, wave = __builtin_amdgcn_readfirstlane(tid >> 6);
    const int lo = p.ph_lo, hi = p.ph_hi;
    volatile LAS unsigned* misc = (volatile LAS unsigned*)(lds + LDS_MISC);
    if (tid < 4) misc[tid] = 0u;
    __syncthreads();
    XcdBarrier bar = xcd_barrier_post((unsigned*)p.ws, misc);
#define IN(k) (lo <= (k) && (k) < hi)
#ifndef REP2
#define REP2 1
#endif
#ifndef REP3
#define REP3 1
#endif
#ifndef REP4
#define REP4 1
#endif
#define SEAM(k) do { if (IN(k) && IN((k) + 1)) { if (p.use_cg) grid.sync(); else xcd_barrier(bar); } } while (0)
    bf16* RA = (bf16*)(p.ws + WS_RA);
    if (IN(0)) phase0(p, lds, tid, lane, wave);
#if defined(REP0)
    __syncthreads(); if (IN(0)) phase0(p, lds, tid, lane, wave);
#endif
    SEAM(0);
    if (IN(1)) phase1(p, lane, wave);
#if defined(REP1)
    if (IN(1)) phase1(p, lane, wave);
#endif
    SEAM(1);
    if (IN(2)) {
        pg8::Gemm g{RA, RA, RA_ROWS, RA_ROWS, 1024}; G1Order S{(int)gridDim.x, (int)blockIdx.x};
        EpiG1 E{(bf16*)(p.ws + WS_PROJ), (bf16*)(p.ws + WS_ZT), (bf16*)(p.ws + WS_KVC), (const float*)(p.ws + WS_ROPE)};
        pg8::gemm_phase<EpiG1, G1Order, true, true>(lds, g, S, E);
    }
#if REP2 == 2
    __syncthreads();
    if (IN(2)) {
        pg8::Gemm g{RA, RA, RA_ROWS, RA_ROWS, 1024}; G1Order S{(int)gridDim.x, (int)blockIdx.x};
        EpiG1 E{(bf16*)(p.ws + WS_PROJ), (bf16*)(p.ws + WS_ZT), (bf16*)(p.ws + WS_KVC), (const float*)(p.ws + WS_ROPE)};
        pg8::gemm_phase<EpiG1, G1Order, true, true>(lds, g, S, E);
    }
#endif
    SEAM(2);
    if (IN(3)) {
        for (int u = blockIdx.x; u < 256; u += gridDim.x) { state_unit(p, lds, u, tid, lane, wave); __syncthreads(); }
        { bf16x8 m1[2][4]; fft_setup(lds, tid, lane, m1);
          for (int u = blockIdx.x; u < 1024; u += gridDim.x) fft_unit(p, lds, u, tid, lane, wave, m1); }
    }
#if REP3 == 2
    __syncthreads();
    if (IN(3)) {
        for (int u = blockIdx.x; u < 256; u += gridDim.x) { state_unit(p, lds, u, tid, lane, wave); __syncthreads(); }
        { bf16x8 m1[2][4]; fft_setup(lds, tid, lane, m1);
          for (int u = blockIdx.x; u < 1024; u += gridDim.x) fft_unit(p, lds, u, tid, lane, wave, m1); }
    }
#endif
    SEAM(3);
    if (IN(4)) for (int rep = 0; rep < REP4; ++rep) { for (int u = blockIdx.x; u < 1024; u += gridDim.x) ret_unit(p, lds, u, tid, lane, wave); }
    SEAM(4);
#if defined(REPS)
    grid.sync(); grid.sync(); grid.sync(); grid.sync();
#endif
    if (IN(5)) {
        __syncthreads();
        pg8::Gemm g{(const bf16*)(p.ws + WS_MIX), (const bf16*)(p.ws + WS_WOT), MTOK, 1024, 1024}; pg8::StaticOrder S; S.init(MTOK, 1024, (int)gridDim.x, (int)blockIdx.x);
        EpiOut E{(bf16*)(p.ws + WS_Y), (float*)(p.ws + WS_ROWSS)};
        pg8::gemm_phase<EpiOut, pg8::StaticOrder, true, true>(lds, g, S, E);
    }
    SEAM(5);
    if (IN(6)) phase6(p, lane, wave);
#if defined(REP6)
    if (IN(6)) phase6(p, lane, wave);
#endif
#undef IN
#undef SEAM
}

#ifndef N_LAUNCHES
#define N_LAUNCHES 1
#endif
extern "C" void kernel_launch(void* const* d_in, const int* in_sizes, int n_in, void* d_out, int out_size, void* d_ws, size_t ws_size, hipStream_t stream) {
    static int grid = 0;
    if (grid == 0) {
        if (n_in != 13 || out_size != MTOK * DM || ws_size < WS_END) { fprintf(stderr, "kernel_launch: unexpected shapes (n_in %d out %d ws %zu)\n", n_in, out_size, ws_size); grid = -1; return; }
        int dev = 0, cus = 0, per_cu = 0;
        hipGetDevice(&dev); hipDeviceGetAttribute(&cus, hipDeviceAttributeMultiprocessorCount, dev);
        if (hipFuncSetAttribute((const void*)hymba_fwd, hipFuncAttributeMaxDynamicSharedMemorySize, LDS_BYTES) != hipSuccess) { fprintf(stderr, "kernel_launch: hipFuncSetAttribute failed\n"); grid = -1; return; }
        if (hipOccupancyMaxActiveBlocksPerMultiprocessor(&per_cu, (const void*)hymba_fwd, 512, LDS_BYTES) != hipSuccess || per_cu < 1) { fprintf(stderr, "kernel_launch: occupancy query says %d\n", per_cu); per_cu = 1; }
        (void)hipGetLastError();
        grid = cus > 256 ? 256 : cus;
    }
    if (grid < 0) return;
    Params p{};
    p.x = (const float*)d_in[0]; p.c = (const float*)d_in[1]; p.ctx = (const float*)d_in[2]; p.c_ctx = (const float*)d_in[3];
    p.w_ada = (const float*)d_in[4]; p.b_ada = (const float*)d_in[5]; p.g_pre = (const float*)d_in[6]; p.g_post = (const float*)d_in[7];
    p.w_in = (const float*)d_in[8]; p.w_fourier = (const float*)d_in[9]; p.decay_logit = (const float*)d_in[10]; p.gn_gain = (const float*)d_in[11]; p.w_out = (const float*)d_in[12];
    p.out = (float*)d_out; p.ws = (unsigned char*)d_ws;
    if (hipMemsetAsync(d_ws, 0, 16384, stream) != hipSuccess) { fprintf(stderr, "kernel_launch: memset failed\n"); return; }
    if (N_LAUNCHES == 1) {
        p.ph_lo = 0; p.ph_hi = 7; p.use_cg = 0;
        void* args[] = {&p};
        hipError_t e = hipLaunchCooperativeKernel((const void*)hymba_fwd, dim3(grid), dim3(512), args, LDS_BYTES, stream);
        if (e != hipSuccess) fprintf(stderr, "cooperative launch failed: %s (grid %d)\n", hipGetErrorString(e), grid);
    } else {
        for (int ph = 0; ph < 7; ++ph) { p.ph_lo = ph; p.ph_hi = ph + 1; hipLaunchKernelGGL(hymba_fwd, dim3(grid), dim3(512), LDS_BYTES, stream, p); }
    }
}
```

```cpp
#include <hip/hip_runtime.h>
#include <hip/hip_cooperative_groups.h>
#include <cstdio>
#include <cstdint>
namespace cg = cooperative_groups;
namespace pg8 {
#define PG8_LAS __attribute__((address_space(3)))
typedef unsigned short bf16_t;
typedef short bf16x8 __attribute__((ext_vector_type(8)));
typedef float f32x4 __attribute__((ext_vector_type(4)));
typedef unsigned u32x4 __attribute__((ext_vector_type(4)));
constexpr int BM = 256, BK = 64, HALF = 128, HTB = HALF * BK * 2  , STAGE_BYTES = 8 * HTB, NXCD = 8, WGM = 8;

__host__ __device__ __forceinline__ int lds_byte(int r, int c) { const int st = (r >> 4) * 2 + (c >> 5), rr = r & 15, cc = c & 31, ob = rr * 64 + cc * 2; return st * 1024 + (ob ^ (((ob >> 9) & 1) << 5)); }
__host__ __device__ __forceinline__ void stage_rc(int b, int& R, int& C) { const int st = b / 1024, sb = b % 1024, swz = sb ^ (((sb >> 9) & 1) << 5); R = (st >> 1) * 16 + swz / 64; C = (st & 1) * 32 + (swz % 64) / 2; }
__host__ __device__ __forceinline__ int perm32(int rho) { const int n = rho >> 4, i = rho & 15; return 8 * (i >> 2) + 4 * n + (i & 3); }

struct Unit { int pm, pn; };
struct Gemm { const bf16_t* A; const bf16_t* Bt; int M, N, K; };

struct StaticOrder {
    int nM, nN, nwg, G, c;
    __host__ __device__ void init(int M, int N, int G_, int c_) { nM = M / BM; nN = N / BM; nwg = nM * nN; G = G_; c = c_; }
    __host__ __device__ bool next(int i, Unit& u) const {
        const long L = (long)i * G + c; if (L >= nwg) return false;
        int wgid = (int)L; { const int q = nwg / NXCD, r = nwg % NXCD, xcd = wgid % NXCD, off = wgid / NXCD; wgid = (xcd < r ? xcd * (q + 1) : r * (q + 1) + (xcd - r) * q) + off; }
        const int nig = WGM * nN, gid = wgid / nig, fm = gid * WGM, gsz = (nM - fm) < WGM ? (nM - fm) : WGM;
        u.pm = fm + ((wgid % nig) % gsz); u.pn = (wgid % nig) / gsz; return true;
    }
    __device__ __forceinline__ void a_ready(const Unit&) const {}
    __device__ __forceinline__ void done(const Unit&) const {}
};

__device__ __forceinline__ unsigned cvt_pk_bf16(float lo, float hi) { unsigned r; asm volatile("v_cvt_pk_bf16_f32 %0, %1, %2" : "=v"(r) : "v"(lo), "v"(hi)); return r; }

template <class Epi, class Sched, bool ALIGN_EPI = false, bool SP2 = false>
__device__ __forceinline__ void gemm_phase(PG8_LAS unsigned char* lds, const Gemm g, const Sched& S, const Epi& E) {
    const int tid = threadIdx.x, wid = __builtin_amdgcn_readfirstlane(tid >> 6), lane = tid & 63, wr = wid >> 2, wc = wid & 3, fr = lane & 15, fq = lane >> 4;
    const int K = g.K, nt = K / BK;
    unsigned voffA[2], voffB[2];
#pragma unroll
    for (int i = 0; i < 2; ++i) { int R, C; stage_rc(tid * 16 + i * 8192, R, C); const int Rb = Epi::PERM ? ((R & ~31) + perm32(R & 31)) : R;
        voffA[i] = (unsigned)(R * K + C) * 2u; voffB[i] = (unsigned)(Rb * K + C) * 2u; }
    const size_t kstep = (size_t)(BK * 2);
    const size_t hstep = (size_t)HALF * K * 2;
    const size_t tstep = 2 * hstep;
    const unsigned ldsw = (unsigned)wid * 1024u;
    const int aoff = lds_byte(wr * 64 + fr, fq * 8), boff = lds_byte(wc * 32 + fr, fq * 8);
#define PG8_SA(b, h) (((b) * 2 + (h)) * HTB)
#define PG8_SB(b, h) ((4 + (b) * 2 + (h)) * HTB)
#define PG8_STAGE(bufoff, gbase, voff) do { _Pragma("unroll") for (int _i = 0; _i < 2; ++_i) \
        __builtin_amdgcn_global_load_lds((const unsigned*)((const char*)(gbase) + (voff)[_i]), (PG8_LAS unsigned*)(lds + (bufoff) + ldsw + _i * 8192), 16, 0, 0); } while (0)
#define PG8_LDA(dst, b, h) do { _Pragma("unroll") for (int m = 0; m < 4; ++m) _Pragma("unroll") for (int k = 0; k < 2; ++k) dst[m][k] = *(const PG8_LAS bf16x8*)(lds + PG8_SA(b, h) + aoff + m * 2048 + k * 1024); } while (0)
#define PG8_LDB(dst, b, h) do { _Pragma("unroll") for (int n = 0; n < 2; ++n) _Pragma("unroll") for (int k = 0; k < 2; ++k) dst[n][k] = *(const PG8_LAS bf16x8*)(lds + PG8_SB(b, h) + boff + n * 2048 + k * 1024); } while (0)
#define PG8_MMA(ai, bj, At, Bt) do { __builtin_amdgcn_s_setprio(1); _Pragma("unroll") for (int m = 0; m < 4; ++m) _Pragma("unroll") for (int n = 0; n < 2; ++n) _Pragma("unroll") for (int k = 0; k < 2; ++k) \
        acc[ai][bj][m][n] = __builtin_amdgcn_mfma_f32_16x16x32_bf16(Bt[n][k], At[m][k], acc[ai][bj][m][n], 0, 0, 0); __builtin_amdgcn_s_setprio(0); } while (0)
#define PG8_WAIT_V(n) asm volatile("s_waitcnt vmcnt(" #n ")" ::: "memory")
#define PG8_WAIT_L(n) asm volatile("s_waitcnt lgkmcnt(" #n ")" ::: "memory")
#define PG8_BAR __builtin_amdgcn_s_barrier()
#define PG8_SCHED __builtin_amdgcn_sched_barrier(0)
    Unit cur, nxt; int ui = 0;
    if (!S.next(0, cur)) return;
    f32x4 acc[2][2][4][2];
#pragma unroll
    for (int a = 0; a < 2; ++a)
#pragma unroll
        for (int b = 0; b < 2; ++b)
#pragma unroll
            for (int m = 0; m < 4; ++m)
#pragma unroll
                for (int n = 0; n < 2; ++n) acc[a][b][m][n] = (f32x4){0.f, 0.f, 0.f, 0.f};
    bf16x8 At[4][2], B0[2][2], B1[2][2];
    const char* cA = (const char*)g.A + (size_t)cur.pm * tstep; const char* cB = (const char*)g.Bt + (size_t)cur.pn * tstep;
    S.a_ready(cur);
    if constexpr (SP2) {
        PG8_STAGE(PG8_SB(0, 0), cB, voffB); PG8_STAGE(PG8_SB(0, 1), cB + hstep, voffB); PG8_STAGE(PG8_SA(0, 0), cA, voffA); PG8_STAGE(PG8_SA(0, 1), cA + hstep, voffA);
        if (wr == 1) PG8_BAR;
        PG8_WAIT_V(2); PG8_BAR;
        PG8_STAGE(PG8_SB(1, 0), cB + kstep, voffB); PG8_STAGE(PG8_SA(1, 0), cA + kstep, voffA); PG8_STAGE(PG8_SB(1, 1), cB + hstep + kstep, voffB);
        PG8_WAIT_V(6); PG8_BAR;
    } else {
        PG8_STAGE(PG8_SB(0, 0), cB, voffB); PG8_STAGE(PG8_SA(0, 0), cA, voffA); PG8_STAGE(PG8_SB(0, 1), cB + hstep, voffB); PG8_STAGE(PG8_SA(0, 1), cA + hstep, voffA);
        if (wr == 1) PG8_BAR;
        PG8_WAIT_V(4); PG8_BAR;
        PG8_STAGE(PG8_SB(1, 0), cB + kstep, voffB); PG8_STAGE(PG8_SA(1, 0), cA + kstep, voffA); PG8_STAGE(PG8_SB(1, 1), cB + hstep + kstep, voffB);
        PG8_WAIT_V(6); PG8_BAR;
    }
    for (;;) {
        const bool has_next = S.next(ui + 1, nxt);
        const char* nA = has_next ? (const char*)g.A + (size_t)nxt.pm * tstep : cA; const char* nB = has_next ? (const char*)g.Bt + (size_t)nxt.pn * tstep : cB;
        for (int t = 0; t < nt; t += 2) {
            const bool last = (t == nt - 2);
            const char* a1 = cA + (size_t)(t + 1) * kstep;
            const char* a2 = last ? nA : cA + (size_t)(t + 2) * kstep; const char* b2 = last ? nB : cB + (size_t)(t + 2) * kstep;
            const char* a3 = a2 + kstep; const char* b3 = b2 + kstep;
            if (last && has_next) S.a_ready(nxt);
            if constexpr (SP2) {
            PG8_LDB(B0, 0, 0); PG8_LDB(B1, 0, 1); PG8_SCHED; PG8_LDA(At, 0, 0); PG8_STAGE(PG8_SA(1, 1), a1 + hstep, voffA);
            PG8_WAIT_V(8); PG8_WAIT_L(0); PG8_BAR; PG8_MMA(0, 0, At, B0); PG8_MMA(0, 1, At, B1); PG8_BAR; PG8_SCHED;
            PG8_LDA(At, 0, 1); PG8_STAGE(PG8_SB(0, 0), b2, voffB); PG8_STAGE(PG8_SB(0, 1), b2 + hstep, voffB); PG8_STAGE(PG8_SA(0, 0), a2, voffA);
            PG8_WAIT_V(8); PG8_WAIT_L(0); PG8_BAR; PG8_MMA(1, 0, At, B0); PG8_MMA(1, 1, At, B1); PG8_BAR; PG8_SCHED;
            PG8_LDB(B0, 1, 0); PG8_LDB(B1, 1, 1); PG8_SCHED; PG8_LDA(At, 1, 0); PG8_STAGE(PG8_SA(0, 1), a2 + hstep, voffA);
            PG8_WAIT_V(8); PG8_WAIT_L(0); PG8_BAR; PG8_MMA(0, 0, At, B0); PG8_MMA(0, 1, At, B1); PG8_BAR; PG8_SCHED;
            PG8_LDA(At, 1, 1); PG8_STAGE(PG8_SB(1, 0), b3, voffB); PG8_STAGE(PG8_SB(1, 1), b3 + hstep, voffB); PG8_STAGE(PG8_SA(1, 0), a3, voffA);
            PG8_WAIT_V(8); PG8_WAIT_L(0); PG8_BAR; PG8_MMA(1, 0, At, B0); PG8_MMA(1, 1, At, B1); PG8_BAR; PG8_SCHED;
            } else {
            PG8_LDB(B0, 0, 0); PG8_SCHED; PG8_LDA(At, 0, 0); PG8_STAGE(PG8_SA(1, 1), a1 + hstep, voffA);
            PG8_WAIT_L(8); PG8_BAR; PG8_WAIT_L(0); PG8_MMA(0, 0, At, B0); PG8_BAR; PG8_SCHED;
            PG8_LDB(B1, 0, 1); PG8_STAGE(PG8_SB(0, 0), b2, voffB);
            PG8_BAR; PG8_WAIT_L(0); PG8_MMA(0, 1, At, B1); PG8_BAR;
            PG8_LDA(At, 0, 1); PG8_STAGE(PG8_SA(0, 0), a2, voffA);
            PG8_BAR; PG8_WAIT_L(0); PG8_MMA(1, 0, At, B0); PG8_BAR; PG8_SCHED;
            PG8_STAGE(PG8_SB(0, 1), b2 + hstep, voffB);
            PG8_WAIT_V(6); PG8_BAR; PG8_MMA(1, 1, At, B1); PG8_BAR;
            PG8_LDB(B0, 1, 0); PG8_SCHED; PG8_LDA(At, 1, 0); PG8_STAGE(PG8_SA(0, 1), a2 + hstep, voffA);
            PG8_WAIT_L(8); PG8_BAR; PG8_WAIT_L(0); PG8_MMA(0, 0, At, B0); PG8_BAR; PG8_SCHED;
            PG8_LDB(B1, 1, 1); PG8_STAGE(PG8_SB(1, 0), b3, voffB);
            PG8_BAR; PG8_WAIT_L(0); PG8_MMA(0, 1, At, B1); PG8_BAR;
            PG8_LDA(At, 1, 1); PG8_STAGE(PG8_SA(1, 0), a3, voffA);
            PG8_BAR; PG8_WAIT_L(0); PG8_MMA(1, 0, At, B0); PG8_BAR; PG8_SCHED;
            PG8_STAGE(PG8_SB(1, 1), b3 + hstep, voffB);
            PG8_WAIT_V(6); PG8_BAR; PG8_MMA(1, 1, At, B1); PG8_BAR;
            }
        }
        if constexpr (ALIGN_EPI) { if (wr == 0) PG8_BAR; }
        if constexpr (!Epi::AFTER_DRAIN) { E(acc, cur, wr, wc, fr, fq); S.done(cur); }
        if (!has_next) break;
#pragma unroll
        for (int a = 0; a < 2; ++a)
#pragma unroll
            for (int b = 0; b < 2; ++b)
#pragma unroll
                for (int m = 0; m < 4; ++m)
#pragma unroll
                    for (int n = 0; n < 2; ++n) acc[a][b][m][n] = (f32x4){0.f, 0.f, 0.f, 0.f};
        cur = nxt; cA = nA; cB = nB; ++ui;
        if constexpr (ALIGN_EPI) { if (wr == 1) PG8_BAR; }
    }
    PG8_WAIT_V(0);
    if constexpr (!ALIGN_EPI) { if (wr == 0) PG8_BAR; }
    PG8_BAR;
    if constexpr (Epi::AFTER_DRAIN) { E.fused(acc, cur, wr, wc, fr, fq, lds, wid, lane); S.done(cur); }
#undef PG8_SA
#undef PG8_SB
#undef PG8_STAGE
#undef PG8_LDA
#undef PG8_LDB
#undef PG8_MMA
#undef PG8_WAIT_V
#undef PG8_WAIT_L
#undef PG8_BAR
#undef PG8_SCHED
}
}

#define LAS __attribute__((address_space(3)))
#define DI __device__ __forceinline__
typedef unsigned short bf16;
typedef unsigned v4u __attribute__((ext_vector_type(4)));
typedef unsigned v2u __attribute__((ext_vector_type(2)));
typedef float f32x4 __attribute__((ext_vector_type(4)));
typedef short bf16x8 __attribute__((ext_vector_type(8)));
typedef short s16x4 __attribute__((ext_vector_type(4)));

constexpr int NB = 16, SEQ = 2048, DM = 1024, MTOK = NB * SEQ, CTXL = 256, MCTX = NB * CTXL;
constexpr int PROJ_LD = 2560;
constexpr int PC_G = 0, PC_Q = 512, PC_K = 1024, PC_V = 1536, PC_R = 2048;
constexpr float EPSV = 1e-6f;
constexpr float QK_SCALE = 0.08838834764831845f;
constexpr int RT_CTX = 128, RT_W = 144, RT_WF = 154, RA_ROWS = 158 * 256;
constexpr int G1_MAIN = 1280, G1_FT = 512, G1_CTX = 64, G1_UNITS = G1_MAIN + G1_FT + G1_CTX;

constexpr size_t MiB = 1u << 20;
constexpr size_t WS_ADA = 1 * MiB;
constexpr size_t WS_ROPE = WS_ADA + 256 * 1024;
constexpr size_t WS_ROWSS = 396 * MiB;
constexpr size_t WS_RA = 2 * MiB;
constexpr size_t WS_MIX = WS_RA;
constexpr size_t WS_PROJ = 82 * MiB;
constexpr size_t WS_Y = WS_PROJ;
constexpr size_t WS_KVC = 242 * MiB;
constexpr size_t WS_ZT = 250 * MiB;
constexpr size_t WS_DT = 314 * MiB;
constexpr size_t WS_ST = 330 * MiB;
constexpr size_t WS_WOT = 394 * MiB;
constexpr size_t WS_END = 398 * MiB;
constexpr int LDS_BYTES = 147456, LDS_MISC = 139264;

struct Params {
    const float *x, *c, *ctx, *c_ctx, *w_ada, *b_ada, *g_pre, *g_post, *w_in, *w_fourier, *decay_logit, *gn_gain, *w_out;
    float* out; unsigned char* ws; int ph_lo, ph_hi, use_cg, pad;
};

DI unsigned f2bf(float f) { unsigned u = __builtin_bit_cast(unsigned, f); return (u + 0x7fffu + ((u >> 16) & 1u)) >> 16; }
DI unsigned pk2(float lo, float hi) { unsigned r; asm("v_cvt_pk_bf16_f32 %0, %1, %2" : "=v"(r) : "v"(lo), "v"(hi)); return r; }
DI float bflo(unsigned u) { return __builtin_bit_cast(float, u << 16); }
DI float bfhi(unsigned u) { return __builtin_bit_cast(float, u & 0xffff0000u); }
DI float silu_f(float v) { return v / (1.f + __expf(-v)); }
DI float wave_sum(float v) {
#pragma unroll
    for (int o = 1; o < 64; o <<= 1) v += __shfl_xor(v, o);
    return v;
}
DI unsigned offb(unsigned row, unsigned ch) { return 256u * row + 16u * (ch ^ (((row & 3) << 2) | ((row >> 2) & 3))); }
DI s16x4 tr_read(LAS unsigned char* p) { return __builtin_amdgcn_ds_read_tr16_b64_v4i16((LAS s16x4*)p); }
DI bf16x8 cat8(s16x4 a, s16x4 b) { bf16x8 r; r[0] = a[0]; r[1] = a[1]; r[2] = a[2]; r[3] = a[3]; r[4] = b[0]; r[5] = b[1]; r[6] = b[2]; r[7] = b[3]; return r; }
#define MFMA16(a, b, c) __builtin_amdgcn_mfma_f32_16x16x32_bf16((a), (b), (c), 0, 0, 0)

struct G1Order {
    int G, c;
    DI bool next(int i, pg8::Unit& u) const {
        const int L = i * G + c; if (L >= G1_UNITS) return false;
        if (L < G1_MAIN) {
            const int wgid = (L & 7) * (G1_MAIN / 8) + (L >> 3);
            const int r80 = wgid % 80;
            u.pm = (wgid / 80) * 8 + (r80 & 7); u.pn = RT_W + (r80 >> 3);
        } else if (L < G1_MAIN + G1_FT) {
            const int l2 = L - G1_MAIN, idx = (l2 & 7) * (G1_FT / 8) + (l2 >> 3);
            u.pm = RT_WF + (idx & 3); u.pn = idx >> 2;
        } else {
            const int l2 = L - G1_MAIN - G1_FT;
            u.pm = RT_CTX + (l2 >> 2); u.pn = RT_W + 4 + (l2 & 3);
        }
        return true;
    }
    DI void a_ready(const pg8::Unit&) const {}
    DI void done(const pg8::Unit&) const {}
};

DI v4u pack8(f32x4 a, f32x4 b) { v4u w; w.x = pk2(a[0], a[1]); w.y = pk2(a[2], a[3]); w.z = pk2(b[0], b[1]); w.w = pk2(b[2], b[3]); return w; }

struct EpiG1 {
    static constexpr bool PERM = true, AFTER_DRAIN = false;
    bf16* PROJ; bf16* ZT; bf16* KVC; const float* rope;
    DI void operator()(const f32x4 (&acc)[2][2][4][2], const pg8::Unit& u, int wr, int wc, int fr, int fq) const {
        const int rl0 = wr * 64 + fr, cl0 = wc * 32 + 8 * fq;
        bf16* base; int ld, mode = 0; float sc = 1.f;
        if (u.pm < RT_CTX) {
            const int wt = u.pn - RT_W, type = wt >> 1;
            base = PROJ + (size_t)(u.pm * 256) * PROJ_LD + wt * 256; ld = PROJ_LD;
            mode = (type == 1 || type == 2) ? 1 : (type == 3 ? 0 : 2); sc = (type == 1) ? QK_SCALE : 1.f;
        } else if (u.pm >= RT_WF) {
            base = ZT + ((size_t)(u.pn >> 3) * 1024 + (u.pm - RT_WF) * 256) * SEQ + (u.pn & 7) * 256; ld = SEQ;
        } else {
            base = KVC + (size_t)((u.pm - RT_CTX) * 256) * 1024 + (u.pn - RT_W - 4) * 256; ld = 1024;
        }
        base += (size_t)rl0 * ld + cl0;
        const int lbase = (u.pm * 256 + rl0) & (SEQ - 1);
        const float* rbase = rope + (16 * (wc & 1) + 4 * fq) * 2;
#pragma unroll
        for (int ai = 0; ai < 2; ++ai)
#pragma unroll
            for (int m = 0; m < 4; ++m) {
                bf16* rowp = base + (size_t)(ai * 128 + m * 16) * ld;
                f32x4 v00 = acc[ai][0][m][0], v01 = acc[ai][0][m][1], v10 = acc[ai][1][m][0], v11 = acc[ai][1][m][1];
                if (mode == 1) {
                    const int l = lbase + ai * 128 + m * 16;
                    const int pos = (wc >> 1) ? (l & 63) : (l >> 6);
                    const f32x4 r0 = *(const f32x4*)(rbase + pos * 64), r1 = *(const f32x4*)(rbase + pos * 64 + 4);
                    f32x4 t;
                    t = v00 * sc; v00[0] = t[0] * r0[0] - t[1] * r0[1]; v00[1] = t[0] * r0[1] + t[1] * r0[0]; v00[2] = t[2] * r0[2] - t[3] * r0[3]; v00[3] = t[2] * r0[3] + t[3] * r0[2];
                    t = v01 * sc; v01[0] = t[0] * r1[0] - t[1] * r1[1]; v01[1] = t[0] * r1[1] + t[1] * r1[0]; v01[2] = t[2] * r1[2] - t[3] * r1[3]; v01[3] = t[2] * r1[3] + t[3] * r1[2];
                    t = v10 * sc; v10[0] = t[0] * r0[0] - t[1] * r0[1]; v10[1] = t[0] * r0[1] + t[1] * r0[0]; v10[2] = t[2] * r0[2] - t[3] * r0[3]; v10[3] = t[2] * r0[3] + t[3] * r0[2];
                    t = v11 * sc; v11[0] = t[0] * r1[0] - t[1] * r1[1]; v11[1] = t[0] * r1[1] + t[1] * r1[0]; v11[2] = t[2] * r1[2] - t[3] * r1[3]; v11[3] = t[2] * r1[3] + t[3] * r1[2];
                } else if (mode == 2) {
#pragma unroll
                    for (int j = 0; j < 4; ++j) { v00[j] = silu_f(v00[j]); v01[j] = silu_f(v01[j]); v10[j] = silu_f(v10[j]); v11[j] = silu_f(v11[j]); }
                }
                *(v4u*)(rowp) = pack8(v00, v01);
                *(v4u*)(rowp + 128) = pack8(v10, v11);
                asm volatile("" ::: "memory");
            }
    }
};

struct EpiDft {
    static constexpr bool PERM = true, AFTER_DRAIN = false;
    const bf16* PROJ; bf16* MIX;
    DI void operator()(const f32x4 (&acc)[2][2][4][2], const pg8::Unit& u, int wr, int wc, int fr, int fq) const {
        const int rl0 = wr * 64 + fr, cl0 = wc * 32 + 8 * fq;
        const int b = u.pn >> 1, chg0 = (u.pn & 1) * 256 + cl0;
#pragma unroll
        for (int ai = 0; ai < 2; ++ai)
#pragma unroll
            for (int m = 0; m < 4; ++m) {
                const size_t tok = (size_t)b * SEQ + u.pm * 256 + rl0 + ai * 128 + m * 16;
#pragma unroll
                for (int bj = 0; bj < 2; ++bj) {
                    const v4u g = *(const v4u*)(PROJ + tok * PROJ_LD + PC_G + chg0 + bj * 128);
                    f32x4 v0 = acc[ai][bj][m][0], v1 = acc[ai][bj][m][1];
                    v0[0] *= bflo(g.x); v0[1] *= bfhi(g.x); v0[2] *= bflo(g.y); v0[3] *= bfhi(g.y);
                    v1[0] *= bflo(g.z); v1[1] *= bfhi(g.z); v1[2] *= bflo(g.w); v1[3] *= bfhi(g.w);
                    *(v4u*)(MIX + tok * 1024 + chg0 + bj * 128) = pack8(v0, v1);
                }
            }
    }
};

struct EpiOut {
    static constexpr bool PERM = true, AFTER_DRAIN = false;
    bf16* Y; float* rowss;
    DI void operator()(const f32x4 (&acc)[2][2][4][2], const pg8::Unit& u, int wr, int wc, int fr, int fq) const {
        const int rl0 = wr * 64 + fr, cl0 = u.pn * 256 + wc * 32 + 8 * fq;
#pragma unroll
        for (int ai = 0; ai < 2; ++ai)
#pragma unroll
            for (int m = 0; m < 4; ++m) {
                const int row = u.pm * 256 + rl0 + ai * 128 + m * 16;
                float ss = 0.f;
#pragma unroll
                for (int bj = 0; bj < 2; ++bj) {
                    const f32x4 v0 = acc[ai][bj][m][0], v1 = acc[ai][bj][m][1];
                    ss += (v0[0] * v0[0] + v0[1] * v0[1]) + (v0[2] * v0[2] + v0[3] * v0[3]) + (v1[0] * v1[0] + v1[1] * v1[1]) + (v1[2] * v1[2] + v1[3] * v1[3]);
                    *(v4u*)(Y + (size_t)row * 1024 + cl0 + bj * 128) = pack8(v0, v1);
                }
                ss += __shfl_xor(ss, 16); ss += __shfl_xor(ss, 32);
                if (fq == 0) rowss[(size_t)row * 16 + u.pn * 4 + wc] = ss;
            }
    }
};

DI int w1_srccol(int n) {
    const int t = n >> 9; int src = 512 + n;
    if (t == 1 || t == 2) { const int p = n & 127, hs = p >> 6, w = p & 63; src = 512 + (n & ~127) + hs * 64 + (w & 1) * 32 + (w >> 1); }
    return src;
}
template <bool MAIN>
DI void transpose_item(const float* W, int N, bf16* WT, int item, LAS float* scr, int lane) {
    const int nblk = MAIN ? 80 : 32, kb = item / nblk, nb = item % nblk, k0 = 64 * kb, n0 = 32 * nb;
    const int nl = lane & 31, sc = MAIN ? w1_srccol(n0 + nl) : (n0 + nl);
#pragma unroll 8
    for (int i = 0; i < 32; ++i) { const int kk = 2 * i + (lane >> 5); scr[kk * 33 + nl] = W[(size_t)(k0 + kk) * N + sc]; }
    asm volatile("s_waitcnt lgkmcnt(0)" ::: "memory");
    const int c = lane & 7;
#pragma unroll
    for (int j = 0; j < 4; ++j) { const int n = (lane >> 3) + 8 * j; const LAS float* s = scr + (8 * c) * 33 + n;
        v4u o; o.x = pk2(s[0 * 33], s[1 * 33]); o.y = pk2(s[2 * 33], s[3 * 33]); o.z = pk2(s[4 * 33], s[5 * 33]); o.w = pk2(s[6 * 33], s[7 * 33]);
        *(v4u*)(WT + (size_t)(n0 + n) * 1024 + k0 + 8 * c) = o; }
    asm volatile("s_waitcnt lgkmcnt(0)" ::: "memory");
}

DI void phase0(const Params& p, LAS unsigned char* lds, int tid, int lane, int wave) {
    float* ADA = (float*)(p.ws + WS_ADA); float* rope = (float*)(p.ws + WS_ROPE);
    bf16* RA = (bf16*)(p.ws + WS_RA); bf16* WOT = (bf16*)(p.ws + WS_WOT);
    bf16* W1T = RA + (size_t)RT_W * 256 * 1024; bf16* WFT = RA + (size_t)RT_WF * 256 * 1024;
    LAS float* sl = (LAS float*)lds; LAS float* red = sl + 17 * 1024;
    for (int i = tid; i < 17 * 1024; i += 512) { const int v = i >> 10, k = i & 1023; const float cv = (v < 16) ? p.c[v * 1024 + k] : p.c_ctx[k]; sl[i] = cv / (1.f + expf(-cv)); }
    __syncthreads();
    for (int vw = blockIdx.x; vw < 256; vw += gridDim.x) {
        const int j0 = 12 * vw, col = tid & 15, ks = tid >> 4;
        float acc[17];
#pragma unroll
        for (int v = 0; v < 17; ++v) acc[v] = 0.f;
        if (col < 12) {
            for (int kk = 0; kk < 32; ++kk) { const int k = ks * 32 + kk; const float wv = p.w_ada[(size_t)k * 3072 + j0 + col];
#pragma unroll
                for (int v = 0; v < 17; ++v) acc[v] += sl[v * 1024 + k] * wv; }
#pragma unroll
            for (int v = 0; v < 17; ++v) red[(ks * 17 + v) * 12 + col] = acc[v];
        }
        __syncthreads();
        if (tid < 204) { const int v = tid / 12, cc = tid % 12; float s = p.b_ada[j0 + cc];
            for (int k2 = 0; k2 < 32; ++k2) s += red[(k2 * 17 + v) * 12 + cc];
            ADA[v * 3072 + j0 + cc] = s; }
        __syncthreads();
    }
    {
        LAS float* scr = (LAS float*)(lds + wave * 8448);
        const int gw = blockIdx.x * 8 + wave, NGW = gridDim.x * 8;
        for (int it = gw; it < 1280 + 512; it += NGW) {
            if (it < 1280) transpose_item<true>(p.w_in, 3072, W1T, it, scr, lane);
            else transpose_item<false>(p.w_out, 1024, WOT, it - 1280, scr, lane);
        }
    }
    __syncthreads();
    {
        LAS float* ct = (LAS float*)lds; LAS float* st = ct + 128; LAS float* Tl = st + 128;
        if (tid < 128) { float s, c; sincospif((float)tid * (1.f / 64.f), &s, &c); ct[tid] = c; st[tid] = s; }
        __syncthreads();
        for (int vw = blockIdx.x; vw < 256; vw += gridDim.x) {
            const int g = vw >> 6, d0 = (vw & 63) * 2;
            { const int pq = tid >> 8, dd = (tid >> 7) & 1, c = tid & 127; float a = 0.f;
              for (int j = 0; j < 128; ++j) { const int idx = (j * c) & 127; a += (pq ? st[idx] : ct[idx]) * p.w_fourier[(size_t)(g * 128 + j) * 128 + d0 + dd]; }
              Tl[(dd * 2 + pq) * 128 + c] = a * (1.f / 512.f); }
            __syncthreads();
#pragma unroll 1
            for (int kq = tid; kq < 1024; kq += 512) {
                float a0 = 0.f, a1 = 0.f, a2 = 0.f, a3 = 0.f;
                const f32x4* wp = (const f32x4*)(p.w_in + (size_t)kq * 3072 + g * 128);
                for (int c4 = 0; c4 < 32; ++c4) { const f32x4 wv = wp[c4];
#pragma unroll
                    for (int e = 0; e < 4; ++e) { const int c = c4 * 4 + e; a0 += wv[e] * Tl[c]; a1 += wv[e] * Tl[128 + c]; a2 += wv[e] * Tl[256 + c]; a3 += wv[e] * Tl[384 + c]; } }
                bf16* o = WFT + (size_t)((g * 128 + d0) * 2) * 1024 + kq;
                o[0] = (bf16)f2bf(a0); o[1024] = (bf16)f2bf(a1); o[2048] = (bf16)f2bf(a2); o[3072] = (bf16)f2bf(a3);
            }
            __syncthreads();
        }
    }
    for (int vw = blockIdx.x; vw < 256; vw += gridDim.x) {
        if (vw < 4) { const int idx = vw * 512 + tid, pos = idx >> 5, i = idx & 31; const float inv = powf(10000.f, -(float)i * (1.f / 32.f)); const float ang = (float)pos * inv;
            rope[idx * 2] = cosf(ang); rope[idx * 2 + 1] = sinf(ang); }
    }
}

DI void phase1(const Params& p, int lane, int wave) {
    const float* ADA = (const float*)(p.ws + WS_ADA); bf16* RA = (bf16*)(p.ws + WS_RA);
    const int gw = blockIdx.x * 8 + wave, NGW = gridDim.x * 8, NR = MTOK + MCTX, rpw = (NR + NGW - 1) / NGW;
    int r0 = gw * rpw, r1 = r0 + rpw; if (r1 > NR) r1 = NR;
    int vcur = -1; f32x4 gs[4], sh[4];
    for (int r = r0; r < r1; ++r) {
        const int v = (r < MTOK) ? (r >> 11) : 16;
        if (v != vcur) { vcur = v;
#pragma unroll
            for (int j = 0; j < 4; ++j) { const int col = lane * 4 + 256 * j; const f32x4 g = *(const f32x4*)(p.g_pre + col), sc = *(const f32x4*)(ADA + v * 3072 + 1024 + col);
                gs[j] = g * (sc + 1.f); sh[j] = *(const f32x4*)(ADA + v * 3072 + col); } }
        const float* xr = (r < MTOK) ? p.x + (size_t)r * 1024 : p.ctx + (size_t)(r - MTOK) * 1024;
        f32x4 xv[4]; float s = 0.f;
#pragma unroll
        for (int j = 0; j < 4; ++j) { xv[j] = *(const f32x4*)(xr + lane * 4 + 256 * j); s += (xv[j][0] * xv[j][0] + xv[j][1] * xv[j][1]) + (xv[j][2] * xv[j][2] + xv[j][3] * xv[j][3]); }
        const float rstd = rsqrtf(wave_sum(s) * (1.f / 1024.f) + EPSV);
        bf16* o = RA + (size_t)r * 1024;
#pragma unroll
        for (int j = 0; j < 4; ++j) { const f32x4 hv = xv[j] * rstd * gs[j] + sh[j]; v2u w; w.x = pk2(hv[0], hv[1]); w.y = pk2(hv[2], hv[3]); *(v2u*)(o + lane * 4 + 256 * j) = w; }
    }
}

DI void state_unit(const Params& p, LAS unsigned char* lds, int unit, int tid, int lane, int wave) {
    const bf16* PROJ = (const bf16*)(p.ws + WS_PROJ); const bf16* KVC = (const bf16*)(p.ws + WS_KVC); bf16* ST = (bf16*)(p.ws + WS_ST);
    const int eh = unit & 1, dir = (unit >> 1) & 1, h = (unit >> 2) & 3, b = unit >> 4;
    const int fr = lane & 15, fq = lane >> 4, q4 = fr >> 2, pp = fr & 3;
    const int et = wave & 3, dtb = (wave >> 2) * 4, cb = 4 * eh + et;
    const float lg = p.decay_logit[dir * 4 + h]; const float l2 = -log1pf(expf(-lg)) * 1.4426950408889634f;
    const float cdec = exp2f(128.f * l2);
    LAS unsigned char* Kimg = lds; LAS unsigned char* Vimg = lds + 32768;
    f32x4 acc[4];
#pragma unroll
    for (int i = 0; i < 4; ++i) acc[i] = (f32x4){0.f, 0.f, 0.f, 0.f};
    v4u kr0[4], vr0[2], kr1[4], vr1[2];
#define ST_LOAD(s, kr, vr) do { const bf16* Kp; int ld; \
        if ((s) < 2) { const int cc = dir ? 1 - (s) : (s); Kp = KVC + (size_t)(b * 256 + cc * 128) * 1024 + h * 128; ld = 1024; } \
        else { const int c = dir ? 17 - (s) : (s) - 2; Kp = PROJ + (size_t)(b * SEQ + c * 128) * PROJ_LD + PC_K + h * 128; ld = PROJ_LD; } \
        _Pragma("unroll") for (int i = 0; i < 4; ++i) { const int id = tid + 512 * i; kr[i] = *(const v4u*)(Kp + (size_t)(id >> 4) * ld + (id & 15) * 8); } \
        _Pragma("unroll") for (int i = 0; i < 2; ++i) { const int id = tid + 512 * i; vr[i] = *(const v4u*)(Kp + 512 + (size_t)(id >> 3) * ld + (8 * eh + (id & 7)) * 8); } } while (0)
#define ST_STEP(s, kr, vr) do { \
        if ((s) < 17) { \
            if (s) __syncthreads(); \
            _Pragma("unroll") for (int i = 0; i < 4; ++i) { const int id = tid + 512 * i; *(LAS v4u*)(Kimg + offb(id >> 4, id & 15)) = kr[i]; } \
            _Pragma("unroll") for (int i = 0; i < 2; ++i) { const int id = tid + 512 * i, m = id >> 3; const float wgt = exp2f((float)(dir ? m : 127 - m) * l2); \
                v4u o; o.x = pk2(bflo(vr[i].x) * wgt, bfhi(vr[i].x) * wgt); o.y = pk2(bflo(vr[i].y) * wgt, bfhi(vr[i].y) * wgt); \
                o.z = pk2(bflo(vr[i].z) * wgt, bfhi(vr[i].z) * wgt); o.w = pk2(bflo(vr[i].w) * wgt, bfhi(vr[i].w) * wgt); \
                *(LAS v4u*)(Vimg + offb(m, 8 * eh + (id & 7))) = o; } \
            __syncthreads(); \
            if ((s) + 2 < 17) ST_LOAD((s) + 2, kr, vr); \
        } \
        if ((s) >= 2) { \
            const int c = dir ? 17 - (s) : (s) - 2; \
            bf16* so = ST + ((size_t)(((b * 4 + h) * 16 + c) * 2 + dir)) * 16384 + (size_t)(64 * eh + 16 * et + fr) * 128; \
            _Pragma("unroll") for (int i = 0; i < 4; ++i) { v2u w; w.x = pk2(acc[i][0], acc[i][1]); w.y = pk2(acc[i][2], acc[i][3]); *(v2u*)(so + 16 * (dtb + i) + 4 * fq) = w; } \
        } \
        if ((s) < 17) { \
            _Pragma("unroll") for (int i = 0; i < 4; ++i) acc[i] = acc[i] * cdec; \
            _Pragma("unroll") for (int ks = 0; ks < 4; ++ks) { \
                const unsigned r0 = 32 * ks + 8 * fq + q4; \
                const bf16x8 vb = cat8(tr_read(Vimg + offb(r0, 2 * cb + (pp >> 1)) + 8 * (pp & 1)), tr_read(Vimg + offb(r0 + 4, 2 * cb + (pp >> 1)) + 8 * (pp & 1))); \
                _Pragma("unroll") for (int i = 0; i < 4; ++i) { const int dt = dtb + i; \
                    const bf16x8 ka = cat8(tr_read(Kimg + offb(r0, 2 * dt + (pp >> 1)) + 8 * (pp & 1)), tr_read(Kimg + offb(r0 + 4, 2 * dt + (pp >> 1)) + 8 * (pp & 1))); \
                    acc[i] = MFMA16(ka, vb, acc[i]); } \
            } \
        } } while (0)
    ST_LOAD(0, kr0, vr0); ST_LOAD(1, kr1, vr1);
#pragma unroll 1
    for (int s = 0; s < 18; s += 2) { ST_STEP(s, kr0, vr0); ST_STEP(s + 1, kr1, vr1); }
#undef ST_STEP
#undef ST_LOAD
}

DI void ret_unit(const Params& p, LAS unsigned char* lds, int unit, int tid, int lane, int wave) {
    const bf16* PROJ = (const bf16*)(p.ws + WS_PROJ); const bf16* ST = (const bf16*)(p.ws + WS_ST); bf16* MIX = (bf16*)(p.ws + WS_MIX);
    const int c = unit & 15, h = (unit >> 4) & 3, b = unit >> 6;
    const int fr = lane & 15, fq = lane >> 4, q4 = fr >> 2, pp = fr & 3;
    const size_t tok0 = (size_t)b * SEQ + c * 128;
    const float l2f = -log1pf(expf(-p.decay_logit[h])) * 1.4426950408889634f, l2b = -log1pf(expf(-p.decay_logit[4 + h])) * 1.4426950408889634f;
    LAS unsigned char* Kimg = lds; LAS unsigned char* Vimg = lds + 32768; LAS unsigned char* Simg = lds + 65536; LAS unsigned char* Ost = lds + 98304 + wave * 4352;
    const bf16* Kp = PROJ + tok0 * PROJ_LD + PC_K + h * 128; const bf16* Vp = PROJ + tok0 * PROJ_LD + PC_V + h * 128;
    const bf16* Sf = ST + ((size_t)(((b * 4 + h) * 16 + c) * 2)) * 16384; const bf16* Sb = Sf + 16384;
    v4u kr[4], vr[4], sr[4], sbr[4]; bf16x8 qf[4];
#pragma unroll
    for (int i = 0; i < 4; ++i) { const int id = tid + 512 * i, row = id >> 4, ch = id & 15;
        kr[i] = *(const v4u*)(Kp + (size_t)row * PROJ_LD + ch * 8); vr[i] = *(const v4u*)(Vp + (size_t)row * PROJ_LD + ch * 8);
        sr[i] = *(const v4u*)(Sf + row * 128 + ch * 8); sbr[i] = *(const v4u*)(Sb + row * 128 + ch * 8); }
    { const bf16* Qp = PROJ + (tok0 + 16 * wave + fr) * PROJ_LD + PC_Q + h * 128 + 8 * fq;
#pragma unroll
      for (int ks = 0; ks < 4; ++ks) qf[ks] = *(const bf16x8*)(Qp + 32 * ks); }
    __syncthreads();
#pragma unroll
    for (int i = 0; i < 4; ++i) { const int id = tid + 512 * i; const unsigned o = offb(id >> 4, id & 15);
        *(LAS v4u*)(Kimg + o) = kr[i]; *(LAS v4u*)(Vimg + o) = vr[i]; *(LAS v4u*)(Simg + o) = sr[i]; }
    __syncthreads();
    const int nl = 16 * wave + fr;
    const float sf = exp2f((float)(nl + 1) * l2f), sbv = exp2f((float)(128 - nl) * l2b);
    f32x4 O[8];
#pragma unroll
    for (int et = 0; et < 8; ++et) { f32x4 a = (f32x4){0.f, 0.f, 0.f, 0.f};
#pragma unroll
        for (int ks = 0; ks < 4; ++ks) a = MFMA16(*(const LAS bf16x8*)(Simg + offb(16 * et + fr, 4 * ks + fq)), qf[ks], a);
        O[et] = a * sf; }
    bf16x8 pf[4];
#pragma unroll
    for (int k2 = 0; k2 < 4; ++k2) {
        v4u pw;
#pragma unroll
        for (int hf = 0; hf < 2; ++hf) { const int mt = 2 * k2 + hf; f32x4 sacc = (f32x4){0.f, 0.f, 0.f, 0.f};
#pragma unroll
            for (int ks = 0; ks < 4; ++ks) sacc = MFMA16(*(const LAS bf16x8*)(Kimg + offb(16 * mt + fr, 4 * ks + fq)), qf[ks], sacc);
#pragma unroll
            for (int j = 0; j < 4; ++j) { const int df = nl - (16 * mt + 4 * fq + j); sacc[j] *= (df >= 0) ? exp2f((float)df * l2f) : exp2f((float)(-df) * l2b); }
            if (hf == 0) { pw.x = pk2(sacc[0], sacc[1]); pw.y = pk2(sacc[2], sacc[3]); } else { pw.z = pk2(sacc[0], sacc[1]); pw.w = pk2(sacc[2], sacc[3]); } }
        pf[k2] = __builtin_bit_cast(bf16x8, pw);
    }
#pragma unroll
    for (int et = 0; et < 8; ++et)
#pragma unroll
        for (int ks = 0; ks < 4; ++ks) { const unsigned r0 = 32 * ks + 4 * fq + q4;
            const bf16x8 va = cat8(tr_read(Vimg + offb(r0, 2 * et + (pp >> 1)) + 8 * (pp & 1)), tr_read(Vimg + offb(r0 + 16, 2 * et + (pp >> 1)) + 8 * (pp & 1)));
            O[et] = MFMA16(va, pf[ks], O[et]); }
    __syncthreads();
#pragma unroll
    for (int i = 0; i < 4; ++i) { const int id = tid + 512 * i; *(LAS v4u*)(Simg + offb(id >> 4, id & 15)) = sbr[i]; }
    __syncthreads();
#pragma unroll
    for (int et = 0; et < 8; ++et) { f32x4 a = (f32x4){0.f, 0.f, 0.f, 0.f};
#pragma unroll
        for (int ks = 0; ks < 4; ++ks) a = MFMA16(*(const LAS bf16x8*)(Simg + offb(16 * et + fr, 4 * ks + fq)), qf[ks], a);
        O[et] = O[et] + a * sbv; }
    float s1 = 0.f;
#pragma unroll
    for (int et = 0; et < 8; ++et) s1 += (O[et][0] + O[et][1]) + (O[et][2] + O[et][3]);
    s1 += __shfl_xor(s1, 16); s1 += __shfl_xor(s1, 32);
    const float mu = s1 * (1.f / 128.f); float s2 = 0.f;
#pragma unroll
    for (int et = 0; et < 8; ++et) { O[et] = O[et] - mu; s2 += (O[et][0] * O[et][0] + O[et][1] * O[et][1]) + (O[et][2] * O[et][2] + O[et][3] * O[et][3]); }
    s2 += __shfl_xor(s2, 16); s2 += __shfl_xor(s2, 32);
    const float rstd = rsqrtf(s2 * (1.f / 128.f) + EPSV);
#pragma unroll
    for (int et = 0; et < 8; ++et) { v2u w; w.x = pk2(O[et][0] * rstd, O[et][1] * rstd); w.y = pk2(O[et][2] * rstd, O[et][3] * rstd); *(LAS v2u*)(Ost + fr * 272 + (16 * et + 4 * fq) * 2) = w; }
    asm volatile("s_waitcnt lgkmcnt(0)" ::: "memory");
#pragma unroll
    for (int i = 0; i < 4; ++i) { const int id = lane + 64 * i, row = id >> 4, ch = id & 15;
        const v4u on = *(const LAS v4u*)(Ost + row * 272 + ch * 16);
        const size_t tok = tok0 + 16 * wave + row;
        const v4u g = *(const v4u*)(PROJ + tok * PROJ_LD + PC_R + h * 128 + ch * 8);
        const f32x4 g0 = *(const f32x4*)(p.gn_gain + h * 128 + ch * 8), g1 = *(const f32x4*)(p.gn_gain + h * 128 + ch * 8 + 4);
        v4u o;
        o.x = pk2(bflo(on.x) * g0[0] * bflo(g.x), bfhi(on.x) * g0[1] * bfhi(g.x)); o.y = pk2(bflo(on.y) * g0[2] * bflo(g.y), bfhi(on.y) * g0[3] * bfhi(g.y));
        o.z = pk2(bflo(on.z) * g1[0] * bflo(g.z), bfhi(on.z) * g1[1] * bfhi(g.z)); o.w = pk2(bflo(on.w) * g1[2] * bflo(g.w), bfhi(on.w) * g1[3] * bfhi(g.w));
        *(v4u*)(MIX + tok * 1024 + 512 + h * 128 + ch * 8) = o; }
}

constexpr int FFT_IN = 0, FFT_STG = 65536, FFT_A2 = 98304, FFT_CT = 114688;
DI void fft_setup(LAS unsigned char* lds, int tid, int lane, bf16x8 (&m1)[2][4]) {
    LAS float* ct = (LAS float*)(lds + FFT_CT);
    for (int i = tid; i < 2048; i += 512) ct[i] = cospif((float)i * (1.f / 1024.f));
    __syncthreads();
    const int fr = lane & 15, fq = lane >> 4;
#pragma unroll
    for (int pq = 0; pq < 2; ++pq)
#pragma unroll
        for (int c4 = 0; c4 < 4; ++c4) { const int ri = c4 >> 1, k1 = 16 * (c4 & 1) + fr; float v[8];
#pragma unroll
            for (int i = 0; i < 8; ++i) { const int l1 = 8 * fq + i, idx = ((k1 * l1) & 31) * 64; const float C = ct[idx], S = ct[(idx - 512) & 2047];
                v[i] = (pq == 0 && ri == 0) ? C : ((pq == 1 && ri == 1) ? -C : -S); }
            v4u w; w.x = pk2(v[0], v[1]); w.y = pk2(v[2], v[3]); w.z = pk2(v[4], v[5]); w.w = pk2(v[6], v[7]); m1[pq][c4] = __builtin_bit_cast(bf16x8, w); }
    for (int e = tid; e < 1024; e += 512) { const int ln = e & 63, fr2 = ln & 15, fq2 = ln >> 4, ks2 = (e >> 6) & 3, mt = e >> 8, ri = ks2 >> 1, base = 32 * (ks2 & 1), k2 = 16 * mt + fr2; float v[8];
#pragma unroll
        for (int i = 0; i < 8; ++i) { const int l2 = base + ((i < 4) ? 4 * fq2 + i : 16 + 4 * fq2 + (i - 4)), idx = ((k2 * l2) & 63) * 32; v[i] = ri ? ct[(idx - 512) & 2047] : ct[idx]; }
        v4u w; w.x = pk2(v[0], v[1]); w.y = pk2(v[2], v[3]); w.z = pk2(v[4], v[5]); w.w = pk2(v[6], v[7]); *(LAS v4u*)(lds + FFT_A2 + e * 16) = w; }
    __syncthreads();
}
DI void fft_decode(int v, int& b, int& g, int& s8) {
    const int i = v >> 8, w = v & 255, x = w & 7, j = w >> 3, bg = i * 16 + x * 2 + (j >> 4);
    s8 = j & 15; b = bg >> 2; g = bg & 3;
}
DI void fft_units(const Params& p, LAS unsigned char* lds, int tid, int lane, int wave, const bf16x8 (&m1)[2][4]) {
    const bf16* PROJ = (const bf16*)(p.ws + WS_PROJ); const bf16* ZT = (const bf16*)(p.ws + WS_ZT); bf16* MIX = (bf16*)(p.ws + WS_MIX);
    const int fr = lane & 15, fq = lane >> 4, q4 = fr >> 2, pp = fr & 3;
    LAS unsigned char* img = lds + FFT_IN + wave * 8192;
    const LAS float* ct = (const LAS float*)(lds + FFT_CT);
    LAS unsigned char* stg = lds + FFT_STG;
    int v = blockIdx.x; if (v >= 1024) return;
    int b, g, s8; fft_decode(v, b, g, s8);
    v4u ld[8];
    { const bf16* src = ZT + ((size_t)b * 1024 + (g * 128 + 8 * s8) * 2) * SEQ;
#pragma unroll
      for (int i = 0; i < 8; ++i) ld[i] = *(const v4u*)(src + (size_t)(tid + 512 * i) * 8); }
#pragma unroll 1
    for (; v < 1024; v += gridDim.x) {
        __syncthreads();
#pragma unroll
        for (int i = 0; i < 8; ++i) *(LAS v4u*)(lds + FFT_IN + (tid + 512 * i) * 16) = ld[i];
        __syncthreads();
        v4u gt[4];
#pragma unroll
        for (int i = 0; i < 4; ++i) gt[i] = *(const v4u*)(PROJ + ((size_t)b * SEQ + tid + 512 * i) * PROJ_LD + PC_G + g * 128 + 8 * s8);
        const int cb = b, cg = g, cs8 = s8;
        if (v + (int)gridDim.x < 1024) { fft_decode(v + gridDim.x, b, g, s8);
            const bf16* src = ZT + ((size_t)b * 1024 + (g * 128 + 8 * s8) * 2) * SEQ;
#pragma unroll
            for (int i = 0; i < 8; ++i) ld[i] = *(const v4u*)(src + (size_t)(tid + 512 * i) * 8); }
        f32x4 D1[4][4];
#pragma unroll
        for (int rt = 0; rt < 4; ++rt) {
            LAS unsigned char* a0 = img + (8 * fq + q4) * 128 + (16 * rt + 4 * pp) * 2;
            const bf16x8 ap = cat8(tr_read(a0), tr_read(a0 + 512)), aq = cat8(tr_read(a0 + 4096), tr_read(a0 + 4096 + 512));
#pragma unroll
            for (int c4 = 0; c4 < 4; ++c4) { f32x4 d = (f32x4){0.f, 0.f, 0.f, 0.f}; d = MFMA16(ap, m1[0][c4], d); d = MFMA16(aq, m1[1][c4], d); D1[rt][c4] = d; }
        }
        bf16x8 b2[4][2];
#pragma unroll
        for (int kt = 0; kt < 2; ++kt)
#pragma unroll
            for (int hf = 0; hf < 2; ++hf) { v4u wre, wim;
#pragma unroll
                for (int hh = 0; hh < 2; ++hh) { const int rt = 2 * hf + hh; float re[4], im[4];
#pragma unroll
                    for (int j = 0; j < 4; ++j) { const int idx = (16 * kt + fr) * (16 * rt + 4 * fq + j); const float c = ct[idx], sn = ct[(idx - 512) & 2047];
                        const float tr = D1[rt][kt][j], ti = D1[rt][2 + kt][j]; re[j] = tr * c + ti * sn; im[j] = ti * c - tr * sn; }
                    if (hh == 0) { wre.x = pk2(re[0], re[1]); wre.y = pk2(re[2], re[3]); wim.x = pk2(im[0], im[1]); wim.y = pk2(im[2], im[3]); }
                    else { wre.z = pk2(re[0], re[1]); wre.w = pk2(re[2], re[3]); wim.z = pk2(im[0], im[1]); wim.w = pk2(im[2], im[3]); } }
                b2[hf][kt] = __builtin_bit_cast(bf16x8, wre); b2[2 + hf][kt] = __builtin_bit_cast(bf16x8, wim); }
#pragma unroll
        for (int mt = 0; mt < 4; ++mt) {
            bf16x8 a2[4];
#pragma unroll
            for (int ks2 = 0; ks2 < 4; ++ks2) a2[ks2] = *(const LAS bf16x8*)(lds + FFT_A2 + ((mt * 4 + ks2) * 64 + lane) * 16);
#pragma unroll
            for (int kt = 0; kt < 2; ++kt) { f32x4 d = (f32x4){0.f, 0.f, 0.f, 0.f};
#pragma unroll
                for (int ks2 = 0; ks2 < 4; ++ks2) d = MFMA16(a2[ks2], b2[ks2][kt], d);
#pragma unroll
                for (int j = 0; j < 4; ++j) { const int k = (16 * kt + fr) + 32 * (16 * mt + 4 * fq + j); *(LAS unsigned short*)(stg + k * 16 + wave * 2) = (unsigned short)f2bf(d[j]); } }
        }
        __syncthreads();
#pragma unroll
        for (int i = 0; i < 4; ++i) { const int k = tid + 512 * i; const size_t tok = (size_t)cb * SEQ + k;
            const v4u y = *(const LAS v4u*)(stg + k * 16);
            v4u o; o.x = pk2(bflo(y.x) * bflo(gt[i].x), bfhi(y.x) * bfhi(gt[i].x)); o.y = pk2(bflo(y.y) * bflo(gt[i].y), bfhi(y.y) * bfhi(gt[i].y));
            o.z = pk2(bflo(y.z) * bflo(gt[i].z), bfhi(y.z) * bfhi(gt[i].z)); o.w = pk2(bflo(y.w) * bflo(gt[i].w), bfhi(y.w) * bfhi(gt[i].w));
            *(v4u*)(MIX + tok * 1024 + cg * 128 + 8 * cs8) = o; }
    }
}

DI void phase6(const Params& p, int lane, int wave) {
    const float* ADA = (const float*)(p.ws + WS_ADA); const float* rowss = (const float*)(p.ws + WS_ROWSS); const bf16* Y = (const bf16*)(p.ws + WS_Y);
    const int gw = blockIdx.x * 8 + wave, NGW = gridDim.x * 8, rpw = (MTOK + NGW - 1) / NGW;
    int r0 = gw * rpw, r1 = r0 + rpw; if (r1 > MTOK) r1 = MTOK;
    int vcur = -1; f32x4 gg[4];
    for (int r = r0; r < r1; ++r) {
        const int v = r >> 11;
        if (v != vcur) { vcur = v;
#pragma unroll
            for (int j = 0; j < 4; ++j) { const int col = lane * 4 + 256 * j; gg[j] = *(const f32x4*)(p.g_post + col) * *(const f32x4*)(ADA + v * 3072 + 2048 + col); } }
        float ssum = (lane < 16) ? rowss[(size_t)r * 16 + lane] : 0.f;
#pragma unroll
        for (int o = 1; o < 16; o <<= 1) ssum += __shfl_xor(ssum, o);
        ssum = __shfl(ssum, 0);
        const float rstd = rsqrtf(ssum * (1.f / 1024.f) + EPSV);
#pragma unroll
        for (int j = 0; j < 4; ++j) { const int col = lane * 4 + 256 * j;
            const f32x4 xv = *(const f32x4*)(p.x + (size_t)r * 1024 + col); const v2u yv = *(const v2u*)(Y + (size_t)r * 1024 + col);
            f32x4 o; o[0] = xv[0] + gg[j][0] * (bflo(yv.x) * rstd); o[1] = xv[1] + gg[j][1] * (bfhi(yv.x) * rstd); o[2] = xv[2] + gg[j][2] * (bflo(yv.y) * rstd); o[3] = xv[3] + gg[j][3] * (bfhi(yv.y) * rstd);
            *(f32x4*)(p.out + (size_t)r * 1024 + col) = o; }
    }
}

#define XB_TMO      128
#define XB_XCNT(j)  (256  + 64 * (j))
#define XB_XSUB(j)  (1280 + 64 * (j))
#define XB_XGEN(j)  (2304 + 64 * (j))
#define XB_TOP      3328
#define XB_TOPGEN   3392
#define XCD_BAR_WORDS 3456
#define XB_SPIN_CAP (1u << 18)

__device__ __forceinline__ unsigned xb_ld(unsigned* p)              { return __hip_atomic_load(p, __ATOMIC_RELAXED, __HIP_MEMORY_SCOPE_AGENT); }
__device__ __forceinline__ unsigned xb_add(unsigned* p, unsigned v) { return __hip_atomic_fetch_add(p, v, __ATOMIC_RELAXED, __HIP_MEMORY_SCOPE_AGENT); }
__device__ __forceinline__ unsigned xb_xcc_id() { return (unsigned)__builtin_amdgcn_s_getreg((3 << 11) | 20) & 0xFu; }
#define XB_SPIN(cond, bar) do { unsigned _sp = 0; while (cond) { __builtin_amdgcn_s_sleep(1); \
    if ((++_sp & 255u) == 0u) { if (xb_ld(&(bar)[XB_TMO])) break; if (_sp > XB_SPIN_CAP) { atomicAdd(&(bar)[XB_TMO], 1u); break; } } } } while (0)

struct XcdBarrier {
    unsigned* bar; unsigned x;
    volatile LAS unsigned* st;
};

__device__ __forceinline__ XcdBarrier xcd_barrier_post(unsigned* bar, volatile LAS unsigned* st) {
    XcdBarrier b; b.bar = bar; b.x = xb_xcc_id(); b.st = st;
    if (threadIdx.x == 0) (void)xb_add(&bar[XB_XCNT(b.x)], 1u);
    return b;
}
__device__ __forceinline__ void xcd_barrier_complete(unsigned* bar, unsigned x, unsigned& nloc, unsigned& nx) {
    const unsigned G = gridDim.x * gridDim.y * gridDim.z;
    unsigned sum, cnt, mine, sp = 0u;
    for (;;) {
        sum = 0u; cnt = 0u; mine = 0u;
#pragma unroll
        for (unsigned j = 0; j < 16; ++j) { const unsigned c = xb_ld(&bar[XB_XCNT(j)]); sum += c; cnt += (c > 0u) ? 1u : 0u; mine = (j == x) ? c : mine; }
        if (sum == G) break;
        __builtin_amdgcn_s_sleep(1);
        if ((++sp & 255u) == 0u) { if (xb_ld(&bar[XB_TMO])) break; if (sp > XB_SPIN_CAP) { atomicAdd(&bar[XB_TMO], 1u); break; } }
    }
    nloc = mine > 0u ? mine : 1u; nx = cnt > 0u ? cnt : 1u;
}

__device__ __forceinline__ void xcd_barrier(const XcdBarrier& b) {
    asm volatile("s_waitcnt vmcnt(0)" ::: "memory");
    __syncthreads();
    if (threadIdx.x == 0) {
        unsigned* bar = b.bar;
        __builtin_amdgcn_s_waitcnt(0);
        unsigned nloc = b.st[0], nx = b.st[1];
        if (nloc == 0u) { xcd_barrier_complete(bar, b.x, nloc, nx); b.st[0] = nloc; b.st[1] = nx; }
        const unsigned old = xb_add(&bar[XB_XSUB(b.x)], 1u);
        const unsigned gen = old / nloc;
        if (old + 1u == (gen + 1u) * nloc) {
            __builtin_amdgcn_fence(__ATOMIC_RELEASE, "agent");
            asm volatile("s_waitcnt vmcnt(0)" ::: "memory");
            const unsigned og = xb_add(&bar[XB_TOP], 1u);
            const unsigned tg = og / nx;
            if (og + 1u == (tg + 1u) * nx) xb_add(&bar[XB_TOPGEN], 1u);
            else XB_SPIN(xb_ld(&bar[XB_TOPGEN]) == tg, bar);
            __builtin_amdgcn_fence(__ATOMIC_ACQUIRE, "agent");
            xb_add(&bar[XB_XGEN(b.x)], 1u);
            asm volatile("s_waitcnt vmcnt(0)" ::: "memory");
        } else {
            XB_SPIN(xb_ld(&bar[XB_XGEN(b.x)]) == gen, bar);
            __builtin_amdgcn_fence(__ATOMIC_ACQUIRE, "agent");
            asm volatile("s_waitcnt vmcnt(0)" ::: "memory");
        }
    }
    __syncthreads();
}


__global__ void __launch_bounds__(512, 2) hymba_fwd(Params p) {
    extern __shared__ __attribute__((aligned(16))) unsigned char lds_raw[];
    LAS unsigned char* lds = (LAS unsigned char*)lds_raw;
    cg::grid_group grid = cg::this_grid();
    const int tid = threadIdx.x, lane = tid & 63, wave = __builtin_amdgcn_readfirstlane(tid >> 6);
    const int lo = p.ph_lo, hi = p.ph_hi;
    volatile LAS unsigned* misc = (volatile LAS unsigned*)(lds + LDS_MISC);
    if (tid < 4) misc[tid] = 0u;
    __syncthreads();
    XcdBarrier bar = xcd_barrier_post((unsigned*)p.ws, misc);
#define IN(k) (lo <= (k) && (k) < hi)
#ifndef REP2
#define REP2 1
#endif
#ifndef REP3
#define REP3 1
#endif
#ifndef REP4
#define REP4 1
#endif
#define SEAM(k) do { if (IN(k) && IN((k) + 1)) { if (p.use_cg) grid.sync(); else xcd_barrier(bar); } } while (0)
    bf16* RA = (bf16*)(p.ws + WS_RA);
    if (IN(0)) phase0(p, lds, tid, lane, wave);
#if defined(REP0)
    __syncthreads(); if (IN(0)) phase0(p, lds, tid, lane, wave);
#endif
    SEAM(0);
    if (IN(1)) phase1(p, lane, wave);
#if defined(REP1)
    if (IN(1)) phase1(p, lane, wave);
#endif
    SEAM(1);
    if (IN(2)) {
        pg8::Gemm g{RA, RA, RA_ROWS, RA_ROWS, 1024}; G1Order S{(int)gridDim.x, (int)blockIdx.x};
        EpiG1 E{(bf16*)(p.ws + WS_PROJ), (bf16*)(p.ws + WS_ZT), (bf16*)(p.ws + WS_KVC), (const float*)(p.ws + WS_ROPE)};
        pg8::gemm_phase<EpiG1, G1Order, true, true>(lds, g, S, E);
    }
#if REP2 == 2
    __syncthreads();
    if (IN(2)) {
        pg8::Gemm g{RA, RA, RA_ROWS, RA_ROWS, 1024}; G1Order S{(int)gridDim.x, (int)blockIdx.x};
        EpiG1 E{(bf16*)(p.ws + WS_PROJ), (bf16*)(p.ws + WS_ZT), (bf16*)(p.ws + WS_KVC), (const float*)(p.ws + WS_ROPE)};
        pg8::gemm_phase<EpiG1, G1Order, true, true>(lds, g, S, E);
    }
#endif
    SEAM(2);
    if (IN(3)) {
        for (int u = blockIdx.x; u < 256; u += gridDim.x) { state_unit(p, lds, u, tid, lane, wave); __syncthreads(); }
        { bf16x8 m1[2][4]; fft_setup(lds, tid, lane, m1);
          fft_units(p, lds, tid, lane, wave, m1); }
    }
#if REP3 == 2
    __syncthreads();
    if (IN(3)) {
        for (int u = blockIdx.x; u < 256; u += gridDim.x) { state_unit(p, lds, u, tid, lane, wave); __syncthreads(); }
        { bf16x8 m1[2][4]; fft_setup(lds, tid, lane, m1);
          fft_units(p, lds, tid, lane, wave, m1); }
    }
#endif
    SEAM(3);
    if (IN(4)) for (int rep = 0; rep < REP4; ++rep) { for (int u = blockIdx.x; u < 1024; u += gridDim.x) ret_unit(p, lds, u, tid, lane, wave); }
    SEAM(4);
#if defined(REPS)
    xcd_barrier(bar); xcd_barrier(bar); xcd_barrier(bar); xcd_barrier(bar);
#endif
    if (IN(5)) {
        __syncthreads();
        pg8::Gemm g{(const bf16*)(p.ws + WS_MIX), (const bf16*)(p.ws + WS_WOT), MTOK, 1024, 1024}; pg8::StaticOrder S; S.init(MTOK, 1024, (int)gridDim.x, (int)blockIdx.x);
        EpiOut E{(bf16*)(p.ws + WS_Y), (float*)(p.ws + WS_ROWSS)};
        pg8::gemm_phase<EpiOut, pg8::StaticOrder, true, true>(lds, g, S, E);
    }
#if defined(REP5)
    __syncthreads();
    if (IN(5)) {
        __syncthreads();
        pg8::Gemm g{(const bf16*)(p.ws + WS_MIX), (const bf16*)(p.ws + WS_WOT), MTOK, 1024, 1024}; pg8::StaticOrder S; S.init(MTOK, 1024, (int)gridDim.x, (int)blockIdx.x);
        EpiOut E{(bf16*)(p.ws + WS_Y), (float*)(p.ws + WS_ROWSS)};
        pg8::gemm_phase<EpiOut, pg8::StaticOrder, true, true>(lds, g, S, E);
    }
#endif
    SEAM(5);
    if (IN(6)) phase6(p, lane, wave);
#if defined(REP6)
    if (IN(6)) phase6(p, lane, wave);
#endif
#undef IN
#undef SEAM
}

#ifndef N_LAUNCHES
#define N_LAUNCHES 1
#endif
extern "C" void kernel_launch(void* const* d_in, const int* in_sizes, int n_in, void* d_out, int out_size, void* d_ws, size_t ws_size, hipStream_t stream) {
    static int grid = 0;
    if (grid == 0) {
        if (n_in != 13 || out_size != MTOK * DM || ws_size < WS_END) { fprintf(stderr, "kernel_launch: unexpected shapes (n_in %d out %d ws %zu)\n", n_in, out_size, ws_size); grid = -1; return; }
        int dev = 0, cus = 0, per_cu = 0;
        hipGetDevice(&dev); hipDeviceGetAttribute(&cus, hipDeviceAttributeMultiprocessorCount, dev);
        if (hipFuncSetAttribute((const void*)hymba_fwd, hipFuncAttributeMaxDynamicSharedMemorySize, LDS_BYTES) != hipSuccess) { fprintf(stderr, "kernel_launch: hipFuncSetAttribute failed\n"); grid = -1; return; }
        if (hipOccupancyMaxActiveBlocksPerMultiprocessor(&per_cu, (const void*)hymba_fwd, 512, LDS_BYTES) != hipSuccess || per_cu < 1) { fprintf(stderr, "kernel_launch: occupancy query says %d\n", per_cu); per_cu = 1; }
        (void)hipGetLastError();
        grid = cus > 256 ? 256 : cus;
    }
    if (grid < 0) return;
    Params p{};
    p.x = (const float*)d_in[0]; p.c = (const float*)d_in[1]; p.ctx = (const float*)d_in[2]; p.c_ctx = (const float*)d_in[3];
    p.w_ada = (const float*)d_in[4]; p.b_ada = (const float*)d_in[5]; p.g_pre = (const float*)d_in[6]; p.g_post = (const float*)d_in[7];
    p.w_in = (const float*)d_in[8]; p.w_fourier = (const float*)d_in[9]; p.decay_logit = (const float*)d_in[10]; p.gn_gain = (const float*)d_in[11]; p.w_out = (const float*)d_in[12];
    p.out = (float*)d_out; p.ws = (unsigned char*)d_ws;
    if (hipMemsetAsync(d_ws, 0, 16384, stream) != hipSuccess) { fprintf(stderr, "kernel_launch: memset failed\n"); return; }
    if (N_LAUNCHES == 1) {
        p.ph_lo = 0; p.ph_hi = 7; p.use_cg = 0;
        void* args[] = {&p};
        hipError_t e = hipLaunchCooperativeKernel((const void*)hymba_fwd, dim3(grid), dim3(512), args, LDS_BYTES, stream);
        if (e != hipSuccess) fprintf(stderr, "cooperative launch failed: %s (grid %d)\n", hipGetErrorString(e), grid);
    } else {
        for (int ph = 0; ph < 7; ++ph) { p.ph_lo = ph; p.ph_hi = ph + 1; hipLaunchKernelGGL(hymba_fwd, dim3(grid), dim3(512), LDS_BYTES, stream, p); }
    }
}
```

```cpp
#include <hip/hip_runtime.h>
#include <hip/hip_cooperative_groups.h>
#include <cstdio>
#include <cstdint>
namespace cg = cooperative_groups;
namespace pg8 {
#define PG8_LAS __attribute__((address_space(3)))
typedef unsigned short bf16_t;
typedef short bf16x8 __attribute__((ext_vector_type(8)));
typedef float f32x4 __attribute__((ext_vector_type(4)));
typedef unsigned u32x4 __attribute__((ext_vector_type(4)));
constexpr int BM = 256, BK = 64, HALF = 128, HTB = HALF * BK * 2  , STAGE_BYTES = 8 * HTB, NXCD = 8, WGM = 8;

__host__ __device__ __forceinline__ int lds_byte(int r, int c) { const int st = (r >> 4) * 2 + (c >> 5), rr = r & 15, cc = c & 31, ob = rr * 64 + cc * 2; return st * 1024 + (ob ^ (((ob >> 9) & 1) << 5)); }
__host__ __device__ __forceinline__ void stage_rc(int b, int& R, int& C) { const int st = b / 1024, sb = b % 1024, swz = sb ^ (((sb >> 9) & 1) << 5); R = (st >> 1) * 16 + swz / 64; C = (st & 1) * 32 + (swz % 64) / 2; }
__host__ __device__ __forceinline__ int perm32(int rho) { const int n = rho >> 4, i = rho & 15; return 8 * (i >> 2) + 4 * n + (i & 3); }

struct Unit { int pm, pn; };
struct Gemm { const bf16_t* A; const bf16_t* Bt; int M, N, K, ld; };

struct StaticOrder {
    int nM, nN, nwg, G, c;
    __host__ __device__ void init(int M, int N, int G_, int c_) { nM = M / BM; nN = N / BM; nwg = nM * nN; G = G_; c = c_; }
    __host__ __device__ bool next(int i, Unit& u) const {
        const long L = (long)i * G + c; if (L >= nwg) return false;
        int wgid = (int)L; { const int q = nwg / NXCD, r = nwg % NXCD, xcd = wgid % NXCD, off = wgid / NXCD; wgid = (xcd < r ? xcd * (q + 1) : r * (q + 1) + (xcd - r) * q) + off; }
        const int nig = WGM * nN, gid = wgid / nig, fm = gid * WGM, gsz = (nM - fm) < WGM ? (nM - fm) : WGM;
        u.pm = fm + ((wgid % nig) % gsz); u.pn = (wgid % nig) / gsz; return true;
    }
    __device__ __forceinline__ void a_ready(const Unit&) const {}
    __device__ __forceinline__ void done(const Unit&) const {}
};

__device__ __forceinline__ unsigned cvt_pk_bf16(float lo, float hi) { unsigned r; asm volatile("v_cvt_pk_bf16_f32 %0, %1, %2" : "=v"(r) : "v"(lo), "v"(hi)); return r; }

template <class Epi, class Sched, bool ALIGN_EPI = false, bool SP2 = false>
__device__ __forceinline__ void gemm_phase(PG8_LAS unsigned char* lds, const Gemm g, const Sched& S, const Epi& E) {
    const int tid = threadIdx.x, wid = __builtin_amdgcn_readfirstlane(tid >> 6), lane = tid & 63, wr = wid >> 2, wc = wid & 3, fr = lane & 15, fq = lane >> 4;
    const int K = g.K, nt = K / BK;
    unsigned voffA[2], voffB[2];
#pragma unroll
    for (int i = 0; i < 2; ++i) { int R, C; stage_rc(tid * 16 + i * 8192, R, C); const int Rb = Epi::PERM ? ((R & ~31) + perm32(R & 31)) : R;
        voffA[i] = (unsigned)(R * g.ld + C) * 2u; voffB[i] = (unsigned)(Rb * g.ld + C) * 2u; }
    const size_t kstep = (size_t)(BK * 2);
    const size_t hstep = (size_t)HALF * g.ld * 2;
    const size_t tstep = 2 * hstep;
    const unsigned ldsw = (unsigned)wid * 1024u;
    const int aoff = lds_byte(wr * 64 + fr, fq * 8), boff = lds_byte(wc * 32 + fr, fq * 8);
#define PG8_SA(b, h) (((b) * 2 + (h)) * HTB)
#define PG8_SB(b, h) ((4 + (b) * 2 + (h)) * HTB)
#define PG8_STAGE(bufoff, gbase, voff) do { _Pragma("unroll") for (int _i = 0; _i < 2; ++_i) \
        __builtin_amdgcn_global_load_lds((const unsigned*)((const char*)(gbase) + (voff)[_i]), (PG8_LAS unsigned*)(lds + (bufoff) + ldsw + _i * 8192), 16, 0, 0); } while (0)
#define PG8_LDA(dst, b, h) do { _Pragma("unroll") for (int m = 0; m < 4; ++m) _Pragma("unroll") for (int k = 0; k < 2; ++k) dst[m][k] = *(const PG8_LAS bf16x8*)(lds + PG8_SA(b, h) + aoff + m * 2048 + k * 1024); } while (0)
#define PG8_LDB(dst, b, h) do { _Pragma("unroll") for (int n = 0; n < 2; ++n) _Pragma("unroll") for (int k = 0; k < 2; ++k) dst[n][k] = *(const PG8_LAS bf16x8*)(lds + PG8_SB(b, h) + boff + n * 2048 + k * 1024); } while (0)
#define PG8_MMA(ai, bj, At, Bt) do { __builtin_amdgcn_s_setprio(1); _Pragma("unroll") for (int m = 0; m < 4; ++m) _Pragma("unroll") for (int n = 0; n < 2; ++n) _Pragma("unroll") for (int k = 0; k < 2; ++k) \
        acc[ai][bj][m][n] = __builtin_amdgcn_mfma_f32_16x16x32_bf16(Bt[n][k], At[m][k], acc[ai][bj][m][n], 0, 0, 0); __builtin_amdgcn_s_setprio(0); } while (0)
#define PG8_WAIT_V(n) asm volatile("s_waitcnt vmcnt(" #n ")" ::: "memory")
#define PG8_WAIT_L(n) asm volatile("s_waitcnt lgkmcnt(" #n ")" ::: "memory")
#define PG8_BAR __builtin_amdgcn_s_barrier()
#define PG8_SCHED __builtin_amdgcn_sched_barrier(0)
    Unit cur, nxt; int ui = 0;
    if (!S.next(0, cur)) return;
    f32x4 acc[2][2][4][2];
#pragma unroll
    for (int a = 0; a < 2; ++a)
#pragma unroll
        for (int b = 0; b < 2; ++b)
#pragma unroll
            for (int m = 0; m < 4; ++m)
#pragma unroll
                for (int n = 0; n < 2; ++n) acc[a][b][m][n] = (f32x4){0.f, 0.f, 0.f, 0.f};
    bf16x8 At[4][2], B0[2][2], B1[2][2];
    const char* cA = (const char*)g.A + (size_t)cur.pm * tstep; const char* cB = (const char*)g.Bt + (size_t)cur.pn * tstep;
    S.a_ready(cur);
    if constexpr (SP2) {
        PG8_STAGE(PG8_SB(0, 0), cB, voffB); PG8_STAGE(PG8_SB(0, 1), cB + hstep, voffB); PG8_STAGE(PG8_SA(0, 0), cA, voffA); PG8_STAGE(PG8_SA(0, 1), cA + hstep, voffA);
        if (wr == 1) PG8_BAR;
        PG8_WAIT_V(2); PG8_BAR;
        PG8_STAGE(PG8_SB(1, 0), cB + kstep, voffB); PG8_STAGE(PG8_SA(1, 0), cA + kstep, voffA); PG8_STAGE(PG8_SB(1, 1), cB + hstep + kstep, voffB);
        PG8_WAIT_V(6); PG8_BAR;
    } else {
        PG8_STAGE(PG8_SB(0, 0), cB, voffB); PG8_STAGE(PG8_SA(0, 0), cA, voffA); PG8_STAGE(PG8_SB(0, 1), cB + hstep, voffB); PG8_STAGE(PG8_SA(0, 1), cA + hstep, voffA);
        if (wr == 1) PG8_BAR;
        PG8_WAIT_V(4); PG8_BAR;
        PG8_STAGE(PG8_SB(1, 0), cB + kstep, voffB); PG8_STAGE(PG8_SA(1, 0), cA + kstep, voffA); PG8_STAGE(PG8_SB(1, 1), cB + hstep + kstep, voffB);
        PG8_WAIT_V(6); PG8_BAR;
    }
    for (;;) {
        const bool has_next = S.next(ui + 1, nxt);
        const char* nA = has_next ? (const char*)g.A + (size_t)nxt.pm * tstep : cA; const char* nB = has_next ? (const char*)g.Bt + (size_t)nxt.pn * tstep : cB;
        for (int t = 0; t < nt; t += 2) {
            const bool last = (t == nt - 2);
            const char* a1 = cA + (size_t)(t + 1) * kstep;
            const char* a2 = last ? nA : cA + (size_t)(t + 2) * kstep; const char* b2 = last ? nB : cB + (size_t)(t + 2) * kstep;
            const char* a3 = a2 + kstep; const char* b3 = b2 + kstep;
            if (last && has_next) S.a_ready(nxt);
            if constexpr (SP2) {
            PG8_LDB(B0, 0, 0); PG8_LDB(B1, 0, 1); PG8_SCHED; PG8_LDA(At, 0, 0); PG8_STAGE(PG8_SA(1, 1), a1 + hstep, voffA);
            PG8_WAIT_V(8); PG8_WAIT_L(0); PG8_BAR; PG8_MMA(0, 0, At, B0); PG8_MMA(0, 1, At, B1); PG8_BAR; PG8_SCHED;
            PG8_LDA(At, 0, 1); PG8_STAGE(PG8_SB(0, 0), b2, voffB); PG8_STAGE(PG8_SB(0, 1), b2 + hstep, voffB); PG8_STAGE(PG8_SA(0, 0), a2, voffA);
            PG8_WAIT_V(8); PG8_WAIT_L(0); PG8_BAR; PG8_MMA(1, 0, At, B0); PG8_MMA(1, 1, At, B1); PG8_BAR; PG8_SCHED;
            PG8_LDB(B0, 1, 0); PG8_LDB(B1, 1, 1); PG8_SCHED; PG8_LDA(At, 1, 0); PG8_STAGE(PG8_SA(0, 1), a2 + hstep, voffA);
            PG8_WAIT_V(8); PG8_WAIT_L(0); PG8_BAR; PG8_MMA(0, 0, At, B0); PG8_MMA(0, 1, At, B1); PG8_BAR; PG8_SCHED;
            PG8_LDA(At, 1, 1); PG8_STAGE(PG8_SB(1, 0), b3, voffB); PG8_STAGE(PG8_SB(1, 1), b3 + hstep, voffB); PG8_STAGE(PG8_SA(1, 0), a3, voffA);
            PG8_WAIT_V(8); PG8_WAIT_L(0); PG8_BAR; PG8_MMA(1, 0, At, B0); PG8_MMA(1, 1, At, B1); PG8_BAR; PG8_SCHED;
            } else {
            PG8_LDB(B0, 0, 0); PG8_SCHED; PG8_LDA(At, 0, 0); PG8_STAGE(PG8_SA(1, 1), a1 + hstep, voffA);
            PG8_WAIT_L(8); PG8_BAR; PG8_WAIT_L(0); PG8_MMA(0, 0, At, B0); PG8_BAR; PG8_SCHED;
            PG8_LDB(B1, 0, 1); PG8_STAGE(PG8_SB(0, 0), b2, voffB);
            PG8_BAR; PG8_WAIT_L(0); PG8_MMA(0, 1, At, B1); PG8_BAR;
            PG8_LDA(At, 0, 1); PG8_STAGE(PG8_SA(0, 0), a2, voffA);
            PG8_BAR; PG8_WAIT_L(0); PG8_MMA(1, 0, At, B0); PG8_BAR; PG8_SCHED;
            PG8_STAGE(PG8_SB(0, 1), b2 + hstep, voffB);
            PG8_WAIT_V(6); PG8_BAR; PG8_MMA(1, 1, At, B1); PG8_BAR;
            PG8_LDB(B0, 1, 0); PG8_SCHED; PG8_LDA(At, 1, 0); PG8_STAGE(PG8_SA(0, 1), a2 + hstep, voffA);
            PG8_WAIT_L(8); PG8_BAR; PG8_WAIT_L(0); PG8_MMA(0, 0, At, B0); PG8_BAR; PG8_SCHED;
            PG8_LDB(B1, 1, 1); PG8_STAGE(PG8_SB(1, 0), b3, voffB);
            PG8_BAR; PG8_WAIT_L(0); PG8_MMA(0, 1, At, B1); PG8_BAR;
            PG8_LDA(At, 1, 1); PG8_STAGE(PG8_SA(1, 0), a3, voffA);
            PG8_BAR; PG8_WAIT_L(0); PG8_MMA(1, 0, At, B0); PG8_BAR; PG8_SCHED;
            PG8_STAGE(PG8_SB(1, 1), b3 + hstep, voffB);
            PG8_WAIT_V(6); PG8_BAR; PG8_MMA(1, 1, At, B1); PG8_BAR;
            }
        }
        if constexpr (ALIGN_EPI) { if (wr == 0) PG8_BAR; }
        if constexpr (!Epi::AFTER_DRAIN) { E(acc, cur, wr, wc, fr, fq); S.done(cur); }
        if (!has_next) break;
#pragma unroll
        for (int a = 0; a < 2; ++a)
#pragma unroll
            for (int b = 0; b < 2; ++b)
#pragma unroll
                for (int m = 0; m < 4; ++m)
#pragma unroll
                    for (int n = 0; n < 2; ++n) acc[a][b][m][n] = (f32x4){0.f, 0.f, 0.f, 0.f};
        cur = nxt; cA = nA; cB = nB; ++ui;
        if constexpr (ALIGN_EPI) { if (wr == 1) PG8_BAR; }
    }
    PG8_WAIT_V(0);
    if constexpr (!ALIGN_EPI) { if (wr == 0) PG8_BAR; }
    PG8_BAR;
    if constexpr (Epi::AFTER_DRAIN) { E.fused(acc, cur, wr, wc, fr, fq, lds, wid, lane); S.done(cur); }
#undef PG8_SA
#undef PG8_SB
#undef PG8_STAGE
#undef PG8_LDA
#undef PG8_LDB
#undef PG8_MMA
#undef PG8_WAIT_V
#undef PG8_WAIT_L
#undef PG8_BAR
#undef PG8_SCHED
}
}

#define LAS __attribute__((address_space(3)))
#define DI __device__ __forceinline__
typedef unsigned short bf16;
typedef unsigned v4u __attribute__((ext_vector_type(4)));
typedef unsigned v2u __attribute__((ext_vector_type(2)));
typedef float f32x4 __attribute__((ext_vector_type(4)));
typedef short bf16x8 __attribute__((ext_vector_type(8)));
typedef short s16x4 __attribute__((ext_vector_type(4)));

constexpr int NB = 16, SEQ = 2048, DM = 1024, MTOK = NB * SEQ, CTXL = 256, MCTX = NB * CTXL;
constexpr int PROJ_LD = 2560;
constexpr int PC_G = 0, PC_Q = 512, PC_K = 1024, PC_V = 1536, PC_R = 2048;
constexpr float EPSV = 1e-6f;
constexpr float QK_SCALE = 0.08838834764831845f;
constexpr int RT_CTX = 128, RT_W = 144, RT_WF = 154, RA_ROWS = 158 * 256;
constexpr int G1_MAIN = 1280, G1_FT = 512, G1_UNITS = G1_MAIN + G1_FT;

constexpr size_t MiB = 1u << 20;
constexpr size_t WS_ADA = 1 * MiB;
constexpr size_t WS_ROPE = WS_ADA + 256 * 1024;
constexpr size_t WS_ROWSS = 396 * MiB;
constexpr size_t WS_RA = 2 * MiB;
constexpr size_t WS_MIX = WS_RA;
constexpr size_t WS_PROJ = 82 * MiB;
constexpr size_t WS_Y = WS_PROJ;
constexpr size_t WS_KVC = 242 * MiB;
constexpr size_t WS_ZT = 250 * MiB;
constexpr size_t WS_DT = 314 * MiB;
constexpr size_t WS_ST = 330 * MiB;
constexpr size_t WS_WOT = 394 * MiB;
constexpr size_t WS_YT = 398 * MiB;
constexpr size_t WS_KVCP = 430 * MiB;
constexpr size_t WS_END = 462 * MiB;
constexpr int LDS_BYTES = 147456, LDS_MISC = 139264;

struct Params {
    const float *x, *c, *ctx, *c_ctx, *w_ada, *b_ada, *g_pre, *g_post, *w_in, *w_fourier, *decay_logit, *gn_gain, *w_out;
    float* out; unsigned char* ws; int ph_lo, ph_hi, use_cg, pad;
};

DI unsigned f2bf(float f) { unsigned u = __builtin_bit_cast(unsigned, f); return (u + 0x7fffu + ((u >> 16) & 1u)) >> 16; }
DI unsigned pk2(float lo, float hi) { unsigned r; asm("v_cvt_pk_bf16_f32 %0, %1, %2" : "=v"(r) : "v"(lo), "v"(hi)); return r; }
DI float bflo(unsigned u) { return __builtin_bit_cast(float, u << 16); }
DI float bfhi(unsigned u) { return __builtin_bit_cast(float, u & 0xffff0000u); }
DI float silu_f(float v) { return v / (1.f + __expf(-v)); }
DI float wave_sum(float v) {
#pragma unroll
    for (int o = 1; o < 64; o <<= 1) v += __shfl_xor(v, o);
    return v;
}
DI unsigned offb(unsigned row, unsigned ch) { return 256u * row + 16u * (ch ^ (((row & 3) << 2) | ((row >> 2) & 3))); }
DI s16x4 tr_read(LAS unsigned char* p) { return __builtin_amdgcn_ds_read_tr16_b64_v4i16((LAS s16x4*)p); }
DI bf16x8 cat8(s16x4 a, s16x4 b) { bf16x8 r; r[0] = a[0]; r[1] = a[1]; r[2] = a[2]; r[3] = a[3]; r[4] = b[0]; r[5] = b[1]; r[6] = b[2]; r[7] = b[3]; return r; }
#define MFMA16(a, b, c) __builtin_amdgcn_mfma_f32_16x16x32_bf16((a), (b), (c), 0, 0, 0)

struct G1Order {
    int G, c;
    DI bool next(int i, pg8::Unit& u) const {
        const int L = i * G + c; if (L >= G1_UNITS) return false;
        if (L < G1_MAIN) {
            const int wgid = (L & 7) * (G1_MAIN / 8) + (L >> 3);
            const int r80 = wgid % 80;
            u.pm = (wgid / 80) * 8 + (r80 & 7); u.pn = RT_W + (r80 >> 3);
        } else {
            const int l2 = L - G1_MAIN, idx = (l2 & 7) * (G1_FT / 8) + (l2 >> 3);
            u.pm = RT_WF + (idx & 3); u.pn = idx >> 2;
        }
        return true;
    }
    DI void a_ready(const pg8::Unit&) const {}
    DI void done(const pg8::Unit&) const {}
};

DI v4u pack8(f32x4 a, f32x4 b) { v4u w; w.x = pk2(a[0], a[1]); w.y = pk2(a[2], a[3]); w.z = pk2(b[0], b[1]); w.w = pk2(b[2], b[3]); return w; }

struct EpiG1 {
    static constexpr bool PERM = true, AFTER_DRAIN = false;
    bf16* PROJ; bf16* ZT; bf16* KVC; const float* rope;
    DI void operator()(const f32x4 (&acc)[2][2][4][2], const pg8::Unit& u, int wr, int wc, int fr, int fq) const {
        const int rl0 = wr * 64 + fr, cl0 = wc * 32 + 8 * fq;
        bf16* base; int ld, mode = 0; float sc = 1.f;
        if (u.pm < RT_CTX) {
            const int wt = u.pn - RT_W, type = wt >> 1;
            base = PROJ + (size_t)(u.pm * 256) * PROJ_LD + wt * 256; ld = PROJ_LD;
            mode = (type == 1 || type == 2) ? 1 : (type == 3 ? 0 : 2); sc = (type == 1) ? QK_SCALE : 1.f;
        } else if (u.pm >= RT_WF) {
            base = ZT + ((size_t)(u.pn >> 3) * 1024 + (u.pm - RT_WF) * 256) * SEQ + (u.pn & 7) * 256; ld = SEQ;
        } else {
            base = KVC + (size_t)((u.pm - RT_CTX) * 256) * 1024 + (u.pn - RT_W - 4) * 256; ld = 1024;
        }
        base += (size_t)rl0 * ld + cl0;
        const int lbase = (u.pm * 256 + rl0) & (SEQ - 1);
        const float* rbase = rope + (16 * (wc & 1) + 4 * fq) * 2;
#pragma unroll
        for (int ai = 0; ai < 2; ++ai)
#pragma unroll
            for (int m = 0; m < 4; ++m) {
                bf16* rowp = base + (size_t)(ai * 128 + m * 16) * ld;
                f32x4 v00 = acc[ai][0][m][0], v01 = acc[ai][0][m][1], v10 = acc[ai][1][m][0], v11 = acc[ai][1][m][1];
                if (mode == 1) {
                    const int l = lbase + ai * 128 + m * 16;
                    const int pos = (wc >> 1) ? (l & 63) : (l >> 6);
                    const f32x4 r0 = *(const f32x4*)(rbase + pos * 64), r1 = *(const f32x4*)(rbase + pos * 64 + 4);
                    f32x4 t;
                    t = v00 * sc; v00[0] = t[0] * r0[0] - t[1] * r0[1]; v00[1] = t[0] * r0[1] + t[1] * r0[0]; v00[2] = t[2] * r0[2] - t[3] * r0[3]; v00[3] = t[2] * r0[3] + t[3] * r0[2];
                    t = v01 * sc; v01[0] = t[0] * r1[0] - t[1] * r1[1]; v01[1] = t[0] * r1[1] + t[1] * r1[0]; v01[2] = t[2] * r1[2] - t[3] * r1[3]; v01[3] = t[2] * r1[3] + t[3] * r1[2];
                    t = v10 * sc; v10[0] = t[0] * r0[0] - t[1] * r0[1]; v10[1] = t[0] * r0[1] + t[1] * r0[0]; v10[2] = t[2] * r0[2] - t[3] * r0[3]; v10[3] = t[2] * r0[3] + t[3] * r0[2];
                    t = v11 * sc; v11[0] = t[0] * r1[0] - t[1] * r1[1]; v11[1] = t[0] * r1[1] + t[1] * r1[0]; v11[2] = t[2] * r1[2] - t[3] * r1[3]; v11[3] = t[2] * r1[3] + t[3] * r1[2];
                } else if (mode == 2) {
#pragma unroll
                    for (int j = 0; j < 4; ++j) { v00[j] = silu_f(v00[j]); v01[j] = silu_f(v01[j]); v10[j] = silu_f(v10[j]); v11[j] = silu_f(v11[j]); }
                }
                *(v4u*)(rowp) = pack8(v00, v01);
                *(v4u*)(rowp + 128) = pack8(v10, v11);
                asm volatile("" ::: "memory");
            }
    }
};

struct OneUnit { int pm, pn;
    DI bool next(int i, pg8::Unit& u) const { if (i) return false; u.pm = pm; u.pn = pn; return true; }
    DI void a_ready(const pg8::Unit&) const {}
    DI void done(const pg8::Unit&) const {}
};
struct EpiCtx {
    static constexpr bool PERM = true, AFTER_DRAIN = false;
    bf16* O;
    DI void operator()(const f32x4 (&acc)[2][2][4][2], const pg8::Unit& u, int wr, int wc, int fr, int fq) const {
        bf16* base = O + (size_t)((u.pm - RT_CTX) * 256 + wr * 64 + fr) * 1024 + (u.pn - RT_W - 4) * 256 + wc * 32 + 8 * fq;
#pragma unroll
        for (int ai = 0; ai < 2; ++ai)
#pragma unroll
            for (int m = 0; m < 4; ++m) { bf16* rowp = base + (size_t)(ai * 128 + m * 16) * 1024;
                *(v4u*)(rowp) = pack8(acc[ai][0][m][0], acc[ai][0][m][1]); *(v4u*)(rowp + 128) = pack8(acc[ai][1][m][0], acc[ai][1][m][1]); }
    }
};

struct EpiDft {
    static constexpr bool PERM = true, AFTER_DRAIN = false;
    const bf16* PROJ; bf16* MIX;
    DI void operator()(const f32x4 (&acc)[2][2][4][2], const pg8::Unit& u, int wr, int wc, int fr, int fq) const {
        const int rl0 = wr * 64 + fr, cl0 = wc * 32 + 8 * fq;
        const int b = u.pn >> 1, chg0 = (u.pn & 1) * 256 + cl0;
#pragma unroll
        for (int ai = 0; ai < 2; ++ai)
#pragma unroll
            for (int m = 0; m < 4; ++m) {
                const size_t tok = (size_t)b * SEQ + u.pm * 256 + rl0 + ai * 128 + m * 16;
#pragma unroll
                for (int bj = 0; bj < 2; ++bj) {
                    const v4u g = *(const v4u*)(PROJ + tok * PROJ_LD + PC_G + chg0 + bj * 128);
                    f32x4 v0 = acc[ai][bj][m][0], v1 = acc[ai][bj][m][1];
                    v0[0] *= bflo(g.x); v0[1] *= bfhi(g.x); v0[2] *= bflo(g.y); v0[3] *= bfhi(g.y);
                    v1[0] *= bflo(g.z); v1[1] *= bfhi(g.z); v1[2] *= bflo(g.w); v1[3] *= bfhi(g.w);
                    *(v4u*)(MIX + tok * 1024 + chg0 + bj * 128) = pack8(v0, v1);
                }
            }
    }
};

struct EpiOut {
    static constexpr bool PERM = true, AFTER_DRAIN = false;
    bf16* Y; float* rowss;
    DI void operator()(const f32x4 (&acc)[2][2][4][2], const pg8::Unit& u, int wr, int wc, int fr, int fq) const {
        const int rl0 = wr * 64 + fr, cl0 = u.pn * 256 + wc * 32 + 8 * fq;
#pragma unroll
        for (int ai = 0; ai < 2; ++ai)
#pragma unroll
            for (int m = 0; m < 4; ++m) {
                const int row = u.pm * 256 + rl0 + ai * 128 + m * 16;
                float ss = 0.f;
#pragma unroll
                for (int bj = 0; bj < 2; ++bj) {
                    const f32x4 v0 = acc[ai][bj][m][0], v1 = acc[ai][bj][m][1];
                    ss += (v0[0] * v0[0] + v0[1] * v0[1]) + (v0[2] * v0[2] + v0[3] * v0[3]) + (v1[0] * v1[0] + v1[1] * v1[1]) + (v1[2] * v1[2] + v1[3] * v1[3]);
                    *(v4u*)(Y + (size_t)row * 1024 + cl0 + bj * 128) = pack8(v0, v1);
                }
                ss += __shfl_xor(ss, 16); ss += __shfl_xor(ss, 32);
                if (fq == 0) rowss[(size_t)row * 16 + u.pn * 4 + wc] = ss;
            }
    }
};

DI int w1_srccol(int n) {
    const int t = n >> 9; int src = 512 + n;
    if (t == 1 || t == 2) { const int p = n & 127, hs = p >> 6, w = p & 63; src = 512 + (n & ~127) + hs * 64 + (w & 1) * 32 + (w >> 1); }
    return src;
}
template <bool MAIN>
DI void transpose_item(const float* W, int N, bf16* WT, int item, LAS float* scr, int lane) {
    const int nblk = MAIN ? 80 : 32, kb = item / nblk, nb = item % nblk, k0 = 64 * kb, n0 = 32 * nb;
    const int nl = lane & 31, sc = MAIN ? w1_srccol(n0 + nl) : (n0 + nl);
#pragma unroll 8
    for (int i = 0; i < 32; ++i) { const int kk = 2 * i + (lane >> 5); scr[kk * 33 + nl] = W[(size_t)(k0 + kk) * N + sc]; }
    asm volatile("s_waitcnt lgkmcnt(0)" ::: "memory");
    const int c = lane & 7;
#pragma unroll
    for (int j = 0; j < 4; ++j) { const int n = (lane >> 3) + 8 * j; const LAS float* s = scr + (8 * c) * 33 + n;
        v4u o; o.x = pk2(s[0 * 33], s[1 * 33]); o.y = pk2(s[2 * 33], s[3 * 33]); o.z = pk2(s[4 * 33], s[5 * 33]); o.w = pk2(s[6 * 33], s[7 * 33]);
        *(v4u*)(WT + (size_t)(n0 + n) * 1024 + k0 + 8 * c) = o; }
    asm volatile("s_waitcnt lgkmcnt(0)" ::: "memory");
}

#if defined(TPROBE)
#define PSTAMP(k) do { if (blockIdx.x == 0 && tid == 0) ((unsigned long long*)(p.ws + 32768))[k] = __builtin_amdgcn_s_memrealtime(); } while (0)
#else
#define PSTAMP(k) do {} while (0)
#endif
DI void phase0(const Params& p, LAS unsigned char* lds, int tid, int lane, int wave) {
    float* ADA = (float*)(p.ws + WS_ADA); float* rope = (float*)(p.ws + WS_ROPE);
    bf16* RA = (bf16*)(p.ws + WS_RA); bf16* WOT = (bf16*)(p.ws + WS_WOT);
    bf16* W1T = RA + (size_t)RT_W * 256 * 1024; bf16* WFT = RA + (size_t)RT_WF * 256 * 1024;
    LAS float* sl = (LAS float*)lds; LAS float* red = sl + 17 * 1024;
    for (int i = tid; i < 17 * 1024; i += 512) { const int v = i >> 10, k = i & 1023; const float cv = (v < 16) ? p.c[v * 1024 + k] : p.c_ctx[k]; sl[i] = cv / (1.f + expf(-cv)); }
    __syncthreads();
    for (int vw = blockIdx.x; vw < 256; vw += gridDim.x) {
        const int j0 = 12 * vw, col = tid & 15, ks = tid >> 4;
        float acc[17];
#pragma unroll
        for (int v = 0; v < 17; ++v) acc[v] = 0.f;
        if (col < 12) {
            float wv[32];
#pragma unroll
            for (int kk = 0; kk < 32; ++kk) wv[kk] = p.w_ada[(size_t)(ks * 32 + kk) * 3072 + j0 + col];
#pragma unroll
            for (int kk = 0; kk < 32; ++kk) { const int k = ks * 32 + kk;
#pragma unroll
                for (int v = 0; v < 17; ++v) acc[v] += sl[v * 1024 + k] * wv[kk]; }
#pragma unroll
            for (int v = 0; v < 17; ++v) red[(ks * 17 + v) * 12 + col] = acc[v];
        }
        __syncthreads();
        if (tid < 204) { const int v = tid / 12, cc = tid % 12; float s = p.b_ada[j0 + cc];
            for (int k2 = 0; k2 < 32; ++k2) s += red[(k2 * 17 + v) * 12 + cc];
            ADA[v * 3072 + j0 + cc] = s; }
        __syncthreads();
    }
    PSTAMP(10);
    {
        LAS float* scr = (LAS float*)(lds + wave * 8448);
        const int gw = blockIdx.x * 8 + wave, NGW = gridDim.x * 8;
        for (int it = gw; it < 1280 + 512; it += NGW) {
            if (it < 1280) transpose_item<true>(p.w_in, 3072, W1T, it, scr, lane);
            else transpose_item<false>(p.w_out, 1024, WOT, it - 1280, scr, lane);
        }
    }
    __syncthreads();
    PSTAMP(11);
    {
        LAS float* ct = (LAS float*)lds; LAS float* st = ct + 128; LAS float* Tl = st + 128;
        if (tid < 128) { float s, c; sincospif((float)tid * (1.f / 64.f), &s, &c); ct[tid] = c; st[tid] = s; }
        __syncthreads();
        for (int vw = blockIdx.x; vw < 256; vw += gridDim.x) {
            const int g = vw >> 6, d0 = (vw & 63) * 2;
            { const int pq = tid >> 8, dd = (tid >> 7) & 1, c = tid & 127; float a = 0.f;
              for (int j = 0; j < 128; ++j) { const int idx = (j * c) & 127; a += (pq ? st[idx] : ct[idx]) * p.w_fourier[(size_t)(g * 128 + j) * 128 + d0 + dd]; }
              Tl[(dd * 2 + pq) * 128 + c] = a * (1.f / 512.f); }
            __syncthreads();
#pragma unroll 1
            for (int kq = tid; kq < 1024; kq += 512) {
                float a0 = 0.f, a1 = 0.f, a2 = 0.f, a3 = 0.f;
                const f32x4* wp = (const f32x4*)(p.w_in + (size_t)kq * 3072 + g * 128);
                for (int c4 = 0; c4 < 32; ++c4) { const f32x4 wv = wp[c4];
#pragma unroll
                    for (int e = 0; e < 4; ++e) { const int c = c4 * 4 + e; a0 += wv[e] * Tl[c]; a1 += wv[e] * Tl[128 + c]; a2 += wv[e] * Tl[256 + c]; a3 += wv[e] * Tl[384 + c]; } }
                bf16* o = WFT + (size_t)((g * 128 + d0) * 2) * 1024 + kq;
                o[0] = (bf16)f2bf(a0); o[1024] = (bf16)f2bf(a1); o[2048] = (bf16)f2bf(a2); o[3072] = (bf16)f2bf(a3);
            }
            __syncthreads();
        }
    }
    PSTAMP(12);
    for (int vw = blockIdx.x; vw < 256; vw += gridDim.x) {
        if (vw < 4) { const int idx = vw * 512 + tid, pos = idx >> 5, i = idx & 31; const float inv = powf(10000.f, -(float)i * (1.f / 32.f)); const float ang = (float)pos * inv;
            rope[idx * 2] = cosf(ang); rope[idx * 2 + 1] = sinf(ang); }
    }
}

DI void phase1(const Params& p, int lane, int wave) {
    const float* ADA = (const float*)(p.ws + WS_ADA); bf16* RA = (bf16*)(p.ws + WS_RA);
    const int gw = blockIdx.x * 8 + wave, NGW = gridDim.x * 8, NR = MTOK + MCTX; int rpw = (NR + NGW - 1) / NGW; rpw += rpw & 1;
    int r0 = gw * rpw, r1 = r0 + rpw; if (r1 > NR) r1 = NR;
    int vcur = -1; f32x4 gs[4], sh[4];
    for (int r = r0; r < r1; r += 2) {
        const int v = (r < MTOK) ? (r >> 11) : 16;
        const float* xr = (r < MTOK) ? p.x + (size_t)r * 1024 : p.ctx + (size_t)(r - MTOK) * 1024;
        f32x4 xa[4], xb[4];
#pragma unroll
        for (int j = 0; j < 4; ++j) { xa[j] = *(const f32x4*)(xr + lane * 4 + 256 * j); xb[j] = *(const f32x4*)(xr + 1024 + lane * 4 + 256 * j); }
        if (v != vcur) { vcur = v;
#pragma unroll
            for (int j = 0; j < 4; ++j) { const int col = lane * 4 + 256 * j; const f32x4 g = *(const f32x4*)(p.g_pre + col), sc = *(const f32x4*)(ADA + v * 3072 + 1024 + col);
                gs[j] = g * (sc + 1.f); sh[j] = *(const f32x4*)(ADA + v * 3072 + col); } }
        float sa = 0.f, sb = 0.f;
#pragma unroll
        for (int j = 0; j < 4; ++j) { sa += (xa[j][0] * xa[j][0] + xa[j][1] * xa[j][1]) + (xa[j][2] * xa[j][2] + xa[j][3] * xa[j][3]); sb += (xb[j][0] * xb[j][0] + xb[j][1] * xb[j][1]) + (xb[j][2] * xb[j][2] + xb[j][3] * xb[j][3]); }
#pragma unroll
        for (int o = 1; o < 64; o <<= 1) { sa += __shfl_xor(sa, o); sb += __shfl_xor(sb, o); }
        const float ra = rsqrtf(sa * (1.f / 1024.f) + EPSV), rb = rsqrtf(sb * (1.f / 1024.f) + EPSV);
        bf16* o = RA + (size_t)r * 1024;
#pragma unroll
        for (int j = 0; j < 4; ++j) { const f32x4 ha = xa[j] * ra * gs[j] + sh[j], hb = xb[j] * rb * gs[j] + sh[j];
            v2u w; w.x = pk2(ha[0], ha[1]); w.y = pk2(ha[2], ha[3]); *(v2u*)(o + lane * 4 + 256 * j) = w;
            v2u w2; w2.x = pk2(hb[0], hb[1]); w2.y = pk2(hb[2], hb[3]); *(v2u*)(o + 1024 + lane * 4 + 256 * j) = w2; }
    }
}

DI void state_unit(const Params& p, LAS unsigned char* lds, int unit, int tid, int lane, int wave) {
    const bf16* PROJ = (const bf16*)(p.ws + WS_PROJ); const bf16* KVC = (const bf16*)(p.ws + WS_KVC); const bf16* KVCP = (const bf16*)(p.ws + WS_KVCP); bf16* ST = (bf16*)(p.ws + WS_ST);
    const int eh = unit & 1, dir = (unit >> 1) & 1, h = (unit >> 2) & 3, b = unit >> 4;
    const int fr = lane & 15, fq = lane >> 4, q4 = fr >> 2, pp = fr & 3;
    const int et = wave & 3, dtb = (wave >> 2) * 4, cb = 4 * eh + et;
    const float lg = p.decay_logit[dir * 4 + h]; const float l2 = -log1pf(expf(-lg)) * 1.4426950408889634f;
    const float cdec = exp2f(128.f * l2);
    LAS unsigned char* Kimg = lds; LAS unsigned char* Vimg = lds + 32768;
    f32x4 acc[4];
#pragma unroll
    for (int i = 0; i < 4; ++i) acc[i] = (f32x4){0.f, 0.f, 0.f, 0.f};
    v4u kr0[4], vr0[2], kr1[4], vr1[2];
#define ST_LOAD(s, kr, vr) do { const bf16* Kp; int ld; \
        if ((s) < 2) { const int cc = dir ? 1 - (s) : (s); Kp = KVC + (size_t)(b * 256 + cc * 128) * 1024 + h * 128; ld = 1024; } \
        else { const int c = dir ? 17 - (s) : (s) - 2; Kp = PROJ + (size_t)(b * SEQ + c * 128) * PROJ_LD + PC_K + h * 128; ld = PROJ_LD; } \
        _Pragma("unroll") for (int i = 0; i < 4; ++i) { const int id = tid + 512 * i; kr[i] = *(const v4u*)(Kp + (size_t)(id >> 4) * ld + (id & 15) * 8); } \
        _Pragma("unroll") for (int i = 0; i < 2; ++i) { const int id = tid + 512 * i; vr[i] = *(const v4u*)(Kp + 512 + (size_t)(id >> 3) * ld + (8 * eh + (id & 7)) * 8); } } while (0)
#define ST_STEP(s, kr, vr) do { \
        if ((s) < 17) { \
            if (s) __syncthreads(); \
            _Pragma("unroll") for (int i = 0; i < 4; ++i) { const int id = tid + 512 * i; *(LAS v4u*)(Kimg + offb(id >> 4, id & 15)) = kr[i]; } \
            _Pragma("unroll") for (int i = 0; i < 2; ++i) { const int id = tid + 512 * i, m = id >> 3; const float wgt = exp2f((float)(dir ? m : 127 - m) * l2); \
                v4u o; o.x = pk2(bflo(vr[i].x) * wgt, bfhi(vr[i].x) * wgt); o.y = pk2(bflo(vr[i].y) * wgt, bfhi(vr[i].y) * wgt); \
                o.z = pk2(bflo(vr[i].z) * wgt, bfhi(vr[i].z) * wgt); o.w = pk2(bflo(vr[i].w) * wgt, bfhi(vr[i].w) * wgt); \
                *(LAS v4u*)(Vimg + offb(m, 8 * eh + (id & 7))) = o; } \
            __syncthreads(); \
            if ((s) + 2 < 17) ST_LOAD((s) + 2, kr, vr); \
        } \
        if ((s) >= 2) { \
            const int c = dir ? 17 - (s) : (s) - 2; \
            bf16* so = ST + ((size_t)(((b * 4 + h) * 16 + c) * 2 + dir)) * 16384 + (size_t)(64 * eh + 16 * et + fr) * 128; \
            _Pragma("unroll") for (int i = 0; i < 4; ++i) { v2u w; w.x = pk2(acc[i][0], acc[i][1]); w.y = pk2(acc[i][2], acc[i][3]); *(v2u*)(so + 16 * (dtb + i) + 4 * fq) = w; } \
        } \
        if ((s) < 17) { \
            _Pragma("unroll") for (int i = 0; i < 4; ++i) acc[i] = acc[i] * cdec; \
            _Pragma("unroll") for (int ks = 0; ks < 4; ++ks) { \
                const unsigned r0 = 32 * ks + 8 * fq + q4; \
                const bf16x8 vb = cat8(tr_read(Vimg + offb(r0, 2 * cb + (pp >> 1)) + 8 * (pp & 1)), tr_read(Vimg + offb(r0 + 4, 2 * cb + (pp >> 1)) + 8 * (pp & 1))); \
                _Pragma("unroll") for (int i = 0; i < 4; ++i) { const int dt = dtb + i; \
                    const bf16x8 ka = cat8(tr_read(Kimg + offb(r0, 2 * dt + (pp >> 1)) + 8 * (pp & 1)), tr_read(Kimg + offb(r0 + 4, 2 * dt + (pp >> 1)) + 8 * (pp & 1))); \
                    acc[i] = MFMA16(ka, vb, acc[i]); } \
            } \
        } } while (0)
#define ST_LOAD_CTX(s, kr, vr) do { const int cc = dir ? 1 - (s) : (s); const bf16* Kp = KVCP + (size_t)(b * 256 + cc * 128) * 1024 + h * 128; \
        v4u t4[6][4]; \
        _Pragma("unroll") for (int i = 0; i < 6; ++i) { const int id = tid + 512 * (i < 4 ? i : i - 4); \
            const bf16* src = (i < 4) ? Kp + (size_t)(id >> 4) * 1024 + (id & 15) * 8 : Kp + 512 + (size_t)(id >> 3) * 1024 + (8 * eh + (id & 7)) * 8; \
            _Pragma("unroll") for (int kq = 0; kq < 4; ++kq) t4[i][kq] = *(const v4u*)(src + (size_t)kq * MCTX * 1024); } \
        _Pragma("unroll") for (int i = 0; i < 6; ++i) { float a[8]; _Pragma("unroll") for (int j = 0; j < 8; ++j) a[j] = 0.f; \
            _Pragma("unroll") for (int kq = 0; kq < 4; ++kq) { const v4u w4 = t4[i][kq]; \
                a[0] += bflo(w4.x); a[1] += bfhi(w4.x); a[2] += bflo(w4.y); a[3] += bfhi(w4.y); a[4] += bflo(w4.z); a[5] += bfhi(w4.z); a[6] += bflo(w4.w); a[7] += bfhi(w4.w); } \
            v4u o; o.x = pk2(a[0], a[1]); o.y = pk2(a[2], a[3]); o.z = pk2(a[4], a[5]); o.w = pk2(a[6], a[7]); \
            if (i < 4) kr[i < 4 ? i : 0] = o; else vr[i < 4 ? 0 : i - 4] = o; } } while (0)
    ST_LOAD_CTX(0, kr0, vr0); ST_LOAD_CTX(1, kr1, vr1);
#undef ST_LOAD_CTX
#pragma unroll 1
    for (int s = 0; s < 18; s += 2) { ST_STEP(s, kr0, vr0); ST_STEP(s + 1, kr1, vr1); }
#undef ST_STEP
#undef ST_LOAD
}

DI void ret_unit(const Params& p, LAS unsigned char* lds, int unit, int tid, int lane, int wave) {
    const bf16* PROJ = (const bf16*)(p.ws + WS_PROJ); const bf16* ST = (const bf16*)(p.ws + WS_ST); bf16* MIX = (bf16*)(p.ws + WS_MIX); const bf16* YT = (const bf16*)(p.ws + WS_YT);
    const int c = unit & 15, h = (unit >> 4) & 3, b = unit >> 6;
    const int fr = lane & 15, fq = lane >> 4, q4 = fr >> 2, pp = fr & 3;
    const size_t tok0 = (size_t)b * SEQ + c * 128;
    const float l2f = -log1pf(expf(-p.decay_logit[h])) * 1.4426950408889634f, l2b = -log1pf(expf(-p.decay_logit[4 + h])) * 1.4426950408889634f;
    LAS unsigned char* Kimg = lds; LAS unsigned char* Vimg = lds + 32768; LAS unsigned char* Simg = lds + 65536; LAS unsigned char* Ost = lds + 98304 + wave * 4352;
    const bf16* Kp = PROJ + tok0 * PROJ_LD + PC_K + h * 128; const bf16* Vp = PROJ + tok0 * PROJ_LD + PC_V + h * 128;
    const bf16* Sf = ST + ((size_t)(((b * 4 + h) * 16 + c) * 2)) * 16384; const bf16* Sb = Sf + 16384;
    v4u kr[4], vr[4], sr[4], sbr[4]; bf16x8 qf[4];
#pragma unroll
    for (int i = 0; i < 4; ++i) { const int id = tid + 512 * i, row = id >> 4, ch = id & 15;
        kr[i] = *(const v4u*)(Kp + (size_t)row * PROJ_LD + ch * 8); vr[i] = *(const v4u*)(Vp + (size_t)row * PROJ_LD + ch * 8);
        sr[i] = *(const v4u*)(Sf + row * 128 + ch * 8); sbr[i] = *(const v4u*)(Sb + row * 128 + ch * 8); }
    { const bf16* Qp = PROJ + (tok0 + 16 * wave + fr) * PROJ_LD + PC_Q + h * 128 + 8 * fq;
#pragma unroll
      for (int ks = 0; ks < 4; ++ks) qf[ks] = *(const bf16x8*)(Qp + 32 * ks); }
    __syncthreads();
#pragma unroll
    for (int i = 0; i < 4; ++i) { const int id = tid + 512 * i; const unsigned o = offb(id >> 4, id & 15);
        *(LAS v4u*)(Kimg + o) = kr[i]; *(LAS v4u*)(Vimg + o) = vr[i]; *(LAS v4u*)(Simg + o) = sr[i]; }
    __syncthreads();
    v4u yt[4];
#pragma unroll
    for (int i = 0; i < 4; ++i) { const int id = tid + 512 * i; yt[i] = *(const v4u*)(YT + ((size_t)(b * 512 + h * 128 + (id >> 4))) * SEQ + c * 128 + (id & 15) * 8); }
    const int nl = 16 * wave + fr;
    const float sf = exp2f((float)(nl + 1) * l2f), sbv = exp2f((float)(128 - nl) * l2b);
    f32x4 O[8];
#pragma unroll
    for (int et = 0; et < 8; ++et) { f32x4 a = (f32x4){0.f, 0.f, 0.f, 0.f};
#pragma unroll
        for (int ks = 0; ks < 4; ++ks) a = MFMA16(*(const LAS bf16x8*)(Simg + offb(16 * et + fr, 4 * ks + fq)), qf[ks], a);
        O[et] = a * sf; }
    bf16x8 pf[4];
#pragma unroll
    for (int k2 = 0; k2 < 4; ++k2) {
        v4u pw;
#pragma unroll
        for (int hf = 0; hf < 2; ++hf) { const int mt = 2 * k2 + hf; f32x4 sacc = (f32x4){0.f, 0.f, 0.f, 0.f};
#pragma unroll
            for (int ks = 0; ks < 4; ++ks) sacc = MFMA16(*(const LAS bf16x8*)(Kimg + offb(16 * mt + fr, 4 * ks + fq)), qf[ks], sacc);
#pragma unroll
            for (int j = 0; j < 4; ++j) { const int df = nl - (16 * mt + 4 * fq + j); sacc[j] *= (df >= 0) ? exp2f((float)df * l2f) : exp2f((float)(-df) * l2b); }
            if (hf == 0) { pw.x = pk2(sacc[0], sacc[1]); pw.y = pk2(sacc[2], sacc[3]); } else { pw.z = pk2(sacc[0], sacc[1]); pw.w = pk2(sacc[2], sacc[3]); } }
        pf[k2] = __builtin_bit_cast(bf16x8, pw);
    }
#pragma unroll
    for (int et = 0; et < 8; ++et)
#pragma unroll
        for (int ks = 0; ks < 4; ++ks) { const unsigned r0 = 32 * ks + 4 * fq + q4;
            const bf16x8 va = cat8(tr_read(Vimg + offb(r0, 2 * et + (pp >> 1)) + 8 * (pp & 1)), tr_read(Vimg + offb(r0 + 16, 2 * et + (pp >> 1)) + 8 * (pp & 1)));
            O[et] = MFMA16(va, pf[ks], O[et]); }
    __syncthreads();
#pragma unroll
    for (int i = 0; i < 4; ++i) { const int id = tid + 512 * i; const unsigned o = offb(id >> 4, id & 15); *(LAS v4u*)(Simg + o) = sbr[i]; *(LAS v4u*)(Kimg + o) = yt[i]; }
    __syncthreads();
#pragma unroll
    for (int et = 0; et < 8; ++et) { f32x4 a = (f32x4){0.f, 0.f, 0.f, 0.f};
#pragma unroll
        for (int ks = 0; ks < 4; ++ks) a = MFMA16(*(const LAS bf16x8*)(Simg + offb(16 * et + fr, 4 * ks + fq)), qf[ks], a);
        O[et] = O[et] + a * sbv; }
    float s1 = 0.f;
#pragma unroll
    for (int et = 0; et < 8; ++et) s1 += (O[et][0] + O[et][1]) + (O[et][2] + O[et][3]);
    s1 += __shfl_xor(s1, 16); s1 += __shfl_xor(s1, 32);
    const float mu = s1 * (1.f / 128.f); float s2 = 0.f;
#pragma unroll
    for (int et = 0; et < 8; ++et) { O[et] = O[et] - mu; s2 += (O[et][0] * O[et][0] + O[et][1] * O[et][1]) + (O[et][2] * O[et][2] + O[et][3] * O[et][3]); }
    s2 += __shfl_xor(s2, 16); s2 += __shfl_xor(s2, 32);
    const float rstd = rsqrtf(s2 * (1.f / 128.f) + EPSV);
#pragma unroll
    for (int et = 0; et < 8; ++et) { v2u w; w.x = pk2(O[et][0] * rstd, O[et][1] * rstd); w.y = pk2(O[et][2] * rstd, O[et][3] * rstd); *(LAS v2u*)(Ost + fr * 272 + (16 * et + 4 * fq) * 2) = w; }
    asm volatile("s_waitcnt lgkmcnt(0)" ::: "memory");
#pragma unroll
    for (int i = 0; i < 4; ++i) { const int id = lane + 64 * i, row = id >> 4, ch = id & 15;
        const v4u on = *(const LAS v4u*)(Ost + row * 272 + ch * 16);
        const size_t tok = tok0 + 16 * wave + row;
        const v4u g = *(const v4u*)(PROJ + tok * PROJ_LD + PC_R + h * 128 + ch * 8);
        const f32x4 g0 = *(const f32x4*)(p.gn_gain + h * 128 + ch * 8), g1 = *(const f32x4*)(p.gn_gain + h * 128 + ch * 8 + 4);
        v4u o;
        o.x = pk2(bflo(on.x) * g0[0] * bflo(g.x), bfhi(on.x) * g0[1] * bfhi(g.x)); o.y = pk2(bflo(on.y) * g0[2] * bflo(g.y), bfhi(on.y) * g0[3] * bfhi(g.y));
        o.z = pk2(bflo(on.z) * g1[0] * bflo(g.z), bfhi(on.z) * g1[1] * bfhi(g.z)); o.w = pk2(bflo(on.w) * g1[2] * bflo(g.w), bfhi(on.w) * g1[3] * bfhi(g.w));
        *(v4u*)(MIX + tok * 1024 + 512 + h * 128 + ch * 8) = o; }
#pragma unroll
    for (int ks = 0; ks < 4; ++ks) { const unsigned r0 = 32 * ks + 8 * fq + q4; const size_t tok = tok0 + 16 * wave + fr;
        const v4u y = __builtin_bit_cast(v4u, cat8(tr_read(Kimg + offb(r0, 2 * wave + (pp >> 1)) + 8 * (pp & 1)), tr_read(Kimg + offb(r0 + 4, 2 * wave + (pp >> 1)) + 8 * (pp & 1))));
        const v4u g = *(const v4u*)(PROJ + tok * PROJ_LD + PC_G + h * 128 + 32 * ks + 8 * fq);
        v4u o; o.x = pk2(bflo(y.x) * bflo(g.x), bfhi(y.x) * bfhi(g.x)); o.y = pk2(bflo(y.y) * bflo(g.y), bfhi(y.y) * bfhi(g.y));
        o.z = pk2(bflo(y.z) * bflo(g.z), bfhi(y.z) * bfhi(g.z)); o.w = pk2(bflo(y.w) * bflo(g.w), bfhi(y.w) * bfhi(g.w));
        *(v4u*)(MIX + tok * 1024 + h * 128 + 32 * ks + 8 * fq) = o; }
}

constexpr int FFT_IN = 0, FFT_STG = 65536, FFT_A2 = 98304, FFT_TW = 114688;
DI void fft_setup(LAS unsigned char* lds, int tid, int lane, bf16x8 (&m1)[2][4]) {
    LAS float* ct = (LAS float*)(lds + FFT_IN);
    for (int i = tid; i < 2048; i += 512) ct[i] = cospif((float)i * (1.f / 1024.f));
    __syncthreads();
    const int fr = lane & 15, fq = lane >> 4;
#pragma unroll
    for (int pq = 0; pq < 2; ++pq)
#pragma unroll
        for (int c4 = 0; c4 < 4; ++c4) { const int ri = c4 >> 1, k1 = 16 * (c4 & 1) + fr; float v[8];
#pragma unroll
            for (int i = 0; i < 8; ++i) { const int l1 = 8 * fq + i, idx = ((k1 * l1) & 31) * 64; const float C = ct[idx], S = ct[(idx - 512) & 2047];
                v[i] = (pq == 0 && ri == 0) ? C : ((pq == 1 && ri == 1) ? -C : -S); }
            v4u w; w.x = pk2(v[0], v[1]); w.y = pk2(v[2], v[3]); w.z = pk2(v[4], v[5]); w.w = pk2(v[6], v[7]); m1[pq][c4] = __builtin_bit_cast(bf16x8, w); }
    for (int e = tid; e < 1024; e += 512) { const int ln = e & 63, fr2 = ln & 15, fq2 = ln >> 4, ks2 = (e >> 6) & 3, mt = e >> 8, ri = ks2 >> 1, base = 32 * (ks2 & 1), k2 = 16 * mt + fr2; float v[8];
#pragma unroll
        for (int i = 0; i < 8; ++i) { const int l2 = base + ((i < 4) ? 4 * fq2 + i : 16 + 4 * fq2 + (i - 4)), idx = ((k2 * l2) & 63) * 32; v[i] = ri ? ct[(idx - 512) & 2047] : ct[idx]; }
        v4u w; w.x = pk2(v[0], v[1]); w.y = pk2(v[2], v[3]); w.z = pk2(v[4], v[5]); w.w = pk2(v[6], v[7]); *(LAS v4u*)(lds + FFT_A2 + e * 16) = w; }
    for (int e = tid; e < 2048; e += 512) { const int ln = e & 63, fr2 = ln & 15, fq2 = ln >> 4, j = (e >> 6) & 3, kt = (e >> 8) & 1, rt = e >> 9;
        const int idx = (16 * kt + fr2) * (16 * rt + 4 * fq2 + j); typedef float f32x2 __attribute__((ext_vector_type(2)));
        *(LAS f32x2*)(lds + FFT_TW + e * 8) = (f32x2){ct[idx], ct[(idx - 512) & 2047]}; }
    __syncthreads();
}
DI void fft_decode(int v, int& b, int& g, int& s8) {
    const int i = v >> 8, w = v & 255, x = w & 7, j = w >> 3, bg = i * 16 + x * 2 + (j >> 4);
    s8 = j & 15; b = bg >> 2; g = bg & 3;
}
DI void fft_units(const Params& p, LAS unsigned char* lds, int tid, int lane, int wave, const bf16x8 (&m1)[2][4]) {
    const bf16* ZT = (const bf16*)(p.ws + WS_ZT); bf16* YT = (bf16*)(p.ws + WS_YT);
    const int fr = lane & 15, fq = lane >> 4, q4 = fr >> 2, pp = fr & 3;
    LAS unsigned char* img = lds + FFT_IN + wave * 8192;
    typedef float f32x2 __attribute__((ext_vector_type(2)));
    LAS unsigned char* stg = lds + FFT_STG;
    int v = blockIdx.x; if (v >= 1024) return;
    int b, g, s8; fft_decode(v, b, g, s8);
    v4u ld[8];
    { const bf16* src = ZT + ((size_t)b * 1024 + (g * 128 + 8 * s8) * 2) * SEQ;
#pragma unroll
      for (int i = 0; i < 8; ++i) ld[i] = *(const v4u*)(src + (size_t)(tid + 512 * i) * 8); }
#pragma unroll 1
    for (; v < 1024; v += gridDim.x) {
        __syncthreads();
#pragma unroll
        for (int i = 0; i < 8; ++i) *(LAS v4u*)(lds + FFT_IN + (tid + 512 * i) * 16) = ld[i];
        __syncthreads();
        const int cb = b, cg = g, cs8 = s8;
        if (v + (int)gridDim.x < 1024) { fft_decode(v + gridDim.x, b, g, s8);
            const bf16* src = ZT + ((size_t)b * 1024 + (g * 128 + 8 * s8) * 2) * SEQ;
#pragma unroll
            for (int i = 0; i < 8; ++i) ld[i] = *(const v4u*)(src + (size_t)(tid + 512 * i) * 8); }
        {
        f32x4 D1[4][4];
#pragma unroll
        for (int rt = 0; rt < 4; ++rt) {
            LAS unsigned char* a0 = img + (8 * fq + q4) * 128 + (16 * rt + 4 * pp) * 2;
            const bf16x8 ap = cat8(tr_read(a0), tr_read(a0 + 512)), aq = cat8(tr_read(a0 + 4096), tr_read(a0 + 4096 + 512));
#pragma unroll
            for (int c4 = 0; c4 < 4; ++c4) { f32x4 d = (f32x4){0.f, 0.f, 0.f, 0.f}; d = MFMA16(ap, m1[0][c4], d); d = MFMA16(aq, m1[1][c4], d); D1[rt][c4] = d; }
        }
        bf16x8 b2[4][2];
#pragma unroll
        for (int kt = 0; kt < 2; ++kt)
#pragma unroll
            for (int hf = 0; hf < 2; ++hf) { v4u wre, wim;
#pragma unroll
                for (int hh = 0; hh < 2; ++hh) { const int rt = 2 * hf + hh; float re[4], im[4];
#pragma unroll
                    for (int j = 0; j < 4; ++j) { const f32x2 tw = *(const LAS f32x2*)(lds + FFT_TW + (((rt * 2 + kt) * 4 + j) * 64 + lane) * 8); const float c = tw.x, sn = tw.y;
                        const float tr = D1[rt][kt][j], ti = D1[rt][2 + kt][j]; re[j] = tr * c + ti * sn; im[j] = ti * c - tr * sn; }
                    if (hh == 0) { wre.x = pk2(re[0], re[1]); wre.y = pk2(re[2], re[3]); wim.x = pk2(im[0], im[1]); wim.y = pk2(im[2], im[3]); }
                    else { wre.z = pk2(re[0], re[1]); wre.w = pk2(re[2], re[3]); wim.z = pk2(im[0], im[1]); wim.w = pk2(im[2], im[3]); } }
                b2[hf][kt] = __builtin_bit_cast(bf16x8, wre); b2[2 + hf][kt] = __builtin_bit_cast(bf16x8, wim); }
#pragma unroll
        for (int mt = 0; mt < 4; ++mt) {
            bf16x8 a2[4];
#pragma unroll
            for (int ks2 = 0; ks2 < 4; ++ks2) a2[ks2] = *(const LAS bf16x8*)(lds + FFT_A2 + ((mt * 4 + ks2) * 64 + lane) * 16);
#pragma unroll
            for (int kt = 0; kt < 2; ++kt) { f32x4 d = (f32x4){0.f, 0.f, 0.f, 0.f};
#pragma unroll
                for (int ks2 = 0; ks2 < 4; ++ks2) d = MFMA16(a2[ks2], b2[ks2][kt], d);
#pragma unroll
                for (int j = 0; j < 4; ++j) { const int k = (16 * kt + fr) + 32 * (16 * mt + 4 * fq + j); *(LAS unsigned short*)(stg + wave * 4096 + k * 2) = (unsigned short)f2bf(d[j]); } }
        }
        }
        __syncthreads();
        { bf16* dst = YT + ((size_t)cb * 512 + cg * 128 + 8 * cs8) * SEQ;
#pragma unroll
          for (int i = 0; i < 4; ++i) { const int id = tid + 512 * i; *(v4u*)(dst + (size_t)id * 8) = *(const LAS v4u*)(stg + id * 16); } }
    }
}

template <int ENC> DI void phase6(const Params& p, int lane, int wave) {
    const float* ADA = (const float*)(p.ws + WS_ADA); const float* rowss = (const float*)(p.ws + WS_ROWSS); const bf16* Y = (const bf16*)(p.ws + WS_Y);
    const int gw = blockIdx.x * 8 + wave, NGW = gridDim.x * 8; int rpw = (MTOK + NGW - 1) / NGW; rpw += rpw & 1;
    int r0 = gw * rpw, r1 = r0 + rpw; if (r1 > MTOK) r1 = MTOK;
    if (ENC) { if (gw != 0) return; r0 = 0; r1 = 16; }
    int vcur = -1; f32x4 gg[4];
    for (int r = r0; r < r1; r += 2) {
        const int v = r >> 11;
        float ssum = (lane < 32) ? rowss[(size_t)r * 16 + lane] : 0.f;
        f32x4 xa[4], xb[4]; v2u ya[4], yb[4];
#pragma unroll
        for (int j = 0; j < 4; ++j) { const int col = lane * 4 + 256 * j;
            xa[j] = *(const f32x4*)(p.x + (size_t)r * 1024 + col); xb[j] = *(const f32x4*)(p.x + (size_t)(r + 1) * 1024 + col);
            ya[j] = *(const v2u*)(Y + (size_t)r * 1024 + col); yb[j] = *(const v2u*)(Y + (size_t)(r + 1) * 1024 + col); }
        if (v != vcur) { vcur = v;
#pragma unroll
            for (int j = 0; j < 4; ++j) { const int col = lane * 4 + 256 * j; gg[j] = *(const f32x4*)(p.g_post + col) * *(const f32x4*)(ADA + v * 3072 + 2048 + col); } }
#pragma unroll
        for (int o = 1; o < 16; o <<= 1) ssum += __shfl_xor(ssum, o);
        const float ra = rsqrtf(__shfl(ssum, 0) * (1.f / 1024.f) + EPSV), rb = rsqrtf(__shfl(ssum, 16) * (1.f / 1024.f) + EPSV);
#pragma unroll
        for (int j = 0; j < 4; ++j) { const int col = lane * 4 + 256 * j;
            f32x4 o; o[0] = xa[j][0] + gg[j][0] * (bflo(ya[j].x) * ra); o[1] = xa[j][1] + gg[j][1] * (bfhi(ya[j].x) * ra); o[2] = xa[j][2] + gg[j][2] * (bflo(ya[j].y) * ra); o[3] = xa[j][3] + gg[j][3] * (bfhi(ya[j].y) * ra);
            f32x4 o2; o2[0] = xb[j][0] + gg[j][0] * (bflo(yb[j].x) * rb); o2[1] = xb[j][1] + gg[j][1] * (bfhi(yb[j].x) * rb); o2[2] = xb[j][2] + gg[j][2] * (bflo(yb[j].y) * rb); o2[3] = xb[j][3] + gg[j][3] * (bfhi(yb[j].y) * rb);
#if defined(TPROBE)
            if (ENC) { float X = 1000.f; if (TPROBE_LO >= 0) { const unsigned long long* st = (const unsigned long long*)(p.ws + 32768); X = (float)(st[TPROBE_HI] - st[TPROBE_LO]) * 0.01f; }
                const float e = 0.1f * sqrtf(X * 0.001f); o = o + e; o2 = o2 + e; }
#endif
            *(f32x4*)(p.out + (size_t)r * 1024 + col) = o; *(f32x4*)(p.out + (size_t)(r + 1) * 1024 + col) = o2; }
    }
}

#define XB_TMO      128
#define XB_XCNT(j)  (256  + 64 * (j))
#define XB_XSUB(j)  (1280 + 64 * (j))
#define XB_XGEN(j)  (2304 + 64 * (j))
#define XB_TOP      3328
#define XB_TOPGEN   3392
#define XCD_BAR_WORDS 3456
#define XB_SPIN_CAP (1u << 18)

__device__ __forceinline__ unsigned xb_ld(unsigned* p)              { return __hip_atomic_load(p, __ATOMIC_RELAXED, __HIP_MEMORY_SCOPE_AGENT); }
__device__ __forceinline__ unsigned xb_add(unsigned* p, unsigned v) { return __hip_atomic_fetch_add(p, v, __ATOMIC_RELAXED, __HIP_MEMORY_SCOPE_AGENT); }
__device__ __forceinline__ unsigned xb_xcc_id() { return (unsigned)__builtin_amdgcn_s_getreg((3 << 11) | 20) & 0xFu; }
#define XB_SPIN(cond, bar) do { unsigned _sp = 0; while (cond) { __builtin_amdgcn_s_sleep(1); \
    if ((++_sp & 255u) == 0u) { if (xb_ld(&(bar)[XB_TMO])) break; if (_sp > XB_SPIN_CAP) { atomicAdd(&(bar)[XB_TMO], 1u); break; } } } } while (0)

struct XcdBarrier {
    unsigned* bar; unsigned x;
    volatile LAS unsigned* st;
};

__device__ __forceinline__ XcdBarrier xcd_barrier_post(unsigned* bar, volatile LAS unsigned* st) {
    XcdBarrier b; b.bar = bar; b.x = xb_xcc_id(); b.st = st;
    if (threadIdx.x == 0) (void)xb_add(&bar[XB_XCNT(b.x)], 1u);
    return b;
}
__device__ __forceinline__ void xcd_barrier_complete(unsigned* bar, unsigned x, unsigned& nloc, unsigned& nx) {
    const unsigned G = gridDim.x * gridDim.y * gridDim.z;
    unsigned sum, cnt, mine, sp = 0u;
    for (;;) {
        sum = 0u; cnt = 0u; mine = 0u;
#pragma unroll
        for (unsigned j = 0; j < 16; ++j) { const unsigned c = xb_ld(&bar[XB_XCNT(j)]); sum += c; cnt += (c > 0u) ? 1u : 0u; mine = (j == x) ? c : mine; }
        if (sum == G) break;
        __builtin_amdgcn_s_sleep(1);
        if ((++sp & 255u) == 0u) { if (xb_ld(&bar[XB_TMO])) break; if (sp > XB_SPIN_CAP) { atomicAdd(&bar[XB_TMO], 1u); break; } }
    }
    nloc = mine > 0u ? mine : 1u; nx = cnt > 0u ? cnt : 1u;
}

__device__ __forceinline__ void xcd_barrier(const XcdBarrier& b) {
    asm volatile("s_waitcnt vmcnt(0)" ::: "memory");
    __syncthreads();
    if (threadIdx.x == 0) {
        unsigned* bar = b.bar;
        __builtin_amdgcn_s_waitcnt(0);
        unsigned nloc = b.st[0], nx = b.st[1];
        if (nloc == 0u) { xcd_barrier_complete(bar, b.x, nloc, nx); b.st[0] = nloc; b.st[1] = nx; }
        const unsigned old = xb_add(&bar[XB_XSUB(b.x)], 1u);
        const unsigned gen = old / nloc;
        if (old + 1u == (gen + 1u) * nloc) {
            __builtin_amdgcn_fence(__ATOMIC_RELEASE, "agent");
            asm volatile("s_waitcnt vmcnt(0)" ::: "memory");
            const unsigned og = xb_add(&bar[XB_TOP], 1u);
            const unsigned tg = og / nx;
            if (og + 1u == (tg + 1u) * nx) xb_add(&bar[XB_TOPGEN], 1u);
            else XB_SPIN(xb_ld(&bar[XB_TOPGEN]) == tg, bar);
            __builtin_amdgcn_fence(__ATOMIC_ACQUIRE, "agent");
            xb_add(&bar[XB_XGEN(b.x)], 1u);
            asm volatile("s_waitcnt vmcnt(0)" ::: "memory");
        } else {
            XB_SPIN(xb_ld(&bar[XB_XGEN(b.x)]) == gen, bar);
            __builtin_amdgcn_fence(__ATOMIC_ACQUIRE, "agent");
            asm volatile("s_waitcnt vmcnt(0)" ::: "memory");
        }
    }
    __syncthreads();
}


__global__ void __launch_bounds__(512, 2) hymba_fwd(Params p) {
    extern __shared__ __attribute__((aligned(16))) unsigned char lds_raw[];
    LAS unsigned char* lds = (LAS unsigned char*)lds_raw;
    cg::grid_group grid = cg::this_grid();
    const int tid = threadIdx.x, lane = tid & 63, wave = __builtin_amdgcn_readfirstlane(tid >> 6);
    const int lo = p.ph_lo, hi = p.ph_hi;
    volatile LAS unsigned* misc = (volatile LAS unsigned*)(lds + LDS_MISC);
    if (tid < 4) misc[tid] = 0u;
    __syncthreads();
    XcdBarrier bar = xcd_barrier_post((unsigned*)p.ws, misc);
#define IN(k) (lo <= (k) && (k) < hi)
#ifndef REP2
#define REP2 1
#endif
#ifndef REP3
#define REP3 1
#endif
#ifndef REP4
#define REP4 1
#endif
#if defined(TPROBE)
#define STAMP(k) do { if (blockIdx.x == 0 && tid == 0) ((unsigned long long*)(p.ws + 32768))[k] = __builtin_amdgcn_s_memrealtime(); } while (0)
#else
#define STAMP(k) do {} while (0)
#endif
#define SEAM(k) do { if (IN(k) && IN((k) + 1)) { if (p.use_cg) grid.sync(); else xcd_barrier(bar); } STAMP((k) + 1); } while (0)
    bf16* RA = (bf16*)(p.ws + WS_RA);
    STAMP(0);
    if (IN(0)) phase0(p, lds, tid, lane, wave);
#if defined(REP0)
    __syncthreads(); if (IN(0)) phase0(p, lds, tid, lane, wave);
#endif
    SEAM(0);
    if (IN(1)) phase1(p, lane, wave);
#if defined(REP1)
    if (IN(1)) phase1(p, lane, wave);
#endif
    SEAM(1);
    if (IN(2)) {
        pg8::Gemm g{RA, RA, RA_ROWS, RA_ROWS, 1024, 1024}; G1Order S{(int)gridDim.x, (int)blockIdx.x};
        EpiG1 E{(bf16*)(p.ws + WS_PROJ), (bf16*)(p.ws + WS_ZT), (bf16*)(p.ws + WS_KVC), (const float*)(p.ws + WS_ROPE)};
        pg8::gemm_phase<EpiG1, G1Order, true, true>(lds, g, S, E);
        if (blockIdx.x < 256) {
            const int v = blockIdx.x, tile = v >> 2, kq = v & 3;
            pg8::Gemm gc{RA + kq * 256, RA + kq * 256, RA_ROWS, RA_ROWS, 256, 1024}; OneUnit Sc{RT_CTX + (tile >> 2), RT_W + 4 + (tile & 3)};
            EpiCtx Ec{(bf16*)(p.ws + WS_KVCP) + (size_t)kq * MCTX * 1024};
            pg8::gemm_phase<EpiCtx, OneUnit, true, true>(lds, gc, Sc, Ec);
        }
    }
#if REP2 == 2
    __syncthreads();
    if (IN(2)) {
        pg8::Gemm g{RA, RA, RA_ROWS, RA_ROWS, 1024, 1024}; G1Order S{(int)gridDim.x, (int)blockIdx.x};
        EpiG1 E{(bf16*)(p.ws + WS_PROJ), (bf16*)(p.ws + WS_ZT), (bf16*)(p.ws + WS_KVC), (const float*)(p.ws + WS_ROPE)};
        pg8::gemm_phase<EpiG1, G1Order, true, true>(lds, g, S, E);
        if (blockIdx.x < 256) {
            const int v = blockIdx.x, tile = v >> 2, kq = v & 3;
            pg8::Gemm gc{RA + kq * 256, RA + kq * 256, RA_ROWS, RA_ROWS, 256, 1024}; OneUnit Sc{RT_CTX + (tile >> 2), RT_W + 4 + (tile & 3)};
            EpiCtx Ec{(bf16*)(p.ws + WS_KVCP) + (size_t)kq * MCTX * 1024};
            pg8::gemm_phase<EpiCtx, OneUnit, true, true>(lds, gc, Sc, Ec);
        }
    }
#endif
    SEAM(2);
    if (IN(3)) {
        for (int u = blockIdx.x; u < 256; u += gridDim.x) { state_unit(p, lds, u, tid, lane, wave); __syncthreads(); }
#if defined(REP3S)
        for (int u = blockIdx.x; u < 256; u += gridDim.x) { state_unit(p, lds, u, tid, lane, wave); __syncthreads(); }
#endif
        STAMP(13);
        { bf16x8 m1[2][4]; fft_setup(lds, tid, lane, m1);
          fft_units(p, lds, tid, lane, wave, m1);
#if defined(REP3F)
          fft_units(p, lds, tid, lane, wave, m1);
#endif
        }
    }
#if REP3 == 2
    __syncthreads();
    if (IN(3)) {
        for (int u = blockIdx.x; u < 256; u += gridDim.x) { state_unit(p, lds, u, tid, lane, wave); __syncthreads(); }
#if defined(REP3S)
        for (int u = blockIdx.x; u < 256; u += gridDim.x) { state_unit(p, lds, u, tid, lane, wave); __syncthreads(); }
#endif
        STAMP(13);
        { bf16x8 m1[2][4]; fft_setup(lds, tid, lane, m1);
          fft_units(p, lds, tid, lane, wave, m1);
#if defined(REP3F)
          fft_units(p, lds, tid, lane, wave, m1);
#endif
        }
    }
#endif
    SEAM(3);
    if (IN(4)) for (int rep = 0; rep < REP4; ++rep) { for (int u = blockIdx.x; u < 1024; u += gridDim.x) ret_unit(p, lds, u, tid, lane, wave); }
    SEAM(4);
#if defined(REPS)
    xcd_barrier(bar); xcd_barrier(bar); xcd_barrier(bar); xcd_barrier(bar);
#endif
    if (IN(5)) {
        __syncthreads();
        pg8::Gemm g{(const bf16*)(p.ws + WS_MIX), (const bf16*)(p.ws + WS_WOT), MTOK, 1024, 1024, 1024}; pg8::StaticOrder S; S.init(MTOK, 1024, (int)gridDim.x, (int)blockIdx.x);
        EpiOut E{(bf16*)(p.ws + WS_Y), (float*)(p.ws + WS_ROWSS)};
        pg8::gemm_phase<EpiOut, pg8::StaticOrder, true, true>(lds, g, S, E);
    }
#if defined(REP5)
    __syncthreads();
    if (IN(5)) {
        __syncthreads();
        pg8::Gemm g{(const bf16*)(p.ws + WS_MIX), (const bf16*)(p.ws + WS_WOT), MTOK, 1024, 1024, 1024}; pg8::StaticOrder S; S.init(MTOK, 1024, (int)gridDim.x, (int)blockIdx.x);
        EpiOut E{(bf16*)(p.ws + WS_Y), (float*)(p.ws + WS_ROWSS)};
        pg8::gemm_phase<EpiOut, pg8::StaticOrder, true, true>(lds, g, S, E);
    }
#endif
    SEAM(5);
    if (IN(6)) phase6<0>(p, lane, wave);
#if defined(TPROBE)
    xcd_barrier(bar); STAMP(7);
    phase6<1>(p, lane, wave);
#endif
#undef IN
#undef SEAM
}

#ifndef N_LAUNCHES
#define N_LAUNCHES 1
#endif
extern "C" void kernel_launch(void* const* d_in, const int* in_sizes, int n_in, void* d_out, int out_size, void* d_ws, size_t ws_size, hipStream_t stream) {
    static int grid = 0;
    if (grid == 0) {
        if (n_in != 13 || out_size != MTOK * DM || ws_size < WS_END) { fprintf(stderr, "kernel_launch: unexpected shapes (n_in %d out %d ws %zu)\n", n_in, out_size, ws_size); grid = -1; return; }
        int dev = 0, cus = 0, per_cu = 0;
        hipGetDevice(&dev); hipDeviceGetAttribute(&cus, hipDeviceAttributeMultiprocessorCount, dev);
        if (hipFuncSetAttribute((const void*)hymba_fwd, hipFuncAttributeMaxDynamicSharedMemorySize, LDS_BYTES) != hipSuccess) { fprintf(stderr, "kernel_launch: hipFuncSetAttribute failed\n"); grid = -1; return; }
        if (hipOccupancyMaxActiveBlocksPerMultiprocessor(&per_cu, (const void*)hymba_fwd, 512, LDS_BYTES) != hipSuccess || per_cu < 1) { fprintf(stderr, "kernel_launch: occupancy query says %d\n", per_cu); per_cu = 1; }
        (void)hipGetLastError();
        grid = 256;
        if (cus < 256) { fprintf(stderr, "kernel_launch: needs 256 CUs, device has %d\n", cus); grid = -1; return; }
    }
    if (grid < 0) return;
    Params p{};
    p.x = (const float*)d_in[0]; p.c = (const float*)d_in[1]; p.ctx = (const float*)d_in[2]; p.c_ctx = (const float*)d_in[3];
    p.w_ada = (const float*)d_in[4]; p.b_ada = (const float*)d_in[5]; p.g_pre = (const float*)d_in[6]; p.g_post = (const float*)d_in[7];
    p.w_in = (const float*)d_in[8]; p.w_fourier = (const float*)d_in[9]; p.decay_logit = (const float*)d_in[10]; p.gn_gain = (const float*)d_in[11]; p.w_out = (const float*)d_in[12];
    p.out = (float*)d_out; p.ws = (unsigned char*)d_ws;
    if (hipMemsetAsync(d_ws, 0, 16384, stream) != hipSuccess) { fprintf(stderr, "kernel_launch: memset failed\n"); return; }
    if (N_LAUNCHES == 1) {
        p.ph_lo = 0; p.ph_hi = 7; p.use_cg = 0;
        void* args[] = {&p};
        hipError_t e = hipLaunchCooperativeKernel((const void*)hymba_fwd, dim3(grid), dim3(512), args, LDS_BYTES, stream);
        if (e != hipSuccess) fprintf(stderr, "cooperative launch failed: %s (grid %d)\n", hipGetErrorString(e), grid);
    } else {
        for (int ph = 0; ph < 7; ++ph) { p.ph_lo = ph; p.ph_hi = ph + 1; hipLaunchKernelGGL(hymba_fwd, dim3(grid), dim3(512), LDS_BYTES, stream, p); }
    }
}
```

```cpp
#include <hip/hip_runtime.h>
#include <hip/hip_cooperative_groups.h>
#include <cstdio>
#include <cstdint>
namespace cg = cooperative_groups;
namespace pg8 {
#define PG8_LAS __attribute__((address_space(3)))
typedef unsigned short bf16_t;
typedef short bf16x8 __attribute__((ext_vector_type(8)));
typedef float f32x4 __attribute__((ext_vector_type(4)));
typedef unsigned u32x4 __attribute__((ext_vector_type(4)));
constexpr int BM = 256, BK = 64, HALF = 128, HTB = HALF * BK * 2  , STAGE_BYTES = 8 * HTB, NXCD = 8, WGM = 8;

__host__ __device__ __forceinline__ int lds_byte(int r, int c) { const int st = (r >> 4) * 2 + (c >> 5), rr = r & 15, cc = c & 31, ob = rr * 64 + cc * 2; return st * 1024 + (ob ^ (((ob >> 9) & 1) << 5)); }
__host__ __device__ __forceinline__ void stage_rc(int b, int& R, int& C) { const int st = b / 1024, sb = b % 1024, swz = sb ^ (((sb >> 9) & 1) << 5); R = (st >> 1) * 16 + swz / 64; C = (st & 1) * 32 + (swz % 64) / 2; }
__host__ __device__ __forceinline__ int perm32(int rho) { const int n = rho >> 4, i = rho & 15; return 8 * (i >> 2) + 4 * n + (i & 3); }

struct Unit { int pm, pn; };
struct Gemm { const bf16_t* A; const bf16_t* Bt; int M, N, K, ld; };

struct StaticOrder {
    int nM, nN, nwg, G, c;
    __host__ __device__ void init(int M, int N, int G_, int c_) { nM = M / BM; nN = N / BM; nwg = nM * nN; G = G_; c = c_; }
    __host__ __device__ bool next(int i, Unit& u) const {
        const long L = (long)i * G + c; if (L >= nwg) return false;
        int wgid = (int)L; { const int q = nwg / NXCD, r = nwg % NXCD, xcd = wgid % NXCD, off = wgid / NXCD; wgid = (xcd < r ? xcd * (q + 1) : r * (q + 1) + (xcd - r) * q) + off; }
        const int nig = WGM * nN, gid = wgid / nig, fm = gid * WGM, gsz = (nM - fm) < WGM ? (nM - fm) : WGM;
        u.pm = fm + ((wgid % nig) % gsz); u.pn = (wgid % nig) / gsz; return true;
    }
    __device__ __forceinline__ void a_ready(const Unit&) const {}
    __device__ __forceinline__ void done(const Unit&) const {}
};

__device__ __forceinline__ unsigned cvt_pk_bf16(float lo, float hi) { unsigned r; asm volatile("v_cvt_pk_bf16_f32 %0, %1, %2" : "=v"(r) : "v"(lo), "v"(hi)); return r; }

template <class Epi, class Sched, bool ALIGN_EPI = false, bool SP2 = false>
__device__ __forceinline__ void gemm_phase(PG8_LAS unsigned char* lds, const Gemm g, const Sched& S, const Epi& E) {
    const int tid = threadIdx.x, wid = __builtin_amdgcn_readfirstlane(tid >> 6), lane = tid & 63, wr = wid >> 2, wc = wid & 3, fr = lane & 15, fq = lane >> 4;
    const int K = g.K, nt = K / BK;
    unsigned voffA[2], voffB[2];
#pragma unroll
    for (int i = 0; i < 2; ++i) { int R, C; stage_rc(tid * 16 + i * 8192, R, C); const int Rb = Epi::PERM ? ((R & ~31) + perm32(R & 31)) : R;
        voffA[i] = (unsigned)(R * g.ld + C) * 2u; voffB[i] = (unsigned)(Rb * g.ld + C) * 2u; }
    const size_t kstep = (size_t)(BK * 2);
    const size_t hstep = (size_t)HALF * g.ld * 2;
    const size_t tstep = 2 * hstep;
    const unsigned ldsw = (unsigned)wid * 1024u;
    const int aoff = lds_byte(wr * 64 + fr, fq * 8), boff = lds_byte(wc * 32 + fr, fq * 8);
#define PG8_SA(b, h) (((b) * 2 + (h)) * HTB)
#define PG8_SB(b, h) ((4 + (b) * 2 + (h)) * HTB)
#define PG8_STAGE(bufoff, gbase, voff) do { _Pragma("unroll") for (int _i = 0; _i < 2; ++_i) \
        __builtin_amdgcn_global_load_lds((const unsigned*)((const char*)(gbase) + (voff)[_i]), (PG8_LAS unsigned*)(lds + (bufoff) + ldsw + _i * 8192), 16, 0, 0); } while (0)
#define PG8_LDA(dst, b, h) do { _Pragma("unroll") for (int m = 0; m < 4; ++m) _Pragma("unroll") for (int k = 0; k < 2; ++k) dst[m][k] = *(const PG8_LAS bf16x8*)(lds + PG8_SA(b, h) + aoff + m * 2048 + k * 1024); } while (0)
#define PG8_LDB(dst, b, h) do { _Pragma("unroll") for (int n = 0; n < 2; ++n) _Pragma("unroll") for (int k = 0; k < 2; ++k) dst[n][k] = *(const PG8_LAS bf16x8*)(lds + PG8_SB(b, h) + boff + n * 2048 + k * 1024); } while (0)
#define PG8_MMA(ai, bj, At, Bt) do { __builtin_amdgcn_s_setprio(1); _Pragma("unroll") for (int m = 0; m < 4; ++m) _Pragma("unroll") for (int n = 0; n < 2; ++n) _Pragma("unroll") for (int k = 0; k < 2; ++k) \
        acc[ai][bj][m][n] = __builtin_amdgcn_mfma_f32_16x16x32_bf16(Bt[n][k], At[m][k], acc[ai][bj][m][n], 0, 0, 0); __builtin_amdgcn_s_setprio(0); } while (0)
#define PG8_WAIT_V(n) asm volatile("s_waitcnt vmcnt(" #n ")" ::: "memory")
#define PG8_WAIT_L(n) asm volatile("s_waitcnt lgkmcnt(" #n ")" ::: "memory")
#define PG8_BAR __builtin_amdgcn_s_barrier()
#define PG8_SCHED __builtin_amdgcn_sched_barrier(0)
    Unit cur, nxt; int ui = 0;
    if (!S.next(0, cur)) return;
    f32x4 acc[2][2][4][2];
#pragma unroll
    for (int a = 0; a < 2; ++a)
#pragma unroll
        for (int b = 0; b < 2; ++b)
#pragma unroll
            for (int m = 0; m < 4; ++m)
#pragma unroll
                for (int n = 0; n < 2; ++n) acc[a][b][m][n] = (f32x4){0.f, 0.f, 0.f, 0.f};
    bf16x8 At[4][2], B0[2][2], B1[2][2];
    const char* cA = (const char*)g.A + (size_t)cur.pm * tstep; const char* cB = (const char*)g.Bt + (size_t)cur.pn * tstep;
    S.a_ready(cur);
    if constexpr (SP2) {
        PG8_STAGE(PG8_SB(0, 0), cB, voffB); PG8_STAGE(PG8_SB(0, 1), cB + hstep, voffB); PG8_STAGE(PG8_SA(0, 0), cA, voffA); PG8_STAGE(PG8_SA(0, 1), cA + hstep, voffA);
        if (wr == 1) PG8_BAR;
        PG8_WAIT_V(2); PG8_BAR;
        PG8_STAGE(PG8_SB(1, 0), cB + kstep, voffB); PG8_STAGE(PG8_SA(1, 0), cA + kstep, voffA); PG8_STAGE(PG8_SB(1, 1), cB + hstep + kstep, voffB);
        PG8_WAIT_V(6); PG8_BAR;
    } else {
        PG8_STAGE(PG8_SB(0, 0), cB, voffB); PG8_STAGE(PG8_SA(0, 0), cA, voffA); PG8_STAGE(PG8_SB(0, 1), cB + hstep, voffB); PG8_STAGE(PG8_SA(0, 1), cA + hstep, voffA);
        if (wr == 1) PG8_BAR;
        PG8_WAIT_V(4); PG8_BAR;
        PG8_STAGE(PG8_SB(1, 0), cB + kstep, voffB); PG8_STAGE(PG8_SA(1, 0), cA + kstep, voffA); PG8_STAGE(PG8_SB(1, 1), cB + hstep + kstep, voffB);
        PG8_WAIT_V(6); PG8_BAR;
    }
    for (;;) {
        const bool has_next = S.next(ui + 1, nxt);
        const char* nA = has_next ? (const char*)g.A + (size_t)nxt.pm * tstep : cA; const char* nB = has_next ? (const char*)g.Bt + (size_t)nxt.pn * tstep : cB;
        for (int t = 0; t < nt; t += 2) {
            const bool last = (t == nt - 2);
            const char* a1 = cA + (size_t)(t + 1) * kstep;
            const char* a2 = last ? nA : cA + (size_t)(t + 2) * kstep; const char* b2 = last ? nB : cB + (size_t)(t + 2) * kstep;
            const char* a3 = a2 + kstep; const char* b3 = b2 + kstep;
            if (last && has_next) S.a_ready(nxt);
            if constexpr (SP2) {
            PG8_LDB(B0, 0, 0); PG8_LDB(B1, 0, 1); PG8_SCHED; PG8_LDA(At, 0, 0); PG8_STAGE(PG8_SA(1, 1), a1 + hstep, voffA);
            PG8_WAIT_V(8); PG8_WAIT_L(0); PG8_BAR; PG8_MMA(0, 0, At, B0); PG8_MMA(0, 1, At, B1); PG8_BAR; PG8_SCHED;
            PG8_LDA(At, 0, 1); PG8_STAGE(PG8_SB(0, 0), b2, voffB); PG8_STAGE(PG8_SB(0, 1), b2 + hstep, voffB); PG8_STAGE(PG8_SA(0, 0), a2, voffA);
            PG8_WAIT_V(8); PG8_WAIT_L(0); PG8_BAR; PG8_MMA(1, 0, At, B0); PG8_MMA(1, 1, At, B1); PG8_BAR; PG8_SCHED;
            PG8_LDB(B0, 1, 0); PG8_LDB(B1, 1, 1); PG8_SCHED; PG8_LDA(At, 1, 0); PG8_STAGE(PG8_SA(0, 1), a2 + hstep, voffA);
            PG8_WAIT_V(8); PG8_WAIT_L(0); PG8_BAR; PG8_MMA(0, 0, At, B0); PG8_MMA(0, 1, At, B1); PG8_BAR; PG8_SCHED;
            PG8_LDA(At, 1, 1); PG8_STAGE(PG8_SB(1, 0), b3, voffB); PG8_STAGE(PG8_SB(1, 1), b3 + hstep, voffB); PG8_STAGE(PG8_SA(1, 0), a3, voffA);
            PG8_WAIT_V(8); PG8_WAIT_L(0); PG8_BAR; PG8_MMA(1, 0, At, B0); PG8_MMA(1, 1, At, B1); PG8_BAR; PG8_SCHED;
            } else {
            PG8_LDB(B0, 0, 0); PG8_SCHED; PG8_LDA(At, 0, 0); PG8_STAGE(PG8_SA(1, 1), a1 + hstep, voffA);
            PG8_WAIT_L(8); PG8_BAR; PG8_WAIT_L(0); PG8_MMA(0, 0, At, B0); PG8_BAR; PG8_SCHED;
            PG8_LDB(B1, 0, 1); PG8_STAGE(PG8_SB(0, 0), b2, voffB);
            PG8_BAR; PG8_WAIT_L(0); PG8_MMA(0, 1, At, B1); PG8_BAR;
            PG8_LDA(At, 0, 1); PG8_STAGE(PG8_SA(0, 0), a2, voffA);
            PG8_BAR; PG8_WAIT_L(0); PG8_MMA(1, 0, At, B0); PG8_BAR; PG8_SCHED;
            PG8_STAGE(PG8_SB(0, 1), b2 + hstep, voffB);
            PG8_WAIT_V(6); PG8_BAR; PG8_MMA(1, 1, At, B1); PG8_BAR;
            PG8_LDB(B0, 1, 0); PG8_SCHED; PG8_LDA(At, 1, 0); PG8_STAGE(PG8_SA(0, 1), a2 + hstep, voffA);
            PG8_WAIT_L(8); PG8_BAR; PG8_WAIT_L(0); PG8_MMA(0, 0, At, B0); PG8_BAR; PG8_SCHED;
            PG8_LDB(B1, 1, 1); PG8_STAGE(PG8_SB(1, 0), b3, voffB);
            PG8_BAR; PG8_WAIT_L(0); PG8_MMA(0, 1, At, B1); PG8_BAR;
            PG8_LDA(At, 1, 1); PG8_STAGE(PG8_SA(1, 0), a3, voffA);
            PG8_BAR; PG8_WAIT_L(0); PG8_MMA(1, 0, At, B0); PG8_BAR; PG8_SCHED;
            PG8_STAGE(PG8_SB(1, 1), b3 + hstep, voffB);
            PG8_WAIT_V(6); PG8_BAR; PG8_MMA(1, 1, At, B1); PG8_BAR;
            }
        }
        if constexpr (ALIGN_EPI) { if (wr == 0) PG8_BAR; }
        if constexpr (!Epi::AFTER_DRAIN) { E(acc, cur, wr, wc, fr, fq); S.done(cur); }
        if (!has_next) break;
#pragma unroll
        for (int a = 0; a < 2; ++a)
#pragma unroll
            for (int b = 0; b < 2; ++b)
#pragma unroll
                for (int m = 0; m < 4; ++m)
#pragma unroll
                    for (int n = 0; n < 2; ++n) acc[a][b][m][n] = (f32x4){0.f, 0.f, 0.f, 0.f};
        cur = nxt; cA = nA; cB = nB; ++ui;
        if constexpr (ALIGN_EPI) { if (wr == 1) PG8_BAR; }
    }
    PG8_WAIT_V(0);
    if constexpr (!ALIGN_EPI) { if (wr == 0) PG8_BAR; }
    PG8_BAR;
    if constexpr (Epi::AFTER_DRAIN) { E.fused(acc, cur, wr, wc, fr, fq, lds, wid, lane); S.done(cur); }
#undef PG8_SA
#undef PG8_SB
#undef PG8_STAGE
#undef PG8_LDA
#undef PG8_LDB
#undef PG8_MMA
#undef PG8_WAIT_V
#undef PG8_WAIT_L
#undef PG8_BAR
#undef PG8_SCHED
}
}

#define LAS __attribute__((address_space(3)))
#define DI __device__ __forceinline__
typedef unsigned short bf16;
typedef unsigned v4u __attribute__((ext_vector_type(4)));
typedef unsigned v2u __attribute__((ext_vector_type(2)));
typedef float f32x4 __attribute__((ext_vector_type(4)));
typedef short bf16x8 __attribute__((ext_vector_type(8)));
typedef short s16x4 __attribute__((ext_vector_type(4)));

constexpr int NB = 16, SEQ = 2048, DM = 1024, MTOK = NB * SEQ, CTXL = 256, MCTX = NB * CTXL;
constexpr int PROJ_LD = 2560;
constexpr int PC_G = 0, PC_Q = 512, PC_K = 1024, PC_V = 1536, PC_R = 2048;
constexpr float EPSV = 1e-6f;
constexpr float QK_SCALE = 0.08838834764831845f;
constexpr int RT_CTX = 128, RT_W = 144, RT_WF = 154, RA_ROWS = 158 * 256;
constexpr int G1_MAIN = 1280, G1_FT = 512, G1_UNITS = G1_MAIN + G1_FT;

constexpr size_t MiB = 1u << 20;
constexpr size_t WS_ADA = 1 * MiB;
constexpr size_t WS_ROPE = WS_ADA + 256 * 1024;
constexpr size_t WS_ROWSS = 396 * MiB;
constexpr size_t WS_RA = 2 * MiB;
constexpr size_t WS_MIX = WS_RA;
constexpr size_t WS_PROJ = 82 * MiB;
constexpr size_t WS_Y = WS_PROJ;
constexpr size_t WS_KVC = 242 * MiB;
constexpr size_t WS_ZT = 250 * MiB;
constexpr size_t WS_DT = 314 * MiB;
constexpr size_t WS_ST = 330 * MiB;
constexpr size_t WS_WOT = 394 * MiB;
constexpr size_t WS_YT = 398 * MiB;
constexpr size_t WS_KVCP = 430 * MiB;
constexpr size_t WS_END = 462 * MiB;
constexpr int LDS_BYTES = 147456, LDS_MISC = 139264;

struct Params {
    const float *x, *c, *ctx, *c_ctx, *w_ada, *b_ada, *g_pre, *g_post, *w_in, *w_fourier, *decay_logit, *gn_gain, *w_out;
    float* out; unsigned char* ws; int ph_lo, ph_hi, use_cg, pad;
};

DI unsigned f2bf(float f) { unsigned u = __builtin_bit_cast(unsigned, f); return (u + 0x7fffu + ((u >> 16) & 1u)) >> 16; }
DI unsigned pk2(float lo, float hi) { unsigned r; asm("v_cvt_pk_bf16_f32 %0, %1, %2\n\ts_nop 1" : "=v"(r) : "v"(lo), "v"(hi)); return r; }
DI float bflo(unsigned u) { return __builtin_bit_cast(float, u << 16); }
DI float bfhi(unsigned u) { return __builtin_bit_cast(float, u & 0xffff0000u); }
DI float silu_f(float v) { return v / (1.f + __expf(-v)); }
DI float wave_sum(float v) {
#pragma unroll
    for (int o = 1; o < 64; o <<= 1) v += __shfl_xor(v, o);
    return v;
}
DI unsigned offb(unsigned row, unsigned ch) { return 256u * row + 16u * (ch ^ (((row & 3) << 2) | ((row >> 2) & 3))); }
DI s16x4 tr_read(LAS unsigned char* p) { return __builtin_amdgcn_ds_read_tr16_b64_v4i16((LAS s16x4*)p); }
DI bf16x8 cat8(s16x4 a, s16x4 b) { bf16x8 r; r[0] = a[0]; r[1] = a[1]; r[2] = a[2]; r[3] = a[3]; r[4] = b[0]; r[5] = b[1]; r[6] = b[2]; r[7] = b[3]; return r; }
#define MFMA16(a, b, c) __builtin_amdgcn_mfma_f32_16x16x32_bf16((a), (b), (c), 0, 0, 0)

struct G1Order {
    int G, c;
    DI bool next(int i, pg8::Unit& u) const {
        const int L = i * G + c; if (L >= G1_UNITS) return false;
        if (L < G1_MAIN) {
            const int wgid = (L & 7) * (G1_MAIN / 8) + (L >> 3);
            const int r80 = wgid % 80;
            u.pm = (wgid / 80) * 8 + (r80 & 7); u.pn = RT_W + (r80 >> 3);
        } else {
            const int l2 = L - G1_MAIN, idx = (l2 & 7) * (G1_FT / 8) + (l2 >> 3);
            u.pm = RT_WF + (idx & 3); u.pn = idx >> 2;
        }
        return true;
    }
    DI void a_ready(const pg8::Unit&) const {}
    DI void done(const pg8::Unit&) const {}
};

DI v4u pack8(f32x4 a, f32x4 b) { v4u w; w.x = pk2(a[0], a[1]); w.y = pk2(a[2], a[3]); w.z = pk2(b[0], b[1]); w.w = pk2(b[2], b[3]); return w; }

struct EpiG1 {
    static constexpr bool PERM = true, AFTER_DRAIN = false;
    bf16* PROJ; bf16* ZT; bf16* KVC; const float* rope;
    DI void operator()(const f32x4 (&acc)[2][2][4][2], const pg8::Unit& u, int wr, int wc, int fr, int fq) const {
        const int rl0 = wr * 64 + fr, cl0 = wc * 32 + 8 * fq;
        bf16* base; int ld, mode = 0; float sc = 1.f;
        if (u.pm < RT_CTX) {
            const int wt = u.pn - RT_W, type = wt >> 1;
            base = PROJ + (size_t)(u.pm * 256) * PROJ_LD + wt * 256; ld = PROJ_LD;
            mode = (type == 1 || type == 2) ? 1 : (type == 3 ? 0 : 2); sc = (type == 1) ? QK_SCALE : 1.f;
        } else if (u.pm >= RT_WF) {
            base = ZT + ((size_t)(u.pn >> 3) * 1024 + (u.pm - RT_WF) * 256) * SEQ + (u.pn & 7) * 256; ld = SEQ;
        } else {
            base = KVC + (size_t)((u.pm - RT_CTX) * 256) * 1024 + (u.pn - RT_W - 4) * 256; ld = 1024;
        }
        base += (size_t)rl0 * ld + cl0;
        const int lbase = (u.pm * 256 + rl0) & (SEQ - 1);
        const float* rbase = rope + (16 * (wc & 1) + 4 * fq) * 2;
#pragma unroll
        for (int ai = 0; ai < 2; ++ai)
#pragma unroll
            for (int m = 0; m < 4; ++m) {
                bf16* rowp = base + (size_t)(ai * 128 + m * 16) * ld;
                f32x4 v00 = acc[ai][0][m][0], v01 = acc[ai][0][m][1], v10 = acc[ai][1][m][0], v11 = acc[ai][1][m][1];
                if (mode == 1) {
                    const int l = lbase + ai * 128 + m * 16;
                    const int pos = (wc >> 1) ? (l & 63) : (l >> 6);
                    const f32x4 r0 = *(const f32x4*)(rbase + pos * 64), r1 = *(const f32x4*)(rbase + pos * 64 + 4);
                    f32x4 t;
                    t = v00 * sc; v00[0] = t[0] * r0[0] - t[1] * r0[1]; v00[1] = t[0] * r0[1] + t[1] * r0[0]; v00[2] = t[2] * r0[2] - t[3] * r0[3]; v00[3] = t[2] * r0[3] + t[3] * r0[2];
                    t = v01 * sc; v01[0] = t[0] * r1[0] - t[1] * r1[1]; v01[1] = t[0] * r1[1] + t[1] * r1[0]; v01[2] = t[2] * r1[2] - t[3] * r1[3]; v01[3] = t[2] * r1[3] + t[3] * r1[2];
                    t = v10 * sc; v10[0] = t[0] * r0[0] - t[1] * r0[1]; v10[1] = t[0] * r0[1] + t[1] * r0[0]; v10[2] = t[2] * r0[2] - t[3] * r0[3]; v10[3] = t[2] * r0[3] + t[3] * r0[2];
                    t = v11 * sc; v11[0] = t[0] * r1[0] - t[1] * r1[1]; v11[1] = t[0] * r1[1] + t[1] * r1[0]; v11[2] = t[2] * r1[2] - t[3] * r1[3]; v11[3] = t[2] * r1[3] + t[3] * r1[2];
                } else if (mode == 2) {
#pragma unroll
                    for (int j = 0; j < 4; ++j) { v00[j] = silu_f(v00[j]); v01[j] = silu_f(v01[j]); v10[j] = silu_f(v10[j]); v11[j] = silu_f(v11[j]); }
                }
                *(v4u*)(rowp) = pack8(v00, v01);
                *(v4u*)(rowp + 128) = pack8(v10, v11);
                asm volatile("" ::: "memory");
            }
    }
};

struct OneUnit { int pm, pn;
    DI bool next(int i, pg8::Unit& u) const { if (i) return false; u.pm = pm; u.pn = pn; return true; }
    DI void a_ready(const pg8::Unit&) const {}
    DI void done(const pg8::Unit&) const {}
};
struct EpiCtx {
    static constexpr bool PERM = true, AFTER_DRAIN = false;
    bf16* O;
    DI void operator()(const f32x4 (&acc)[2][2][4][2], const pg8::Unit& u, int wr, int wc, int fr, int fq) const {
        bf16* base = O + (size_t)((u.pm - RT_CTX) * 256 + wr * 64 + fr) * 1024 + (u.pn - RT_W - 4) * 256 + wc * 32 + 8 * fq;
#pragma unroll
        for (int ai = 0; ai < 2; ++ai)
#pragma unroll
            for (int m = 0; m < 4; ++m) { bf16* rowp = base + (size_t)(ai * 128 + m * 16) * 1024;
                *(v4u*)(rowp) = pack8(acc[ai][0][m][0], acc[ai][0][m][1]); *(v4u*)(rowp + 128) = pack8(acc[ai][1][m][0], acc[ai][1][m][1]); }
    }
};

struct EpiDft {
    static constexpr bool PERM = true, AFTER_DRAIN = false;
    const bf16* PROJ; bf16* MIX;
    DI void operator()(const f32x4 (&acc)[2][2][4][2], const pg8::Unit& u, int wr, int wc, int fr, int fq) const {
        const int rl0 = wr * 64 + fr, cl0 = wc * 32 + 8 * fq;
        const int b = u.pn >> 1, chg0 = (u.pn & 1) * 256 + cl0;
#pragma unroll
        for (int ai = 0; ai < 2; ++ai)
#pragma unroll
            for (int m = 0; m < 4; ++m) {
                const size_t tok = (size_t)b * SEQ + u.pm * 256 + rl0 + ai * 128 + m * 16;
#pragma unroll
                for (int bj = 0; bj < 2; ++bj) {
                    const v4u g = *(const v4u*)(PROJ + tok * PROJ_LD + PC_G + chg0 + bj * 128);
                    f32x4 v0 = acc[ai][bj][m][0], v1 = acc[ai][bj][m][1];
                    v0[0] *= bflo(g.x); v0[1] *= bfhi(g.x); v0[2] *= bflo(g.y); v0[3] *= bfhi(g.y);
                    v1[0] *= bflo(g.z); v1[1] *= bfhi(g.z); v1[2] *= bflo(g.w); v1[3] *= bfhi(g.w);
                    *(v4u*)(MIX + tok * 1024 + chg0 + bj * 128) = pack8(v0, v1);
                }
            }
    }
};

struct EpiOut {
    static constexpr bool PERM = true, AFTER_DRAIN = false;
    bf16* Y; float* rowss;
    DI void operator()(const f32x4 (&acc)[2][2][4][2], const pg8::Unit& u, int wr, int wc, int fr, int fq) const {
        const int rl0 = wr * 64 + fr, cl0 = u.pn * 256 + wc * 32 + 8 * fq;
#pragma unroll
        for (int ai = 0; ai < 2; ++ai)
#pragma unroll
            for (int m = 0; m < 4; ++m) {
                const int row = u.pm * 256 + rl0 + ai * 128 + m * 16;
                float ss = 0.f;
#pragma unroll
                for (int bj = 0; bj < 2; ++bj) {
                    const f32x4 v0 = acc[ai][bj][m][0], v1 = acc[ai][bj][m][1];
                    ss += (v0[0] * v0[0] + v0[1] * v0[1]) + (v0[2] * v0[2] + v0[3] * v0[3]) + (v1[0] * v1[0] + v1[1] * v1[1]) + (v1[2] * v1[2] + v1[3] * v1[3]);
                    *(v4u*)(Y + (size_t)row * 1024 + cl0 + bj * 128) = pack8(v0, v1);
                }
                ss += __shfl_xor(ss, 16); ss += __shfl_xor(ss, 32);
                if (fq == 0) rowss[(size_t)row * 16 + u.pn * 4 + wc] = ss;
            }
    }
};

DI int w1_srccol(int n) {
    const int t = n >> 9; int src = 512 + n;
    if (t == 1 || t == 2) { const int p = n & 127, hs = p >> 6, w = p & 63; src = 512 + (n & ~127) + hs * 64 + (w & 1) * 32 + (w >> 1); }
    return src;
}
template <bool MAIN>
DI void transpose_item(const float* W, int N, bf16* WT, int item, LAS float* scr, int lane) {
    const int nblk = MAIN ? 80 : 32, kb = item / nblk, nb = item % nblk, k0 = 64 * kb, n0 = 32 * nb;
    const int nl = lane & 31, sc = MAIN ? w1_srccol(n0 + nl) : (n0 + nl);
#pragma unroll 8
    for (int i = 0; i < 32; ++i) { const int kk = 2 * i + (lane >> 5); scr[kk * 33 + nl] = W[(size_t)(k0 + kk) * N + sc]; }
    asm volatile("s_waitcnt lgkmcnt(0)" ::: "memory");
    const int c = lane & 7;
#pragma unroll
    for (int j = 0; j < 4; ++j) { const int n = (lane >> 3) + 8 * j; const LAS float* s = scr + (8 * c) * 33 + n;
        v4u o; o.x = pk2(s[0 * 33], s[1 * 33]); o.y = pk2(s[2 * 33], s[3 * 33]); o.z = pk2(s[4 * 33], s[5 * 33]); o.w = pk2(s[6 * 33], s[7 * 33]);
        *(v4u*)(WT + (size_t)(n0 + n) * 1024 + k0 + 8 * c) = o; }
    asm volatile("s_waitcnt lgkmcnt(0)" ::: "memory");
}

#if defined(TPROBE)
#define PSTAMP(k) do { if (blockIdx.x == 0 && tid == 0) ((unsigned long long*)(p.ws + 32768))[k] = __builtin_amdgcn_s_memrealtime(); } while (0)
#else
#define PSTAMP(k) do {} while (0)
#endif
DI void phase0(const Params& p, LAS unsigned char* lds, int tid, int lane, int wave) {
    float* ADA = (float*)(p.ws + WS_ADA); float* rope = (float*)(p.ws + WS_ROPE);
    bf16* RA = (bf16*)(p.ws + WS_RA); bf16* WOT = (bf16*)(p.ws + WS_WOT);
    bf16* W1T = RA + (size_t)RT_W * 256 * 1024; bf16* WFT = RA + (size_t)RT_WF * 256 * 1024;
    LAS float* sl = (LAS float*)lds; LAS float* red = sl + 17 * 1024;
    for (int i = tid; i < 17 * 1024; i += 512) { const int v = i >> 10, k = i & 1023; const float cv = (v < 16) ? p.c[v * 1024 + k] : p.c_ctx[k]; sl[i] = cv / (1.f + expf(-cv)); }
    __syncthreads();
    for (int vw = blockIdx.x; vw < 256; vw += gridDim.x) {
        const int j0 = 12 * vw, col = tid & 15, ks = tid >> 4;
        float acc[17];
#pragma unroll
        for (int v = 0; v < 17; ++v) acc[v] = 0.f;
        if (col < 12) {
            float wv[32];
#pragma unroll
            for (int kk = 0; kk < 32; ++kk) wv[kk] = p.w_ada[(size_t)(ks * 32 + kk) * 3072 + j0 + col];
#pragma unroll
            for (int kk = 0; kk < 32; ++kk) { const int k = ks * 32 + kk;
#pragma unroll
                for (int v = 0; v < 17; ++v) acc[v] += sl[v * 1024 + k] * wv[kk]; }
#pragma unroll
            for (int v = 0; v < 17; ++v) red[(ks * 17 + v) * 12 + col] = acc[v];
        }
        __syncthreads();
        if (tid < 204) { const int v = tid / 12, cc = tid % 12; float s = p.b_ada[j0 + cc];
            for (int k2 = 0; k2 < 32; ++k2) s += red[(k2 * 17 + v) * 12 + cc];
            ADA[v * 3072 + j0 + cc] = s; }
        __syncthreads();
    }
    PSTAMP(10);
    {
        LAS float* scr = (LAS float*)(lds + wave * 8448);
        const int gw = blockIdx.x * 8 + wave, NGW = gridDim.x * 8;
        for (int it = gw; it < 1280 + 512; it += NGW) {
            if (it < 1280) transpose_item<true>(p.w_in, 3072, W1T, it, scr, lane);
            else transpose_item<false>(p.w_out, 1024, WOT, it - 1280, scr, lane);
        }
    }
    __syncthreads();
    PSTAMP(11);
    {
        LAS float* ctab = (LAS float*)(lds + 98304); LAS float* stab = ctab + 128;
        LAS unsigned char* CSimg = lds; LAS unsigned char* Wimg = lds + 65536;
        if (tid < 128) { float sn, cs; sincospif((float)tid * (1.f / 64.f), &sn, &cs); ctab[tid] = cs; stab[tid] = sn; }
        __syncthreads();
#pragma unroll 1
        for (int q = 0; q < 8; ++q) { const int id = tid + 512 * q, pq = id >> 11, c = (id >> 4) & 127, ch = id & 15; float v[8];
#pragma unroll
            for (int e = 0; e < 8; ++e) { const int idx = (c * (ch * 8 + e)) & 127; v[e] = pq ? stab[idx] : ctab[idx]; }
            v4u o; o.x = pk2(v[0], v[1]); o.y = pk2(v[2], v[3]); o.z = pk2(v[4], v[5]); o.w = pk2(v[6], v[7]); *(LAS v4u*)(CSimg + pq * 32768 + offb(c, ch)) = o; }
        const int fr = lane & 15, fq = lane >> 4, q4 = fr >> 2, pp = fr & 3;
        for (int vw = blockIdx.x; vw < 256; vw += gridDim.x) {
            const int g = vw >> 6, kb = vw & 63;
            __syncthreads();
#pragma unroll
            for (int q = 0; q < 4; ++q) { const int id = tid + 512 * q, j = id >> 4, ch = id & 15; const f32x4* wp = (const f32x4*)(p.w_fourier + (size_t)(g * 128 + j) * 128 + ch * 8);
                *(LAS v4u*)(Wimg + offb(j, ch)) = pack8(wp[0], wp[1]); }
            f32x4 wa[4][2];
#pragma unroll
            for (int ks = 0; ks < 4; ++ks) { const float* wr_ = p.w_in + (size_t)(16 * kb + fr) * 3072 + g * 128 + 32 * ks + 4 * fq; wa[ks][0] = *(const f32x4*)wr_; wa[ks][1] = *(const f32x4*)(wr_ + 16); }
            __syncthreads();
            bf16x8 wb[4];
#pragma unroll
            for (int ks = 0; ks < 4; ++ks) { const unsigned r0 = 32 * ks + 8 * fq + q4;
                wb[ks] = cat8(tr_read(Wimg + offb(r0, 2 * wave + (pp >> 1)) + 8 * (pp & 1)), tr_read(Wimg + offb(r0 + 4, 2 * wave + (pp >> 1)) + 8 * (pp & 1))); }
            asm volatile("s_waitcnt lgkmcnt(0)" ::: "memory");
            bf16* outp = WFT + (size_t)((g * 128 + 16 * wave + fr) * 2) * 1024 + 16 * kb + 4 * fq;
#pragma unroll
            for (int pq = 0; pq < 2; ++pq) {
                f32x4 acc2 = (f32x4){0.f, 0.f, 0.f, 0.f};
#pragma unroll
                for (int k2 = 0; k2 < 4; ++k2) {
                    v4u tb;
#pragma unroll
                    for (int hf = 0; hf < 2; ++hf) { const int ct = 2 * k2 + hf; f32x4 t = (f32x4){0.f, 0.f, 0.f, 0.f};
#pragma unroll
                        for (int ks = 0; ks < 4; ++ks) t = MFMA16(*(const LAS bf16x8*)(CSimg + pq * 32768 + offb(16 * ct + fr, 4 * ks + fq)), wb[ks], t);
                        if (hf == 0) { tb.x = pk2(t[0], t[1]); tb.y = pk2(t[2], t[3]); } else { tb.z = pk2(t[0], t[1]); tb.w = pk2(t[2], t[3]); } }
                    acc2 = MFMA16(__builtin_bit_cast(bf16x8, pack8(wa[k2][0], wa[k2][1])), __builtin_bit_cast(bf16x8, tb), acc2);
                }
                v2u o; o.x = pk2(acc2[0] * (1.f / 512.f), acc2[1] * (1.f / 512.f)); o.y = pk2(acc2[2] * (1.f / 512.f), acc2[3] * (1.f / 512.f));
                *(v2u*)(outp + pq * 1024) = o;
            }
        }
        __syncthreads();
    }
    PSTAMP(12);
    for (int vw = blockIdx.x; vw < 256; vw += gridDim.x) {
        if (vw < 4) { const int idx = vw * 512 + tid, pos = idx >> 5, i = idx & 31; const float inv = powf(10000.f, -(float)i * (1.f / 32.f)); const float ang = (float)pos * inv;
            rope[idx * 2] = cosf(ang); rope[idx * 2 + 1] = sinf(ang); }
    }
}

constexpr int RW = 4;
DI void phase1(const Params& p, int lane, int wave) {
    const float* ADA = (const float*)(p.ws + WS_ADA); bf16* RA = (bf16*)(p.ws + WS_RA);
    const int gw = blockIdx.x * 8 + wave, NGW = gridDim.x * 8, NR = MTOK + MCTX; int rpw = (NR + NGW - 1) / NGW; rpw = (rpw + RW - 1) / RW * RW;
    int r0 = gw * rpw, r1 = r0 + rpw; if (r1 > NR) r1 = NR;
    int vcur = -1; f32x4 gs[4], sh[4];
    for (int r = r0; r < r1; r += RW) {
        const int v = (r < MTOK) ? (r >> 11) : 16;
        const float* xr = (r < MTOK) ? p.x + (size_t)r * 1024 : p.ctx + (size_t)(r - MTOK) * 1024;
        f32x4 xv[RW][4];
#pragma unroll
        for (int q = 0; q < RW; ++q)
#pragma unroll
            for (int j = 0; j < 4; ++j) xv[q][j] = *(const f32x4*)(xr + q * 1024 + lane * 4 + 256 * j);
        if (v != vcur) { vcur = v;
#pragma unroll
            for (int j = 0; j < 4; ++j) { const int col = lane * 4 + 256 * j; const f32x4 g = *(const f32x4*)(p.g_pre + col), sc = *(const f32x4*)(ADA + v * 3072 + 1024 + col);
                gs[j] = g * (sc + 1.f); sh[j] = *(const f32x4*)(ADA + v * 3072 + col); } }
        float ss[RW];
#pragma unroll
        for (int q = 0; q < RW; ++q) { ss[q] = 0.f;
#pragma unroll
            for (int j = 0; j < 4; ++j) ss[q] += (xv[q][j][0] * xv[q][j][0] + xv[q][j][1] * xv[q][j][1]) + (xv[q][j][2] * xv[q][j][2] + xv[q][j][3] * xv[q][j][3]); }
#pragma unroll
        for (int o = 1; o < 64; o <<= 1)
#pragma unroll
            for (int q = 0; q < RW; ++q) ss[q] += __shfl_xor(ss[q], o);
        bf16* ob = RA + (size_t)r * 1024;
#pragma unroll
        for (int q = 0; q < RW; ++q) { const float rs = rsqrtf(ss[q] * (1.f / 1024.f) + EPSV);
#pragma unroll
            for (int j = 0; j < 4; ++j) { const f32x4 hv = xv[q][j] * rs * gs[j] + sh[j]; v2u w; w.x = pk2(hv[0], hv[1]); w.y = pk2(hv[2], hv[3]); *(v2u*)(ob + q * 1024 + lane * 4 + 256 * j) = w; } }
    }
}

DI void state_unit(const Params& p, LAS unsigned char* lds, int unit, int tid, int lane, int wave) {
    const bf16* PROJ = (const bf16*)(p.ws + WS_PROJ); const bf16* KVC = (const bf16*)(p.ws + WS_KVC); const bf16* KVCP = (const bf16*)(p.ws + WS_KVCP); bf16* ST = (bf16*)(p.ws + WS_ST);
    const int eh = unit & 1, dir = (unit >> 1) & 1, h = (unit >> 2) & 3, b = unit >> 4;
    const int fr = lane & 15, fq = lane >> 4, q4 = fr >> 2, pp = fr & 3;
    const int et = wave & 3, dtb = (wave >> 2) * 4, cb = 4 * eh + et;
    const float lg = p.decay_logit[dir * 4 + h]; const float l2 = -log1pf(expf(-lg)) * 1.4426950408889634f;
    const float cdec = exp2f(128.f * l2);
    LAS unsigned char* Kimg = lds; LAS unsigned char* Vimg = lds + 32768;
    f32x4 acc[4];
#pragma unroll
    for (int i = 0; i < 4; ++i) acc[i] = (f32x4){0.f, 0.f, 0.f, 0.f};
    v4u kr0[4], vr0[2], kr1[4], vr1[2];
#define ST_LOAD(s, kr, vr) do { const bf16* Kp; int ld; \
        if ((s) < 2) { const int cc = dir ? 1 - (s) : (s); Kp = KVC + (size_t)(b * 256 + cc * 128) * 1024 + h * 128; ld = 1024; } \
        else { const int c = dir ? 17 - (s) : (s) - 2; Kp = PROJ + (size_t)(b * SEQ + c * 128) * PROJ_LD + PC_K + h * 128; ld = PROJ_LD; } \
        _Pragma("unroll") for (int i = 0; i < 4; ++i) { const int id = tid + 512 * i; kr[i] = *(const v4u*)(Kp + (size_t)(id >> 4) * ld + (id & 15) * 8); } \
        _Pragma("unroll") for (int i = 0; i < 2; ++i) { const int id = tid + 512 * i; vr[i] = *(const v4u*)(Kp + 512 + (size_t)(id >> 3) * ld + (8 * eh + (id & 7)) * 8); } } while (0)
#define ST_STEP(s, kr, vr) do { \
        if ((s) < 17) { \
            if (s) __syncthreads(); \
            _Pragma("unroll") for (int i = 0; i < 4; ++i) { const int id = tid + 512 * i; *(LAS v4u*)(Kimg + offb(id >> 4, id & 15)) = kr[i]; } \
            _Pragma("unroll") for (int i = 0; i < 2; ++i) { const int id = tid + 512 * i, m = id >> 3; const float wgt = exp2f((float)(dir ? m : 127 - m) * l2); \
                v4u o; o.x = pk2(bflo(vr[i].x) * wgt, bfhi(vr[i].x) * wgt); o.y = pk2(bflo(vr[i].y) * wgt, bfhi(vr[i].y) * wgt); \
                o.z = pk2(bflo(vr[i].z) * wgt, bfhi(vr[i].z) * wgt); o.w = pk2(bflo(vr[i].w) * wgt, bfhi(vr[i].w) * wgt); \
                *(LAS v4u*)(Vimg + offb(m, 8 * eh + (id & 7))) = o; } \
            __syncthreads(); \
            if ((s) + 2 < 17) ST_LOAD((s) + 2, kr, vr); \
        } \
        if ((s) >= 2) { \
            const int c = dir ? 17 - (s) : (s) - 2; \
            bf16* so = ST + ((size_t)(((b * 4 + h) * 16 + c) * 2 + dir)) * 16384 + (size_t)(64 * eh + 16 * et + fr) * 128; \
            _Pragma("unroll") for (int i = 0; i < 4; ++i) { v2u w; w.x = pk2(acc[i][0], acc[i][1]); w.y = pk2(acc[i][2], acc[i][3]); *(v2u*)(so + 16 * (dtb + i) + 4 * fq) = w; } \
        } \
        if ((s) < 17) { \
            _Pragma("unroll") for (int i = 0; i < 4; ++i) acc[i] = acc[i] * cdec; \
            _Pragma("unroll") for (int ks = 0; ks < 4; ++ks) { \
                const unsigned r0 = 32 * ks + 8 * fq + q4; \
                const bf16x8 vb = cat8(tr_read(Vimg + offb(r0, 2 * cb + (pp >> 1)) + 8 * (pp & 1)), tr_read(Vimg + offb(r0 + 4, 2 * cb + (pp >> 1)) + 8 * (pp & 1))); \
                _Pragma("unroll") for (int i = 0; i < 4; ++i) { const int dt = dtb + i; \
                    const bf16x8 ka = cat8(tr_read(Kimg + offb(r0, 2 * dt + (pp >> 1)) + 8 * (pp & 1)), tr_read(Kimg + offb(r0 + 4, 2 * dt + (pp >> 1)) + 8 * (pp & 1))); \
                    acc[i] = MFMA16(ka, vb, acc[i]); } \
            } \
        } } while (0)
#define ST_LOAD_CTX(s, kr, vr) do { const int cc = dir ? 1 - (s) : (s); const bf16* Kp = KVCP + (size_t)(b * 256 + cc * 128) * 1024 + h * 128; \
        v4u t4[6][4]; \
        _Pragma("unroll") for (int i = 0; i < 6; ++i) { const int id = tid + 512 * (i < 4 ? i : i - 4); \
            const bf16* src = (i < 4) ? Kp + (size_t)(id >> 4) * 1024 + (id & 15) * 8 : Kp + 512 + (size_t)(id >> 3) * 1024 + (8 * eh + (id & 7)) * 8; \
            _Pragma("unroll") for (int kq = 0; kq < 4; ++kq) t4[i][kq] = *(const v4u*)(src + (size_t)kq * MCTX * 1024); } \
        _Pragma("unroll") for (int i = 0; i < 6; ++i) { float a[8]; _Pragma("unroll") for (int j = 0; j < 8; ++j) a[j] = 0.f; \
            _Pragma("unroll") for (int kq = 0; kq < 4; ++kq) { const v4u w4 = t4[i][kq]; \
                a[0] += bflo(w4.x); a[1] += bfhi(w4.x); a[2] += bflo(w4.y); a[3] += bfhi(w4.y); a[4] += bflo(w4.z); a[5] += bfhi(w4.z); a[6] += bflo(w4.w); a[7] += bfhi(w4.w); } \
            v4u o; o.x = pk2(a[0], a[1]); o.y = pk2(a[2], a[3]); o.z = pk2(a[4], a[5]); o.w = pk2(a[6], a[7]); \
            if (i < 4) kr[i < 4 ? i : 0] = o; else vr[i < 4 ? 0 : i - 4] = o; } } while (0)
    ST_LOAD_CTX(0, kr0, vr0); ST_LOAD_CTX(1, kr1, vr1);
#undef ST_LOAD_CTX
#pragma unroll 1
    for (int s = 0; s < 18; s += 2) { ST_STEP(s, kr0, vr0); ST_STEP(s + 1, kr1, vr1); }
#undef ST_STEP
#undef ST_LOAD
}

DI void ret_unit(const Params& p, LAS unsigned char* lds, int unit, int tid, int lane, int wave) {
    const bf16* PROJ = (const bf16*)(p.ws + WS_PROJ); const bf16* ST = (const bf16*)(p.ws + WS_ST); bf16* MIX = (bf16*)(p.ws + WS_MIX); const bf16* YT = (const bf16*)(p.ws + WS_YT);
    const int c = unit & 15, h = (unit >> 4) & 3, b = unit >> 6;
    const int fr = lane & 15, fq = lane >> 4, q4 = fr >> 2, pp = fr & 3;
    const size_t tok0 = (size_t)b * SEQ + c * 128;
    const float l2f = -log1pf(expf(-p.decay_logit[h])) * 1.4426950408889634f, l2b = -log1pf(expf(-p.decay_logit[4 + h])) * 1.4426950408889634f;
    LAS unsigned char* Kimg = lds; LAS unsigned char* Vimg = lds + 32768; LAS unsigned char* Simg = lds + 65536; LAS unsigned char* Ost = lds + 98304 + wave * 4352;
    const bf16* Kp = PROJ + tok0 * PROJ_LD + PC_K + h * 128; const bf16* Vp = PROJ + tok0 * PROJ_LD + PC_V + h * 128;
    const bf16* Sf = ST + ((size_t)(((b * 4 + h) * 16 + c) * 2)) * 16384; const bf16* Sb = Sf + 16384;
    v4u kr[4], vr[4], sr[4], sbr[4]; bf16x8 qf[4];
#pragma unroll
    for (int i = 0; i < 4; ++i) { const int id = tid + 512 * i, row = id >> 4, ch = id & 15;
        kr[i] = *(const v4u*)(Kp + (size_t)row * PROJ_LD + ch * 8); vr[i] = *(const v4u*)(Vp + (size_t)row * PROJ_LD + ch * 8);
        sr[i] = *(const v4u*)(Sf + row * 128 + ch * 8); sbr[i] = *(const v4u*)(Sb + row * 128 + ch * 8); }
    { const bf16* Qp = PROJ + (tok0 + 16 * wave + fr) * PROJ_LD + PC_Q + h * 128 + 8 * fq;
#pragma unroll
      for (int ks = 0; ks < 4; ++ks) qf[ks] = *(const bf16x8*)(Qp + 32 * ks); }
    __syncthreads();
#pragma unroll
    for (int i = 0; i < 4; ++i) { const int id = tid + 512 * i; const unsigned o = offb(id >> 4, id & 15);
        *(LAS v4u*)(Kimg + o) = kr[i]; *(LAS v4u*)(Vimg + o) = vr[i]; *(LAS v4u*)(Simg + o) = sr[i]; }
    __syncthreads();
    v4u yt[4];
#pragma unroll
    for (int i = 0; i < 4; ++i) { const int id = tid + 512 * i; yt[i] = *(const v4u*)(YT + ((size_t)(b * 512 + h * 128 + (id >> 4))) * SEQ + c * 128 + (id & 15) * 8); }
    const int nl = 16 * wave + fr;
    const float sf = exp2f((float)(nl + 1) * l2f), sbv = exp2f((float)(128 - nl) * l2b);
    f32x4 O[8];
#pragma unroll
    for (int et = 0; et < 8; ++et) { f32x4 a = (f32x4){0.f, 0.f, 0.f, 0.f};
#pragma unroll
        for (int ks = 0; ks < 4; ++ks) a = MFMA16(*(const LAS bf16x8*)(Simg + offb(16 * et + fr, 4 * ks + fq)), qf[ks], a);
        O[et] = a * sf; }
    bf16x8 pf[4];
#pragma unroll
    for (int k2 = 0; k2 < 4; ++k2) {
        v4u pw;
#pragma unroll
        for (int hf = 0; hf < 2; ++hf) { const int mt = 2 * k2 + hf; f32x4 sacc = (f32x4){0.f, 0.f, 0.f, 0.f};
#pragma unroll
            for (int ks = 0; ks < 4; ++ks) sacc = MFMA16(*(const LAS bf16x8*)(Kimg + offb(16 * mt + fr, 4 * ks + fq)), qf[ks], sacc);
#pragma unroll
            for (int j = 0; j < 4; ++j) { const int df = nl - (16 * mt + 4 * fq + j); sacc[j] *= (df >= 0) ? exp2f((float)df * l2f) : exp2f((float)(-df) * l2b); }
            if (hf == 0) { pw.x = pk2(sacc[0], sacc[1]); pw.y = pk2(sacc[2], sacc[3]); } else { pw.z = pk2(sacc[0], sacc[1]); pw.w = pk2(sacc[2], sacc[3]); } }
        pf[k2] = __builtin_bit_cast(bf16x8, pw);
    }
    asm volatile("s_waitcnt lgkmcnt(0)" ::: "memory");
#pragma unroll
    for (int et = 0; et < 8; ++et)
#pragma unroll
        for (int ks = 0; ks < 4; ++ks) { const unsigned r0 = 32 * ks + 4 * fq + q4;
            const bf16x8 va = cat8(tr_read(Vimg + offb(r0, 2 * et + (pp >> 1)) + 8 * (pp & 1)), tr_read(Vimg + offb(r0 + 16, 2 * et + (pp >> 1)) + 8 * (pp & 1)));
            O[et] = MFMA16(va, pf[ks], O[et]); }
    asm volatile("s_waitcnt lgkmcnt(0)" ::: "memory");
    __syncthreads();
#pragma unroll
    for (int i = 0; i < 4; ++i) { const int id = tid + 512 * i; const unsigned o = offb(id >> 4, id & 15); *(LAS v4u*)(Simg + o) = sbr[i]; *(LAS v4u*)(Kimg + o) = yt[i]; }
    __syncthreads();
    v4u gR[4], gG[4];
#pragma unroll
    for (int i = 0; i < 4; ++i) { const int id = lane + 64 * i; gR[i] = *(const v4u*)(PROJ + (tok0 + 16 * wave + (id >> 4)) * PROJ_LD + PC_R + h * 128 + (id & 15) * 8);
        gG[i] = *(const v4u*)(PROJ + (tok0 + 16 * wave + fr) * PROJ_LD + PC_G + h * 128 + 32 * i + 8 * fq); }
#pragma unroll
    for (int et = 0; et < 8; ++et) { f32x4 a = (f32x4){0.f, 0.f, 0.f, 0.f};
#pragma unroll
        for (int ks = 0; ks < 4; ++ks) a = MFMA16(*(const LAS bf16x8*)(Simg + offb(16 * et + fr, 4 * ks + fq)), qf[ks], a);
        O[et] = O[et] + a * sbv; }
    float s1 = 0.f;
#pragma unroll
    for (int et = 0; et < 8; ++et) s1 += (O[et][0] + O[et][1]) + (O[et][2] + O[et][3]);
    s1 += __shfl_xor(s1, 16); s1 += __shfl_xor(s1, 32);
    const float mu = s1 * (1.f / 128.f); float s2 = 0.f;
#pragma unroll
    for (int et = 0; et < 8; ++et) { O[et] = O[et] - mu; s2 += (O[et][0] * O[et][0] + O[et][1] * O[et][1]) + (O[et][2] * O[et][2] + O[et][3] * O[et][3]); }
    s2 += __shfl_xor(s2, 16); s2 += __shfl_xor(s2, 32);
    const float rstd = rsqrtf(s2 * (1.f / 128.f) + EPSV);
#pragma unroll
    for (int et = 0; et < 8; ++et) { v2u w; w.x = pk2(O[et][0] * rstd, O[et][1] * rstd); w.y = pk2(O[et][2] * rstd, O[et][3] * rstd); *(LAS v2u*)(Ost + fr * 272 + (16 * et + 4 * fq) * 2) = w; }
    asm volatile("s_waitcnt lgkmcnt(0)" ::: "memory");
#pragma unroll
    for (int i = 0; i < 4; ++i) { const int id = lane + 64 * i, row = id >> 4, ch = id & 15;
        const v4u on = *(const LAS v4u*)(Ost + row * 272 + ch * 16);
        const size_t tok = tok0 + 16 * wave + row;
        const v4u g = gR[i];
        const f32x4 g0 = *(const f32x4*)(p.gn_gain + h * 128 + ch * 8), g1 = *(const f32x4*)(p.gn_gain + h * 128 + ch * 8 + 4);
        v4u o;
        o.x = pk2(bflo(on.x) * g0[0] * bflo(g.x), bfhi(on.x) * g0[1] * bfhi(g.x)); o.y = pk2(bflo(on.y) * g0[2] * bflo(g.y), bfhi(on.y) * g0[3] * bfhi(g.y));
        o.z = pk2(bflo(on.z) * g1[0] * bflo(g.z), bfhi(on.z) * g1[1] * bfhi(g.z)); o.w = pk2(bflo(on.w) * g1[2] * bflo(g.w), bfhi(on.w) * g1[3] * bfhi(g.w));
        *(v4u*)(MIX + tok * 1024 + 512 + h * 128 + ch * 8) = o; }
    asm volatile("s_waitcnt lgkmcnt(0)" ::: "memory");
#pragma unroll
    for (int ks = 0; ks < 4; ++ks) { const unsigned r0 = 32 * ks + 8 * fq + q4; const size_t tok = tok0 + 16 * wave + fr;
        const v4u y = __builtin_bit_cast(v4u, cat8(tr_read(Kimg + offb(r0, 2 * wave + (pp >> 1)) + 8 * (pp & 1)), tr_read(Kimg + offb(r0 + 4, 2 * wave + (pp >> 1)) + 8 * (pp & 1))));
        const v4u g = gG[ks];
        v4u o; o.x = pk2(bflo(y.x) * bflo(g.x), bfhi(y.x) * bfhi(g.x)); o.y = pk2(bflo(y.y) * bflo(g.y), bfhi(y.y) * bfhi(g.y));
        o.z = pk2(bflo(y.z) * bflo(g.z), bfhi(y.z) * bfhi(g.z)); o.w = pk2(bflo(y.w) * bflo(g.w), bfhi(y.w) * bfhi(g.w));
        *(v4u*)(MIX + tok * 1024 + h * 128 + 32 * ks + 8 * fq) = o; }
}

constexpr int FFT_IN = 0, FFT_STG = 65536, FFT_A2 = 98304, FFT_TW = 114688;
DI void fft_setup(LAS unsigned char* lds, int tid, int lane, bf16x8 (&m1)[2][4]) {
    LAS float* ct = (LAS float*)(lds + FFT_IN);
    for (int i = tid; i < 2048; i += 512) ct[i] = cospif((float)i * (1.f / 1024.f));
    __syncthreads();
    const int fr = lane & 15, fq = lane >> 4;
#pragma unroll
    for (int pq = 0; pq < 2; ++pq)
#pragma unroll
        for (int c4 = 0; c4 < 4; ++c4) { const int ri = c4 >> 1, k1 = 16 * (c4 & 1) + fr; float v[8];
#pragma unroll
            for (int i = 0; i < 8; ++i) { const int l1 = 8 * fq + i, idx = ((k1 * l1) & 31) * 64; const float C = ct[idx], S = ct[(idx - 512) & 2047];
                v[i] = (pq == 0 && ri == 0) ? C : ((pq == 1 && ri == 1) ? -C : -S); }
            v4u w; w.x = pk2(v[0], v[1]); w.y = pk2(v[2], v[3]); w.z = pk2(v[4], v[5]); w.w = pk2(v[6], v[7]); m1[pq][c4] = __builtin_bit_cast(bf16x8, w); }
    for (int e = tid; e < 1024; e += 512) { const int ln = e & 63, fr2 = ln & 15, fq2 = ln >> 4, ks2 = (e >> 6) & 3, mt = e >> 8, ri = ks2 >> 1, base = 32 * (ks2 & 1), k2 = 16 * mt + fr2; float v[8];
#pragma unroll
        for (int i = 0; i < 8; ++i) { const int l2 = base + ((i < 4) ? 4 * fq2 + i : 16 + 4 * fq2 + (i - 4)), idx = ((k2 * l2) & 63) * 32; v[i] = ri ? ct[(idx - 512) & 2047] : ct[idx]; }
        v4u w; w.x = pk2(v[0], v[1]); w.y = pk2(v[2], v[3]); w.z = pk2(v[4], v[5]); w.w = pk2(v[6], v[7]); *(LAS v4u*)(lds + FFT_A2 + e * 16) = w; }
    for (int e = tid; e < 2048; e += 512) { const int ln = e & 63, fr2 = ln & 15, fq2 = ln >> 4, j = (e >> 6) & 3, kt = (e >> 8) & 1, rt = e >> 9;
        const int idx = (16 * kt + fr2) * (16 * rt + 4 * fq2 + j); typedef float f32x2 __attribute__((ext_vector_type(2)));
        *(LAS f32x2*)(lds + FFT_TW + e * 8) = (f32x2){ct[idx], ct[(idx - 512) & 2047]}; }
    __syncthreads();
}
DI void fft_decode(int v, int& b, int& g, int& s8) {
    const int i = v >> 8, w = v & 255, x = w & 7, j = w >> 3, bg = i * 16 + x * 2 + (j >> 4);
    s8 = j & 15; b = bg >> 2; g = bg & 3;
}
DI void fft_units(const Params& p, LAS unsigned char* lds, int tid, int lane, int wave, const bf16x8 (&m1)[2][4]) {
    const bf16* ZT = (const bf16*)(p.ws + WS_ZT); bf16* YT = (bf16*)(p.ws + WS_YT);
    const int fr = lane & 15, fq = lane >> 4, q4 = fr >> 2, pp = fr & 3;
    LAS unsigned char* img = lds + FFT_IN + wave * 8192;
    typedef float f32x2 __attribute__((ext_vector_type(2)));
    LAS unsigned char* stg = lds + FFT_STG;
    int v = blockIdx.x; if (v >= 1024) return;
    int b, g, s8; fft_decode(v, b, g, s8);
    v4u ld[8];
    { const bf16* src = ZT + ((size_t)b * 1024 + (g * 128 + 8 * s8) * 2) * SEQ;
#pragma unroll
      for (int i = 0; i < 8; ++i) ld[i] = *(const v4u*)(src + (size_t)(tid + 512 * i) * 8); }
#pragma unroll 1
    for (; v < 1024; v += gridDim.x) {
        __syncthreads();
#pragma unroll
        for (int i = 0; i < 8; ++i) *(LAS v4u*)(lds + FFT_IN + (tid + 512 * i) * 16) = ld[i];
        __syncthreads();
        const int cb = b, cg = g, cs8 = s8;
        if (v + (int)gridDim.x < 1024) { fft_decode(v + gridDim.x, b, g, s8);
            const bf16* src = ZT + ((size_t)b * 1024 + (g * 128 + 8 * s8) * 2) * SEQ;
#pragma unroll
            for (int i = 0; i < 8; ++i) ld[i] = *(const v4u*)(src + (size_t)(tid + 512 * i) * 8); }
        {
        f32x4 D1[4][4];
#pragma unroll
        for (int rt = 0; rt < 4; ++rt) {
            LAS unsigned char* a0 = img + (8 * fq + q4) * 128 + (16 * rt + 4 * pp) * 2;
            const bf16x8 ap = cat8(tr_read(a0), tr_read(a0 + 512)), aq = cat8(tr_read(a0 + 4096), tr_read(a0 + 4096 + 512));
#pragma unroll
            for (int c4 = 0; c4 < 4; ++c4) { f32x4 d = (f32x4){0.f, 0.f, 0.f, 0.f}; d = MFMA16(ap, m1[0][c4], d); d = MFMA16(aq, m1[1][c4], d); D1[rt][c4] = d; }
        }
        asm volatile("s_waitcnt lgkmcnt(0)" ::: "memory");
        bf16x8 b2[4][2];
#pragma unroll
        for (int kt = 0; kt < 2; ++kt)
#pragma unroll
            for (int hf = 0; hf < 2; ++hf) { v4u wre, wim;
#pragma unroll
                for (int hh = 0; hh < 2; ++hh) { const int rt = 2 * hf + hh; float re[4], im[4];
#pragma unroll
                    for (int j = 0; j < 4; ++j) { const f32x2 tw = *(const LAS f32x2*)(lds + FFT_TW + (((rt * 2 + kt) * 4 + j) * 64 + lane) * 8); const float c = tw.x, sn = tw.y;
                        const float tr = D1[rt][kt][j], ti = D1[rt][2 + kt][j]; re[j] = tr * c + ti * sn; im[j] = ti * c - tr * sn; }
                    if (hh == 0) { wre.x = pk2(re[0], re[1]); wre.y = pk2(re[2], re[3]); wim.x = pk2(im[0], im[1]); wim.y = pk2(im[2], im[3]); }
                    else { wre.z = pk2(re[0], re[1]); wre.w = pk2(re[2], re[3]); wim.z = pk2(im[0], im[1]); wim.w = pk2(im[2], im[3]); } }
                b2[hf][kt] = __builtin_bit_cast(bf16x8, wre); b2[2 + hf][kt] = __builtin_bit_cast(bf16x8, wim); }
#pragma unroll
        for (int mt = 0; mt < 4; ++mt) {
            bf16x8 a2[4];
#pragma unroll
            for (int ks2 = 0; ks2 < 4; ++ks2) a2[ks2] = *(const LAS bf16x8*)(lds + FFT_A2 + ((mt * 4 + ks2) * 64 + lane) * 16);
#pragma unroll
            for (int kt = 0; kt < 2; ++kt) { f32x4 d = (f32x4){0.f, 0.f, 0.f, 0.f};
#pragma unroll
                for (int ks2 = 0; ks2 < 4; ++ks2) d = MFMA16(a2[ks2], b2[ks2][kt], d);
#pragma unroll
                for (int j = 0; j < 4; ++j) { const int k = (16 * kt + fr) + 32 * (16 * mt + 4 * fq + j); *(LAS unsigned short*)(stg + wave * 4096 + k * 2) = (unsigned short)f2bf(d[j]); } }
        }
        }
        __syncthreads();
        { bf16* dst = YT + ((size_t)cb * 512 + cg * 128 + 8 * cs8) * SEQ;
#pragma unroll
          for (int i = 0; i < 4; ++i) { const int id = tid + 512 * i; *(v4u*)(dst + (size_t)id * 8) = *(const LAS v4u*)(stg + id * 16); } }
    }
}

template <int ENC> DI void phase6(const Params& p, int lane, int wave) {
    const float* ADA = (const float*)(p.ws + WS_ADA); const float* rowss = (const float*)(p.ws + WS_ROWSS); const bf16* Y = (const bf16*)(p.ws + WS_Y);
    const int gw = blockIdx.x * 8 + wave, NGW = gridDim.x * 8; int rpw = (MTOK + NGW - 1) / NGW; rpw = (rpw + RW - 1) / RW * RW;
    int r0 = gw * rpw, r1 = r0 + rpw; if (r1 > MTOK) r1 = MTOK;
    if (ENC) { if (gw != 0) return; r0 = 0; r1 = 16; }
    int vcur = -1; f32x4 gg[4];
    for (int r = r0; r < r1; r += RW) {
        const int v = r >> 11;
        float ssum = rowss[(size_t)r * 16 + lane];
        f32x4 xv[RW][4]; v2u yv[RW][4];
#pragma unroll
        for (int q = 0; q < RW; ++q)
#pragma unroll
            for (int j = 0; j < 4; ++j) { const int col = lane * 4 + 256 * j; xv[q][j] = *(const f32x4*)(p.x + (size_t)(r + q) * 1024 + col); yv[q][j] = *(const v2u*)(Y + (size_t)(r + q) * 1024 + col); }
        if (v != vcur) { vcur = v;
#pragma unroll
            for (int j = 0; j < 4; ++j) { const int col = lane * 4 + 256 * j; gg[j] = *(const f32x4*)(p.g_post + col) * *(const f32x4*)(ADA + v * 3072 + 2048 + col); } }
#pragma unroll
        for (int o = 1; o < 16; o <<= 1) ssum += __shfl_xor(ssum, o);
#pragma unroll
        for (int q = 0; q < RW; ++q) { const float rs = rsqrtf(__shfl(ssum, 16 * q) * (1.f / 1024.f) + EPSV);
#pragma unroll
            for (int j = 0; j < 4; ++j) { const int col = lane * 4 + 256 * j; const f32x4 xq = xv[q][j]; const v2u yq = yv[q][j];
                f32x4 o; o[0] = xq[0] + gg[j][0] * (bflo(yq.x) * rs); o[1] = xq[1] + gg[j][1] * (bfhi(yq.x) * rs); o[2] = xq[2] + gg[j][2] * (bflo(yq.y) * rs); o[3] = xq[3] + gg[j][3] * (bfhi(yq.y) * rs);
#if defined(TPROBE)
                if (ENC) { float X = 1000.f; if (TPROBE_LO >= 0) { const unsigned long long* st = (const unsigned long long*)(p.ws + 32768); X = (float)(st[TPROBE_HI] - st[TPROBE_LO]) * 0.01f; }
                    const float e = 0.1f * sqrtf(X * 0.001f); o = o + e; }
#endif
                *(f32x4*)(p.out + (size_t)(r + q) * 1024 + col) = o; } }
    }
}

#define XB_TMO      128
#define XB_XCNT(j)  (256  + 64 * (j))
#define XB_XSUB(j)  (1280 + 64 * (j))
#define XB_XGEN(j)  (2304 + 64 * (j))
#define XB_TOP      3328
#define XB_TOPGEN   3392
#define XCD_BAR_WORDS 3456
#define XB_SPIN_CAP (1u << 18)

__device__ __forceinline__ unsigned xb_ld(unsigned* p)              { return __hip_atomic_load(p, __ATOMIC_RELAXED, __HIP_MEMORY_SCOPE_AGENT); }
__device__ __forceinline__ unsigned xb_add(unsigned* p, unsigned v) { return __hip_atomic_fetch_add(p, v, __ATOMIC_RELAXED, __HIP_MEMORY_SCOPE_AGENT); }
__device__ __forceinline__ unsigned xb_xcc_id() { return (unsigned)__builtin_amdgcn_s_getreg((3 << 11) | 20) & 0xFu; }
#define XB_SPIN(cond, bar) do { unsigned _sp = 0; while (cond) { __builtin_amdgcn_s_sleep(1); \
    if ((++_sp & 255u) == 0u) { if (xb_ld(&(bar)[XB_TMO])) break; if (_sp > XB_SPIN_CAP) { atomicAdd(&(bar)[XB_TMO], 1u); break; } } } } while (0)

struct XcdBarrier {
    unsigned* bar; unsigned x;
    volatile LAS unsigned* st;
};

__device__ __forceinline__ XcdBarrier xcd_barrier_post(unsigned* bar, volatile LAS unsigned* st) {
    XcdBarrier b; b.bar = bar; b.x = xb_xcc_id(); b.st = st;
    if (threadIdx.x == 0) (void)xb_add(&bar[XB_XCNT(b.x)], 1u);
    return b;
}
__device__ __forceinline__ void xcd_barrier_complete(unsigned* bar, unsigned x, unsigned& nloc, unsigned& nx) {
    const unsigned G = gridDim.x * gridDim.y * gridDim.z;
    unsigned sum, cnt, mine, sp = 0u;
    for (;;) {
        sum = 0u; cnt = 0u; mine = 0u;
#pragma unroll
        for (unsigned j = 0; j < 16; ++j) { const unsigned c = xb_ld(&bar[XB_XCNT(j)]); sum += c; cnt += (c > 0u) ? 1u : 0u; mine = (j == x) ? c : mine; }
        if (sum == G) break;
        __builtin_amdgcn_s_sleep(1);
        if ((++sp & 255u) == 0u) { if (xb_ld(&bar[XB_TMO])) break; if (sp > XB_SPIN_CAP) { atomicAdd(&bar[XB_TMO], 1u); break; } }
    }
    nloc = mine > 0u ? mine : 1u; nx = cnt > 0u ? cnt : 1u;
}

__device__ __forceinline__ void xcd_barrier(const XcdBarrier& b) {
    asm volatile("s_waitcnt vmcnt(0)" ::: "memory");
    __syncthreads();
    if (threadIdx.x == 0) {
        unsigned* bar = b.bar;
        __builtin_amdgcn_s_waitcnt(0);
        unsigned nloc = b.st[0], nx = b.st[1];
        if (nloc == 0u) { xcd_barrier_complete(bar, b.x, nloc, nx); b.st[0] = nloc; b.st[1] = nx; }
        const unsigned old = xb_add(&bar[XB_XSUB(b.x)], 1u);
        const unsigned gen = old / nloc;
        if (old + 1u == (gen + 1u) * nloc) {
            __builtin_amdgcn_fence(__ATOMIC_RELEASE, "agent");
            asm volatile("s_waitcnt vmcnt(0)" ::: "memory");
            const unsigned og = xb_add(&bar[XB_TOP], 1u);
            const unsigned tg = og / nx;
            if (og + 1u == (tg + 1u) * nx) xb_add(&bar[XB_TOPGEN], 1u);
            else XB_SPIN(xb_ld(&bar[XB_TOPGEN]) == tg, bar);
            __builtin_amdgcn_fence(__ATOMIC_ACQUIRE, "agent");
            xb_add(&bar[XB_XGEN(b.x)], 1u);
            asm volatile("s_waitcnt vmcnt(0)" ::: "memory");
        } else {
            XB_SPIN(xb_ld(&bar[XB_XGEN(b.x)]) == gen, bar);
            __builtin_amdgcn_fence(__ATOMIC_ACQUIRE, "agent");
            asm volatile("s_waitcnt vmcnt(0)" ::: "memory");
        }
    }
    __syncthreads();
}


__global__ void __launch_bounds__(512, 2) hymba_fwd(Params p) {
    extern __shared__ __attribute__((aligned(16))) unsigned char lds_raw[];
    LAS unsigned char* lds = (LAS unsigned char*)lds_raw;
    cg::grid_group grid = cg::this_grid();
    const int tid = threadIdx.x, lane = tid & 63, wave = __builtin_amdgcn_readfirstlane(tid >> 6);
    const int lo = p.ph_lo, hi = p.ph_hi;
    volatile LAS unsigned* misc = (volatile LAS unsigned*)(lds + LDS_MISC);
    if (tid < 4) misc[tid] = 0u;
    __syncthreads();
    XcdBarrier bar = xcd_barrier_post((unsigned*)p.ws, misc);
#define IN(k) (lo <= (k) && (k) < hi)
#ifndef REP2
#define REP2 1
#endif
#ifndef REP3
#define REP3 1
#endif
#ifndef REP4
#define REP4 1
#endif
#if defined(TPROBE)
#define STAMP(k) do { if (blockIdx.x == 0 && tid == 0) ((unsigned long long*)(p.ws + 32768))[k] = __builtin_amdgcn_s_memrealtime(); } while (0)
#else
#define STAMP(k) do {} while (0)
#endif
#define SEAM(k) do { if (IN(k) && IN((k) + 1)) { if (p.use_cg) grid.sync(); else xcd_barrier(bar); } STAMP((k) + 1); } while (0)
    bf16* RA = (bf16*)(p.ws + WS_RA);
    STAMP(0);
    if (IN(0)) phase0(p, lds, tid, lane, wave);
#if defined(REP0)
    __syncthreads(); if (IN(0)) phase0(p, lds, tid, lane, wave);
#endif
    SEAM(0);
    if (IN(1)) phase1(p, lane, wave);
#if defined(REP1)
    if (IN(1)) phase1(p, lane, wave);
#endif
    SEAM(1);
    if (IN(2)) {
        pg8::Gemm g{RA, RA, RA_ROWS, RA_ROWS, 1024, 1024}; G1Order S{(int)gridDim.x, (int)blockIdx.x};
        EpiG1 E{(bf16*)(p.ws + WS_PROJ), (bf16*)(p.ws + WS_ZT), (bf16*)(p.ws + WS_KVC), (const float*)(p.ws + WS_ROPE)};
        pg8::gemm_phase<EpiG1, G1Order, true, true>(lds, g, S, E);
        if (blockIdx.x < 256) {
            const int v = blockIdx.x, tile = v >> 2, kq = v & 3;
            pg8::Gemm gc{RA + kq * 256, RA + kq * 256, RA_ROWS, RA_ROWS, 256, 1024}; OneUnit Sc{RT_CTX + (tile >> 2), RT_W + 4 + (tile & 3)};
            EpiCtx Ec{(bf16*)(p.ws + WS_KVCP) + (size_t)kq * MCTX * 1024};
            pg8::gemm_phase<EpiCtx, OneUnit, true, true>(lds, gc, Sc, Ec);
        }
    }
#if REP2 == 2
    __syncthreads();
    if (IN(2)) {
        pg8::Gemm g{RA, RA, RA_ROWS, RA_ROWS, 1024, 1024}; G1Order S{(int)gridDim.x, (int)blockIdx.x};
        EpiG1 E{(bf16*)(p.ws + WS_PROJ), (bf16*)(p.ws + WS_ZT), (bf16*)(p.ws + WS_KVC), (const float*)(p.ws + WS_ROPE)};
        pg8::gemm_phase<EpiG1, G1Order, true, true>(lds, g, S, E);
        if (blockIdx.x < 256) {
            const int v = blockIdx.x, tile = v >> 2, kq = v & 3;
            pg8::Gemm gc{RA + kq * 256, RA + kq * 256, RA_ROWS, RA_ROWS, 256, 1024}; OneUnit Sc{RT_CTX + (tile >> 2), RT_W + 4 + (tile & 3)};
            EpiCtx Ec{(bf16*)(p.ws + WS_KVCP) + (size_t)kq * MCTX * 1024};
            pg8::gemm_phase<EpiCtx, OneUnit, true, true>(lds, gc, Sc, Ec);
        }
    }
#endif
    SEAM(2);
    if (IN(3)) {
        for (int u = blockIdx.x; u < 256; u += gridDim.x) { state_unit(p, lds, u, tid, lane, wave); __syncthreads(); }
#if defined(REP3S)
        for (int u = blockIdx.x; u < 256; u += gridDim.x) { state_unit(p, lds, u, tid, lane, wave); __syncthreads(); }
#endif
        STAMP(13);
        { bf16x8 m1[2][4]; fft_setup(lds, tid, lane, m1);
          fft_units(p, lds, tid, lane, wave, m1);
#if defined(REP3F)
          fft_units(p, lds, tid, lane, wave, m1);
#endif
        }
    }
#if REP3 == 2
    __syncthreads();
    if (IN(3)) {
        for (int u = blockIdx.x; u < 256; u += gridDim.x) { state_unit(p, lds, u, tid, lane, wave); __syncthreads(); }
#if defined(REP3S)
        for (int u = blockIdx.x; u < 256; u += gridDim.x) { state_unit(p, lds, u, tid, lane, wave); __syncthreads(); }
#endif
        STAMP(13);
        { bf16x8 m1[2][4]; fft_setup(lds, tid, lane, m1);
          fft_units(p, lds, tid, lane, wave, m1);
#if defined(REP3F)
          fft_units(p, lds, tid, lane, wave, m1);
#endif
        }
    }
#endif
    SEAM(3);
    if (IN(4)) for (int rep = 0; rep < REP4; ++rep) { for (int u = blockIdx.x; u < 1024; u += gridDim.x) ret_unit(p, lds, u, tid, lane, wave); }
    SEAM(4);
#if defined(REPS)
    xcd_barrier(bar); xcd_barrier(bar); xcd_barrier(bar); xcd_barrier(bar);
#endif
    if (IN(5)) {
        __syncthreads();
        pg8::Gemm g{(const bf16*)(p.ws + WS_MIX), (const bf16*)(p.ws + WS_WOT), MTOK, 1024, 1024, 1024}; pg8::StaticOrder S; S.init(MTOK, 1024, (int)gridDim.x, (int)blockIdx.x);
        EpiOut E{(bf16*)(p.ws + WS_Y), (float*)(p.ws + WS_ROWSS)};
        pg8::gemm_phase<EpiOut, pg8::StaticOrder, true, true>(lds, g, S, E);
    }
#if defined(REP5)
    __syncthreads();
    if (IN(5)) {
        __syncthreads();
        pg8::Gemm g{(const bf16*)(p.ws + WS_MIX), (const bf16*)(p.ws + WS_WOT), MTOK, 1024, 1024, 1024}; pg8::StaticOrder S; S.init(MTOK, 1024, (int)gridDim.x, (int)blockIdx.x);
        EpiOut E{(bf16*)(p.ws + WS_Y), (float*)(p.ws + WS_ROWSS)};
        pg8::gemm_phase<EpiOut, pg8::StaticOrder, true, true>(lds, g, S, E);
    }
#endif
    SEAM(5);
    if (IN(6)) phase6<0>(p, lane, wave);
#if defined(TPROBE)
    xcd_barrier(bar); STAMP(7);
    phase6<1>(p, lane, wave);
#endif
#undef IN
#undef SEAM
}

#ifndef N_LAUNCHES
#define N_LAUNCHES 1
#endif
extern "C" void kernel_launch(void* const* d_in, const int* in_sizes, int n_in, void* d_out, int out_size, void* d_ws, size_t ws_size, hipStream_t stream) {
    static int grid = 0;
    if (grid == 0) {
        if (n_in != 13 || out_size != MTOK * DM || ws_size < WS_END) { fprintf(stderr, "kernel_launch: unexpected shapes (n_in %d out %d ws %zu)\n", n_in, out_size, ws_size); grid = -1; return; }
        int dev = 0, cus = 0, per_cu = 0;
        hipGetDevice(&dev); hipDeviceGetAttribute(&cus, hipDeviceAttributeMultiprocessorCount, dev);
        if (hipFuncSetAttribute((const void*)hymba_fwd, hipFuncAttributeMaxDynamicSharedMemorySize, LDS_BYTES) != hipSuccess) { fprintf(stderr, "kernel_launch: hipFuncSetAttribute failed\n"); grid = -1; return; }
        if (hipOccupancyMaxActiveBlocksPerMultiprocessor(&per_cu, (const void*)hymba_fwd, 512, LDS_BYTES) != hipSuccess || per_cu < 1) { fprintf(stderr, "kernel_launch: occupancy query says %d\n", per_cu); per_cu = 1; }
        (void)hipGetLastError();
        grid = 256;
        if (cus < 256) { fprintf(stderr, "kernel_launch: needs 256 CUs, device has %d\n", cus); grid = -1; return; }
    }
    if (grid < 0) return;
    Params p{};
    p.x = (const float*)d_in[0]; p.c = (const float*)d_in[1]; p.ctx = (const float*)d_in[2]; p.c_ctx = (const float*)d_in[3];
    p.w_ada = (const float*)d_in[4]; p.b_ada = (const float*)d_in[5]; p.g_pre = (const float*)d_in[6]; p.g_post = (const float*)d_in[7];
    p.w_in = (const float*)d_in[8]; p.w_fourier = (const float*)d_in[9]; p.decay_logit = (const float*)d_in[10]; p.gn_gain = (const float*)d_in[11]; p.w_out = (const float*)d_in[12];
    p.out = (float*)d_out; p.ws = (unsigned char*)d_ws;
    if (hipMemsetAsync(d_ws, 0, 16384, stream) != hipSuccess) { fprintf(stderr, "kernel_launch: memset failed\n"); return; }
    if (N_LAUNCHES == 1) {
        p.ph_lo = 0; p.ph_hi = 7; p.use_cg = 0;
        void* args[] = {&p};
        hipError_t e = hipLaunchCooperativeKernel((const void*)hymba_fwd, dim3(grid), dim3(512), args, LDS_BYTES, stream);
        if (e != hipSuccess) fprintf(stderr, "cooperative launch failed: %s (grid %d)\n", hipGetErrorString(e), grid);
    } else {
        for (int ph = 0; ph < 7; ++ph) { p.ph_lo = ph; p.ph_hi = ph + 1; hipLaunchKernelGGL(hymba_fwd, dim3(grid), dim3(512), LDS_BYTES, stream, p); }
    }
}
```

```cpp
#include <hip/hip_runtime.h>
#include <hip/hip_cooperative_groups.h>
#include <cstdio>
#include <cstdint>
namespace cg = cooperative_groups;
namespace pg8 {
#define PG8_LAS __attribute__((address_space(3)))
typedef unsigned short bf16_t;
typedef short bf16x8 __attribute__((ext_vector_type(8)));
typedef float f32x4 __attribute__((ext_vector_type(4)));
typedef unsigned u32x4 __attribute__((ext_vector_type(4)));
constexpr int BM = 256, BK = 64, HALF = 128, HTB = HALF * BK * 2  , STAGE_BYTES = 8 * HTB, NXCD = 8, WGM = 8;

__host__ __device__ __forceinline__ int lds_byte(int r, int c) { const int st = (r >> 4) * 2 + (c >> 5), rr = r & 15, cc = c & 31, ob = rr * 64 + cc * 2; return st * 1024 + (ob ^ (((ob >> 9) & 1) << 5)); }
__host__ __device__ __forceinline__ void stage_rc(int b, int& R, int& C) { const int st = b / 1024, sb = b % 1024, swz = sb ^ (((sb >> 9) & 1) << 5); R = (st >> 1) * 16 + swz / 64; C = (st & 1) * 32 + (swz % 64) / 2; }
__host__ __device__ __forceinline__ int perm32(int rho) { const int n = rho >> 4, i = rho & 15; return 8 * (i >> 2) + 4 * n + (i & 3); }

struct Unit { int pm, pn; };
struct Gemm { const bf16_t* A; const bf16_t* Bt; int M, N, K, ld; };

struct StaticOrder {
    int nM, nN, nwg, G, c;
    __host__ __device__ void init(int M, int N, int G_, int c_) { nM = M / BM; nN = N / BM; nwg = nM * nN; G = G_; c = c_; }
    __host__ __device__ bool next(int i, Unit& u) const {
        const long L = (long)i * G + c; if (L >= nwg) return false;
        int wgid = (int)L; { const int q = nwg / NXCD, r = nwg % NXCD, xcd = wgid % NXCD, off = wgid / NXCD; wgid = (xcd < r ? xcd * (q + 1) : r * (q + 1) + (xcd - r) * q) + off; }
        const int nig = WGM * nN, gid = wgid / nig, fm = gid * WGM, gsz = (nM - fm) < WGM ? (nM - fm) : WGM;
        u.pm = fm + ((wgid % nig) % gsz); u.pn = (wgid % nig) / gsz; return true;
    }
    __device__ __forceinline__ void a_ready(const Unit&) const {}
    __device__ __forceinline__ void done(const Unit&) const {}
};

__device__ __forceinline__ unsigned cvt_pk_bf16(float lo, float hi) { unsigned r; asm volatile("v_cvt_pk_bf16_f32 %0, %1, %2" : "=v"(r) : "v"(lo), "v"(hi)); return r; }

template <class Epi, class Sched, bool ALIGN_EPI = false, bool SP2 = false>
__device__ __forceinline__ void gemm_phase(PG8_LAS unsigned char* lds, const Gemm g, const Sched& S, const Epi& E) {
    const int tid = threadIdx.x, wid = __builtin_amdgcn_readfirstlane(tid >> 6), lane = tid & 63, wr = wid >> 2, wc = wid & 3, fr = lane & 15, fq = lane >> 4;
    const int K = g.K, nt = K / BK;
    unsigned voffA[2], voffB[2];
#pragma unroll
    for (int i = 0; i < 2; ++i) { int R, C; stage_rc(tid * 16 + i * 8192, R, C); const int Rb = Epi::PERM ? ((R & ~31) + perm32(R & 31)) : R;
        voffA[i] = (unsigned)(R * g.ld + C) * 2u; voffB[i] = (unsigned)(Rb * g.ld + C) * 2u; }
    const size_t kstep = (size_t)(BK * 2);
    const size_t hstep = (size_t)HALF * g.ld * 2;
    const size_t tstep = 2 * hstep;
    const unsigned ldsw = (unsigned)wid * 1024u;
    const int aoff = lds_byte(wr * 64 + fr, fq * 8), boff = lds_byte(wc * 32 + fr, fq * 8);
#define PG8_SA(b, h) (((b) * 2 + (h)) * HTB)
#define PG8_SB(b, h) ((4 + (b) * 2 + (h)) * HTB)
#define PG8_STAGE(bufoff, gbase, voff) do { _Pragma("unroll") for (int _i = 0; _i < 2; ++_i) \
        __builtin_amdgcn_global_load_lds((const unsigned*)((const char*)(gbase) + (voff)[_i]), (PG8_LAS unsigned*)(lds + (bufoff) + ldsw + _i * 8192), 16, 0, 0); } while (0)
#define PG8_LDA(dst, b, h) do { _Pragma("unroll") for (int m = 0; m < 4; ++m) _Pragma("unroll") for (int k = 0; k < 2; ++k) dst[m][k] = *(const PG8_LAS bf16x8*)(lds + PG8_SA(b, h) + aoff + m * 2048 + k * 1024); } while (0)
#define PG8_LDB(dst, b, h) do { _Pragma("unroll") for (int n = 0; n < 2; ++n) _Pragma("unroll") for (int k = 0; k < 2; ++k) dst[n][k] = *(const PG8_LAS bf16x8*)(lds + PG8_SB(b, h) + boff + n * 2048 + k * 1024); } while (0)
#define PG8_MMA(ai, bj, At, Bt) do { __builtin_amdgcn_s_setprio(1); _Pragma("unroll") for (int m = 0; m < 4; ++m) _Pragma("unroll") for (int n = 0; n < 2; ++n) _Pragma("unroll") for (int k = 0; k < 2; ++k) \
        acc[ai][bj][m][n] = __builtin_amdgcn_mfma_f32_16x16x32_bf16(Bt[n][k], At[m][k], acc[ai][bj][m][n], 0, 0, 0); __builtin_amdgcn_s_setprio(0); } while (0)
#define PG8_WAIT_V(n) asm volatile("s_waitcnt vmcnt(" #n ")" ::: "memory")
#define PG8_WAIT_L(n) asm volatile("s_waitcnt lgkmcnt(" #n ")" ::: "memory")
#define PG8_BAR __builtin_amdgcn_s_barrier()
#define PG8_SCHED __builtin_amdgcn_sched_barrier(0)
    Unit cur, nxt; int ui = 0;
    if (!S.next(0, cur)) return;
    f32x4 acc[2][2][4][2];
#pragma unroll
    for (int a = 0; a < 2; ++a)
#pragma unroll
        for (int b = 0; b < 2; ++b)
#pragma unroll
            for (int m = 0; m < 4; ++m)
#pragma unroll
                for (int n = 0; n < 2; ++n) acc[a][b][m][n] = (f32x4){0.f, 0.f, 0.f, 0.f};
    bf16x8 At[4][2], B0[2][2], B1[2][2];
    const char* cA = (const char*)g.A + (size_t)cur.pm * tstep; const char* cB = (const char*)g.Bt + (size_t)cur.pn * tstep;
    S.a_ready(cur);
    if constexpr (SP2) {
        PG8_STAGE(PG8_SB(0, 0), cB, voffB); PG8_STAGE(PG8_SB(0, 1), cB + hstep, voffB); PG8_STAGE(PG8_SA(0, 0), cA, voffA); PG8_STAGE(PG8_SA(0, 1), cA + hstep, voffA);
        if (wr == 1) PG8_BAR;
        PG8_WAIT_V(2); PG8_BAR;
        PG8_STAGE(PG8_SB(1, 0), cB + kstep, voffB); PG8_STAGE(PG8_SA(1, 0), cA + kstep, voffA); PG8_STAGE(PG8_SB(1, 1), cB + hstep + kstep, voffB);
        PG8_WAIT_V(6); PG8_BAR;
    } else {
        PG8_STAGE(PG8_SB(0, 0), cB, voffB); PG8_STAGE(PG8_SA(0, 0), cA, voffA); PG8_STAGE(PG8_SB(0, 1), cB + hstep, voffB); PG8_STAGE(PG8_SA(0, 1), cA + hstep, voffA);
        if (wr == 1) PG8_BAR;
        PG8_WAIT_V(4); PG8_BAR;
        PG8_STAGE(PG8_SB(1, 0), cB + kstep, voffB); PG8_STAGE(PG8_SA(1, 0), cA + kstep, voffA); PG8_STAGE(PG8_SB(1, 1), cB + hstep + kstep, voffB);
        PG8_WAIT_V(6); PG8_BAR;
    }
    for (;;) {
        const bool has_next = S.next(ui + 1, nxt);
        const char* nA = has_next ? (const char*)g.A + (size_t)nxt.pm * tstep : cA; const char* nB = has_next ? (const char*)g.Bt + (size_t)nxt.pn * tstep : cB;
        for (int t = 0; t < nt; t += 2) {
            const bool last = (t == nt - 2);
            const char* a1 = cA + (size_t)(t + 1) * kstep;
            const char* a2 = last ? nA : cA + (size_t)(t + 2) * kstep; const char* b2 = last ? nB : cB + (size_t)(t + 2) * kstep;
            const char* a3 = a2 + kstep; const char* b3 = b2 + kstep;
            if (last && has_next) S.a_ready(nxt);
            if constexpr (SP2) {
            PG8_LDB(B0, 0, 0); PG8_LDB(B1, 0, 1); PG8_SCHED; PG8_LDA(At, 0, 0); PG8_STAGE(PG8_SA(1, 1), a1 + hstep, voffA);
            PG8_WAIT_V(8); PG8_WAIT_L(0); PG8_BAR; PG8_MMA(0, 0, At, B0); PG8_MMA(0, 1, At, B1); PG8_BAR; PG8_SCHED;
            PG8_LDA(At, 0, 1); PG8_STAGE(PG8_SB(0, 0), b2, voffB); PG8_STAGE(PG8_SB(0, 1), b2 + hstep, voffB); PG8_STAGE(PG8_SA(0, 0), a2, voffA);
            PG8_WAIT_V(8); PG8_WAIT_L(0); PG8_BAR; PG8_MMA(1, 0, At, B0); PG8_MMA(1, 1, At, B1); PG8_BAR; PG8_SCHED;
            PG8_LDB(B0, 1, 0); PG8_LDB(B1, 1, 1); PG8_SCHED; PG8_LDA(At, 1, 0); PG8_STAGE(PG8_SA(0, 1), a2 + hstep, voffA);
            PG8_WAIT_V(8); PG8_WAIT_L(0); PG8_BAR; PG8_MMA(0, 0, At, B0); PG8_MMA(0, 1, At, B1); PG8_BAR; PG8_SCHED;
            PG8_LDA(At, 1, 1); PG8_STAGE(PG8_SB(1, 0), b3, voffB); PG8_STAGE(PG8_SB(1, 1), b3 + hstep, voffB); PG8_STAGE(PG8_SA(1, 0), a3, voffA);
            PG8_WAIT_V(8); PG8_WAIT_L(0); PG8_BAR; PG8_MMA(1, 0, At, B0); PG8_MMA(1, 1, At, B1); PG8_BAR; PG8_SCHED;
            } else {
            PG8_LDB(B0, 0, 0); PG8_SCHED; PG8_LDA(At, 0, 0); PG8_STAGE(PG8_SA(1, 1), a1 + hstep, voffA);
            PG8_WAIT_L(8); PG8_BAR; PG8_WAIT_L(0); PG8_MMA(0, 0, At, B0); PG8_BAR; PG8_SCHED;
            PG8_LDB(B1, 0, 1); PG8_STAGE(PG8_SB(0, 0), b2, voffB);
            PG8_BAR; PG8_WAIT_L(0); PG8_MMA(0, 1, At, B1); PG8_BAR;
            PG8_LDA(At, 0, 1); PG8_STAGE(PG8_SA(0, 0), a2, voffA);
            PG8_BAR; PG8_WAIT_L(0); PG8_MMA(1, 0, At, B0); PG8_BAR; PG8_SCHED;
            PG8_STAGE(PG8_SB(0, 1), b2 + hstep, voffB);
            PG8_WAIT_V(6); PG8_BAR; PG8_MMA(1, 1, At, B1); PG8_BAR;
            PG8_LDB(B0, 1, 0); PG8_SCHED; PG8_LDA(At, 1, 0); PG8_STAGE(PG8_SA(0, 1), a2 + hstep, voffA);
            PG8_WAIT_L(8); PG8_BAR; PG8_WAIT_L(0); PG8_MMA(0, 0, At, B0); PG8_BAR; PG8_SCHED;
            PG8_LDB(B1, 1, 1); PG8_STAGE(PG8_SB(1, 0), b3, voffB);
            PG8_BAR; PG8_WAIT_L(0); PG8_MMA(0, 1, At, B1); PG8_BAR;
            PG8_LDA(At, 1, 1); PG8_STAGE(PG8_SA(1, 0), a3, voffA);
            PG8_BAR; PG8_WAIT_L(0); PG8_MMA(1, 0, At, B0); PG8_BAR; PG8_SCHED;
            PG8_STAGE(PG8_SB(1, 1), b3 + hstep, voffB);
            PG8_WAIT_V(6); PG8_BAR; PG8_MMA(1, 1, At, B1); PG8_BAR;
            }
        }
        if constexpr (ALIGN_EPI) { if (wr == 0) PG8_BAR; }
        if constexpr (!Epi::AFTER_DRAIN) { E(acc, cur, wr, wc, fr, fq); S.done(cur); }
        if (!has_next) break;
#pragma unroll
        for (int a = 0; a < 2; ++a)
#pragma unroll
            for (int b = 0; b < 2; ++b)
#pragma unroll
                for (int m = 0; m < 4; ++m)
#pragma unroll
                    for (int n = 0; n < 2; ++n) acc[a][b][m][n] = (f32x4){0.f, 0.f, 0.f, 0.f};
        cur = nxt; cA = nA; cB = nB; ++ui;
        if constexpr (ALIGN_EPI) { if (wr == 1) PG8_BAR; }
    }
    PG8_WAIT_V(0);
    if constexpr (!ALIGN_EPI) { if (wr == 0) PG8_BAR; }
    PG8_BAR;
    if constexpr (Epi::AFTER_DRAIN) { E.fused(acc, cur, wr, wc, fr, fq, lds, wid, lane); S.done(cur); }
#undef PG8_SA
#undef PG8_SB
#undef PG8_STAGE
#undef PG8_LDA
#undef PG8_LDB
#undef PG8_MMA
#undef PG8_WAIT_V
#undef PG8_WAIT_L
#undef PG8_BAR
#undef PG8_SCHED
}
}

#define LAS __attribute__((address_space(3)))
#define DI __device__ __forceinline__
typedef unsigned short bf16;
typedef unsigned v4u __attribute__((ext_vector_type(4)));
typedef unsigned v2u __attribute__((ext_vector_type(2)));
typedef float f32x4 __attribute__((ext_vector_type(4)));
typedef short bf16x8 __attribute__((ext_vector_type(8)));
typedef short s16x4 __attribute__((ext_vector_type(4)));

constexpr int NB = 16, SEQ = 2048, DM = 1024, MTOK = NB * SEQ, CTXL = 256, MCTX = NB * CTXL;
constexpr int PROJ_LD = 2560;
constexpr int PC_G = 0, PC_Q = 512, PC_K = 1024, PC_V = 1536, PC_R = 2048;
constexpr float EPSV = 1e-6f;
constexpr float QK_SCALE = 0.08838834764831845f;
constexpr int RT_CTX = 128, RT_W = 144, RT_WF = 154, RA_ROWS = 158 * 256;
constexpr int G1_MAIN = 1280, G1_FT = 512, G1_UNITS = G1_MAIN + G1_FT;

constexpr size_t MiB = 1u << 20;
constexpr size_t WS_ADA = 1 * MiB;
constexpr size_t WS_ROPE = WS_ADA + 256 * 1024;
constexpr size_t WS_ROWSS = 396 * MiB;
constexpr size_t WS_RA = 2 * MiB;
constexpr size_t WS_MIX = WS_RA;
constexpr size_t WS_PROJ = 82 * MiB;
constexpr size_t WS_Y = WS_PROJ;
constexpr size_t WS_KVC = 242 * MiB;
constexpr size_t WS_ZT = 250 * MiB;
constexpr size_t WS_DT = 314 * MiB;
constexpr size_t WS_ST = 330 * MiB;
constexpr size_t WS_WOT = 394 * MiB;
constexpr size_t WS_YT = 398 * MiB;
constexpr size_t WS_KVCP = 430 * MiB;
constexpr size_t WS_END = 462 * MiB;
constexpr int LDS_BYTES = 147456, LDS_MISC = 139264;

struct Params {
    const float *x, *c, *ctx, *c_ctx, *w_ada, *b_ada, *g_pre, *g_post, *w_in, *w_fourier, *decay_logit, *gn_gain, *w_out;
    float* out; unsigned char* ws; int ph_lo, ph_hi, use_cg, pad;
};

DI unsigned f2bf(float f) { unsigned u = __builtin_bit_cast(unsigned, f); return (u + 0x7fffu + ((u >> 16) & 1u)) >> 16; }
DI unsigned pk2(float lo, float hi) { unsigned r; asm("v_cvt_pk_bf16_f32 %0, %1, %2\n\ts_nop 1" : "=v"(r) : "v"(lo), "v"(hi)); return r; }
DI float bflo(unsigned u) { return __builtin_bit_cast(float, u << 16); }
DI float bfhi(unsigned u) { return __builtin_bit_cast(float, u & 0xffff0000u); }
DI float silu_f(float v) { return v / (1.f + __expf(-v)); }
DI float wave_sum(float v) {
#pragma unroll
    for (int o = 1; o < 64; o <<= 1) v += __shfl_xor(v, o);
    return v;
}
DI unsigned offb(unsigned row, unsigned ch) { return 256u * row + 16u * (ch ^ (((row & 3) << 2) | ((row >> 2) & 3))); }
DI s16x4 tr_read(LAS unsigned char* p) { return __builtin_amdgcn_ds_read_tr16_b64_v4i16((LAS s16x4*)p); }
DI bf16x8 cat8(s16x4 a, s16x4 b) { bf16x8 r; r[0] = a[0]; r[1] = a[1]; r[2] = a[2]; r[3] = a[3]; r[4] = b[0]; r[5] = b[1]; r[6] = b[2]; r[7] = b[3]; return r; }
#define MFMA16(a, b, c) __builtin_amdgcn_mfma_f32_16x16x32_bf16((a), (b), (c), 0, 0, 0)

struct G1Order {
    int G, c;
    DI bool next(int i, pg8::Unit& u) const {
        const int L = i * G + c; if (L >= G1_UNITS) return false;
        if (L < G1_MAIN) {
            const int wgid = (L & 7) * (G1_MAIN / 8) + (L >> 3);
            const int r80 = wgid % 80;
            u.pm = (wgid / 80) * 8 + (r80 & 7); u.pn = RT_W + (r80 >> 3);
        } else {
            const int l2 = L - G1_MAIN, idx = (l2 & 7) * (G1_FT / 8) + (l2 >> 3);
            u.pm = RT_WF + (idx & 3); u.pn = idx >> 2;
        }
        return true;
    }
    DI void a_ready(const pg8::Unit&) const {}
    DI void done(const pg8::Unit&) const {}
};

DI v4u pack8(f32x4 a, f32x4 b) { v4u w; w.x = pk2(a[0], a[1]); w.y = pk2(a[2], a[3]); w.z = pk2(b[0], b[1]); w.w = pk2(b[2], b[3]); return w; }

struct EpiG1 {
    static constexpr bool PERM = true, AFTER_DRAIN = false;
    bf16* PROJ; bf16* ZT; bf16* KVC; const float* rope;
    DI void operator()(const f32x4 (&acc)[2][2][4][2], const pg8::Unit& u, int wr, int wc, int fr, int fq) const {
        const int rl0 = wr * 64 + fr, cl0 = wc * 32 + 8 * fq;
        bf16* base; int ld, mode = 0; float sc = 1.f;
        if (u.pm < RT_CTX) {
            const int wt = u.pn - RT_W, type = wt >> 1;
            base = PROJ + (size_t)(u.pm * 256) * PROJ_LD + wt * 256; ld = PROJ_LD;
            mode = (type == 1 || type == 2) ? 1 : (type == 3 ? 0 : 2); sc = (type == 1) ? QK_SCALE : 1.f;
        } else if (u.pm >= RT_WF) {
            base = ZT + ((size_t)(u.pn >> 3) * 1024 + (u.pm - RT_WF) * 256) * SEQ + (u.pn & 7) * 256; ld = SEQ;
        } else {
            base = KVC + (size_t)((u.pm - RT_CTX) * 256) * 1024 + (u.pn - RT_W - 4) * 256; ld = 1024;
        }
        base += (size_t)rl0 * ld + cl0;
        const int lbase = (u.pm * 256 + rl0) & (SEQ - 1);
        const float* rbase = rope + (16 * (wc & 1) + 4 * fq) * 2;
#pragma unroll
        for (int ai = 0; ai < 2; ++ai)
#pragma unroll
            for (int m = 0; m < 4; ++m) {
                bf16* rowp = base + (size_t)(ai * 128 + m * 16) * ld;
                f32x4 v00 = acc[ai][0][m][0], v01 = acc[ai][0][m][1], v10 = acc[ai][1][m][0], v11 = acc[ai][1][m][1];
                if (mode == 1) {
                    const int l = lbase + ai * 128 + m * 16;
                    const int pos = (wc >> 1) ? (l & 63) : (l >> 6);
                    const f32x4 r0 = *(const f32x4*)(rbase + pos * 64), r1 = *(const f32x4*)(rbase + pos * 64 + 4);
                    f32x4 t;
                    t = v00 * sc; v00[0] = t[0] * r0[0] - t[1] * r0[1]; v00[1] = t[0] * r0[1] + t[1] * r0[0]; v00[2] = t[2] * r0[2] - t[3] * r0[3]; v00[3] = t[2] * r0[3] + t[3] * r0[2];
                    t = v01 * sc; v01[0] = t[0] * r1[0] - t[1] * r1[1]; v01[1] = t[0] * r1[1] + t[1] * r1[0]; v01[2] = t[2] * r1[2] - t[3] * r1[3]; v01[3] = t[2] * r1[3] + t[3] * r1[2];
                    t = v10 * sc; v10[0] = t[0] * r0[0] - t[1] * r0[1]; v10[1] = t[0] * r0[1] + t[1] * r0[0]; v10[2] = t[2] * r0[2] - t[3] * r0[3]; v10[3] = t[2] * r0[3] + t[3] * r0[2];
                    t = v11 * sc; v11[0] = t[0] * r1[0] - t[1] * r1[1]; v11[1] = t[0] * r1[1] + t[1] * r1[0]; v11[2] = t[2] * r1[2] - t[3] * r1[3]; v11[3] = t[2] * r1[3] + t[3] * r1[2];
                } else if (mode == 2) {
#pragma unroll
                    for (int j = 0; j < 4; ++j) { v00[j] = silu_f(v00[j]); v01[j] = silu_f(v01[j]); v10[j] = silu_f(v10[j]); v11[j] = silu_f(v11[j]); }
                }
                *(v4u*)(rowp) = pack8(v00, v01);
                *(v4u*)(rowp + 128) = pack8(v10, v11);
                asm volatile("" ::: "memory");
            }
    }
};

struct OneUnit { int pm, pn;
    DI bool next(int i, pg8::Unit& u) const { if (i) return false; u.pm = pm; u.pn = pn; return true; }
    DI void a_ready(const pg8::Unit&) const {}
    DI void done(const pg8::Unit&) const {}
};
struct EpiCtx {
    static constexpr bool PERM = true, AFTER_DRAIN = false;
    bf16* O;
    DI void operator()(const f32x4 (&acc)[2][2][4][2], const pg8::Unit& u, int wr, int wc, int fr, int fq) const {
        bf16* base = O + (size_t)((u.pm - RT_CTX) * 256 + wr * 64 + fr) * 1024 + (u.pn - RT_W - 4) * 256 + wc * 32 + 8 * fq;
#pragma unroll
        for (int ai = 0; ai < 2; ++ai)
#pragma unroll
            for (int m = 0; m < 4; ++m) { bf16* rowp = base + (size_t)(ai * 128 + m * 16) * 1024;
                *(v4u*)(rowp) = pack8(acc[ai][0][m][0], acc[ai][0][m][1]); *(v4u*)(rowp + 128) = pack8(acc[ai][1][m][0], acc[ai][1][m][1]); }
    }
};

struct EpiDft {
    static constexpr bool PERM = true, AFTER_DRAIN = false;
    const bf16* PROJ; bf16* MIX;
    DI void operator()(const f32x4 (&acc)[2][2][4][2], const pg8::Unit& u, int wr, int wc, int fr, int fq) const {
        const int rl0 = wr * 64 + fr, cl0 = wc * 32 + 8 * fq;
        const int b = u.pn >> 1, chg0 = (u.pn & 1) * 256 + cl0;
#pragma unroll
        for (int ai = 0; ai < 2; ++ai)
#pragma unroll
            for (int m = 0; m < 4; ++m) {
                const size_t tok = (size_t)b * SEQ + u.pm * 256 + rl0 + ai * 128 + m * 16;
#pragma unroll
                for (int bj = 0; bj < 2; ++bj) {
                    const v4u g = *(const v4u*)(PROJ + tok * PROJ_LD + PC_G + chg0 + bj * 128);
                    f32x4 v0 = acc[ai][bj][m][0], v1 = acc[ai][bj][m][1];
                    v0[0] *= bflo(g.x); v0[1] *= bfhi(g.x); v0[2] *= bflo(g.y); v0[3] *= bfhi(g.y);
                    v1[0] *= bflo(g.z); v1[1] *= bfhi(g.z); v1[2] *= bflo(g.w); v1[3] *= bfhi(g.w);
                    *(v4u*)(MIX + tok * 1024 + chg0 + bj * 128) = pack8(v0, v1);
                }
            }
    }
};

struct EpiOut {
    static constexpr bool PERM = true, AFTER_DRAIN = false;
    bf16* Y; float* rowss;
    DI void operator()(const f32x4 (&acc)[2][2][4][2], const pg8::Unit& u, int wr, int wc, int fr, int fq) const {
        const int rl0 = wr * 64 + fr, cl0 = u.pn * 256 + wc * 32 + 8 * fq;
#pragma unroll
        for (int ai = 0; ai < 2; ++ai)
#pragma unroll
            for (int m = 0; m < 4; ++m) {
                const int row = u.pm * 256 + rl0 + ai * 128 + m * 16;
                float ss = 0.f;
#pragma unroll
                for (int bj = 0; bj < 2; ++bj) {
                    const f32x4 v0 = acc[ai][bj][m][0], v1 = acc[ai][bj][m][1];
                    ss += (v0[0] * v0[0] + v0[1] * v0[1]) + (v0[2] * v0[2] + v0[3] * v0[3]) + (v1[0] * v1[0] + v1[1] * v1[1]) + (v1[2] * v1[2] + v1[3] * v1[3]);
                    *(v4u*)(Y + (size_t)row * 1024 + cl0 + bj * 128) = pack8(v0, v1);
                }
                ss += __shfl_xor(ss, 16); ss += __shfl_xor(ss, 32);
                if (fq == 0) rowss[(size_t)row * 16 + u.pn * 4 + wc] = ss;
            }
    }
};

DI int w1_srccol(int n) {
    const int t = n >> 9; int src = 512 + n;
    if (t == 1 || t == 2) { const int p = n & 127, hs = p >> 6, w = p & 63; src = 512 + (n & ~127) + hs * 64 + (w & 1) * 32 + (w >> 1); }
    return src;
}
template <bool MAIN>
DI void transpose_item(const float* W, int N, bf16* WT, int item, LAS float* scr, int lane) {
    const int nblk = MAIN ? 80 : 32, kb = item / nblk, nb = item % nblk, k0 = 64 * kb, n0 = 32 * nb;
    const int nl = lane & 31, sc = MAIN ? w1_srccol(n0 + nl) : (n0 + nl);
#pragma unroll 8
    for (int i = 0; i < 32; ++i) { const int kk = 2 * i + (lane >> 5); scr[kk * 33 + nl] = W[(size_t)(k0 + kk) * N + sc]; }
    asm volatile("s_waitcnt lgkmcnt(0)" ::: "memory");
    const int c = lane & 7;
#pragma unroll
    for (int j = 0; j < 4; ++j) { const int n = (lane >> 3) + 8 * j; const LAS float* s = scr + (8 * c) * 33 + n;
        v4u o; o.x = pk2(s[0 * 33], s[1 * 33]); o.y = pk2(s[2 * 33], s[3 * 33]); o.z = pk2(s[4 * 33], s[5 * 33]); o.w = pk2(s[6 * 33], s[7 * 33]);
        *(v4u*)(WT + (size_t)(n0 + n) * 1024 + k0 + 8 * c) = o; }
    asm volatile("s_waitcnt lgkmcnt(0)" ::: "memory");
}

#if defined(TPROBE)
#define PSTAMP(k) do { if (blockIdx.x == 0 && tid == 0) ((unsigned long long*)(p.ws + 32768))[k] = __builtin_amdgcn_s_memrealtime(); } while (0)
#else
#define PSTAMP(k) do {} while (0)
#endif
DI void phase0(const Params& p, LAS unsigned char* lds, int tid, int lane, int wave) {
    float* ADA = (float*)(p.ws + WS_ADA); float* rope = (float*)(p.ws + WS_ROPE);
    bf16* RA = (bf16*)(p.ws + WS_RA); bf16* WOT = (bf16*)(p.ws + WS_WOT);
    bf16* W1T = RA + (size_t)RT_W * 256 * 1024; bf16* WFT = RA + (size_t)RT_WF * 256 * 1024;
    LAS float* sl = (LAS float*)lds; LAS float* red = sl + 17 * 1024;
    for (int i = tid; i < 17 * 1024; i += 512) { const int v = i >> 10, k = i & 1023; const float cv = (v < 16) ? p.c[v * 1024 + k] : p.c_ctx[k]; sl[i] = cv / (1.f + expf(-cv)); }
    __syncthreads();
    for (int vw = blockIdx.x; vw < 256; vw += gridDim.x) {
        const int j0 = 12 * vw, col = tid & 15, ks = tid >> 4;
        float acc[17];
#pragma unroll
        for (int v = 0; v < 17; ++v) acc[v] = 0.f;
        if (col < 12) {
            float wv[32];
#pragma unroll
            for (int kk = 0; kk < 32; ++kk) wv[kk] = p.w_ada[(size_t)(ks * 32 + kk) * 3072 + j0 + col];
#pragma unroll
            for (int kk = 0; kk < 32; ++kk) { const int k = ks * 32 + kk;
#pragma unroll
                for (int v = 0; v < 17; ++v) acc[v] += sl[v * 1024 + k] * wv[kk]; }
#pragma unroll
            for (int v = 0; v < 17; ++v) red[(ks * 17 + v) * 12 + col] = acc[v];
        }
        __syncthreads();
        if (tid < 204) { const int v = tid / 12, cc = tid % 12; float s = p.b_ada[j0 + cc];
            for (int k2 = 0; k2 < 32; ++k2) s += red[(k2 * 17 + v) * 12 + cc];
            ADA[v * 3072 + j0 + cc] = s; }
        __syncthreads();
    }
    PSTAMP(10);
    {
        LAS float* scr = (LAS float*)(lds + wave * 8448);
        const int gw = blockIdx.x * 8 + wave, NGW = gridDim.x * 8;
        for (int it = gw; it < 1280 + 512; it += NGW) {
            if (it < 1280) transpose_item<true>(p.w_in, 3072, W1T, it, scr, lane);
            else transpose_item<false>(p.w_out, 1024, WOT, it - 1280, scr, lane);
        }
    }
    __syncthreads();
    PSTAMP(11);
    {
        LAS float* ctab = (LAS float*)(lds + 98304); LAS float* stab = ctab + 128;
        LAS unsigned char* CSimg = lds; LAS unsigned char* Wimg = lds + 65536;
        if (tid < 128) { float sn, cs; sincospif((float)tid * (1.f / 64.f), &sn, &cs); ctab[tid] = cs; stab[tid] = sn; }
        __syncthreads();
#pragma unroll 1
        for (int q = 0; q < 8; ++q) { const int id = tid + 512 * q, pq = id >> 11, c = (id >> 4) & 127, ch = id & 15; float v[8];
#pragma unroll
            for (int e = 0; e < 8; ++e) { const int idx = (c * (ch * 8 + e)) & 127; v[e] = pq ? stab[idx] : ctab[idx]; }
            v4u o; o.x = pk2(v[0], v[1]); o.y = pk2(v[2], v[3]); o.z = pk2(v[4], v[5]); o.w = pk2(v[6], v[7]); *(LAS v4u*)(CSimg + pq * 32768 + offb(c, ch)) = o; }
        const int fr = lane & 15, fq = lane >> 4, q4 = fr >> 2, pp = fr & 3;
        for (int vw = blockIdx.x; vw < 256; vw += gridDim.x) {
            const int g = vw >> 6, kb = vw & 63;
            __syncthreads();
#pragma unroll
            for (int q = 0; q < 4; ++q) { const int id = tid + 512 * q, j = id >> 4, ch = id & 15; const f32x4* wp = (const f32x4*)(p.w_fourier + (size_t)(g * 128 + j) * 128 + ch * 8);
                *(LAS v4u*)(Wimg + offb(j, ch)) = pack8(wp[0], wp[1]); }
            f32x4 wa[4][2];
#pragma unroll
            for (int ks = 0; ks < 4; ++ks) { const float* wr_ = p.w_in + (size_t)(16 * kb + fr) * 3072 + g * 128 + 32 * ks + 4 * fq; wa[ks][0] = *(const f32x4*)wr_; wa[ks][1] = *(const f32x4*)(wr_ + 16); }
            __syncthreads();
            bf16x8 wb[4];
#pragma unroll
            for (int ks = 0; ks < 4; ++ks) { const unsigned r0 = 32 * ks + 8 * fq + q4;
                wb[ks] = cat8(tr_read(Wimg + offb(r0, 2 * wave + (pp >> 1)) + 8 * (pp & 1)), tr_read(Wimg + offb(r0 + 4, 2 * wave + (pp >> 1)) + 8 * (pp & 1))); }
            asm volatile("s_waitcnt lgkmcnt(0)" ::: "memory");
            bf16* outp = WFT + (size_t)((g * 128 + 16 * wave + fr) * 2) * 1024 + 16 * kb + 4 * fq;
#pragma unroll
            for (int pq = 0; pq < 2; ++pq) {
                f32x4 acc2 = (f32x4){0.f, 0.f, 0.f, 0.f};
#pragma unroll
                for (int k2 = 0; k2 < 4; ++k2) {
                    v4u tb;
#pragma unroll
                    for (int hf = 0; hf < 2; ++hf) { const int ct = 2 * k2 + hf; f32x4 t = (f32x4){0.f, 0.f, 0.f, 0.f};
#pragma unroll
                        for (int ks = 0; ks < 4; ++ks) t = MFMA16(*(const LAS bf16x8*)(CSimg + pq * 32768 + offb(16 * ct + fr, 4 * ks + fq)), wb[ks], t);
                        if (hf == 0) { tb.x = pk2(t[0], t[1]); tb.y = pk2(t[2], t[3]); } else { tb.z = pk2(t[0], t[1]); tb.w = pk2(t[2], t[3]); } }
                    acc2 = MFMA16(__builtin_bit_cast(bf16x8, pack8(wa[k2][0], wa[k2][1])), __builtin_bit_cast(bf16x8, tb), acc2);
                }
                v2u o; o.x = pk2(acc2[0] * (1.f / 512.f), acc2[1] * (1.f / 512.f)); o.y = pk2(acc2[2] * (1.f / 512.f), acc2[3] * (1.f / 512.f));
                *(v2u*)(outp + pq * 1024) = o;
            }
        }
        __syncthreads();
    }
    PSTAMP(12);
    for (int vw = blockIdx.x; vw < 256; vw += gridDim.x) {
        if (vw < 4) { const int idx = vw * 512 + tid, pos = idx >> 5, i = idx & 31; const float inv = powf(10000.f, -(float)i * (1.f / 32.f)); const float ang = (float)pos * inv;
            rope[idx * 2] = cosf(ang); rope[idx * 2 + 1] = sinf(ang); }
    }
}

constexpr int RW = 4;
DI void phase1(const Params& p, int lane, int wave) {
    const float* ADA = (const float*)(p.ws + WS_ADA); bf16* RA = (bf16*)(p.ws + WS_RA);
    const int gw = blockIdx.x * 8 + wave, NGW = gridDim.x * 8, NR = MTOK + MCTX; int rpw = (NR + NGW - 1) / NGW; rpw = (rpw + RW - 1) / RW * RW;
    int r0 = gw * rpw, r1 = r0 + rpw; if (r1 > NR) r1 = NR;
    int vcur = -1; f32x4 gs[4], sh[4];
    for (int r = r0; r < r1; r += RW) {
        const int v = (r < MTOK) ? (r >> 11) : 16;
        const float* xr = (r < MTOK) ? p.x + (size_t)r * 1024 : p.ctx + (size_t)(r - MTOK) * 1024;
        f32x4 xv[RW][4];
#pragma unroll
        for (int q = 0; q < RW; ++q)
#pragma unroll
            for (int j = 0; j < 4; ++j) xv[q][j] = *(const f32x4*)(xr + q * 1024 + lane * 4 + 256 * j);
        if (v != vcur) { vcur = v;
#pragma unroll
            for (int j = 0; j < 4; ++j) { const int col = lane * 4 + 256 * j; const f32x4 g = *(const f32x4*)(p.g_pre + col), sc = *(const f32x4*)(ADA + v * 3072 + 1024 + col);
                gs[j] = g * (sc + 1.f); sh[j] = *(const f32x4*)(ADA + v * 3072 + col); } }
        float ss[RW];
#pragma unroll
        for (int q = 0; q < RW; ++q) { ss[q] = 0.f;
#pragma unroll
            for (int j = 0; j < 4; ++j) ss[q] += (xv[q][j][0] * xv[q][j][0] + xv[q][j][1] * xv[q][j][1]) + (xv[q][j][2] * xv[q][j][2] + xv[q][j][3] * xv[q][j][3]); }
#pragma unroll
        for (int o = 1; o < 64; o <<= 1)
#pragma unroll
            for (int q = 0; q < RW; ++q) ss[q] += __shfl_xor(ss[q], o);
        bf16* ob = RA + (size_t)r * 1024;
#pragma unroll
        for (int q = 0; q < RW; ++q) { const float rs = rsqrtf(ss[q] * (1.f / 1024.f) + EPSV);
#pragma unroll
            for (int j = 0; j < 4; ++j) { const f32x4 hv = xv[q][j] * rs * gs[j] + sh[j]; v2u w; w.x = pk2(hv[0], hv[1]); w.y = pk2(hv[2], hv[3]); *(v2u*)(ob + q * 1024 + lane * 4 + 256 * j) = w; } }
    }
}

DI void state_unit(const Params& p, LAS unsigned char* lds, int unit, int tid, int lane, int wave) {
    const bf16* PROJ = (const bf16*)(p.ws + WS_PROJ); const bf16* KVC = (const bf16*)(p.ws + WS_KVC); const bf16* KVCP = (const bf16*)(p.ws + WS_KVCP); bf16* ST = (bf16*)(p.ws + WS_ST);
    const int eh = unit & 1, dir = (unit >> 1) & 1, h = (unit >> 2) & 3, b = unit >> 4;
    const int fr = lane & 15, fq = lane >> 4, q4 = fr >> 2, pp = fr & 3;
    const int et = wave & 3, dtb = (wave >> 2) * 4, cb = 4 * eh + et;
    const float lg = p.decay_logit[dir * 4 + h]; const float l2 = -log1pf(expf(-lg)) * 1.4426950408889634f;
    const float cdec = exp2f(128.f * l2);
    f32x4 acc[4];
#pragma unroll
    for (int i = 0; i < 4; ++i) acc[i] = (f32x4){0.f, 0.f, 0.f, 0.f};
    v4u kr0[4], vr0[2], kr1[4], vr1[2];
#define ST_LOAD(s, kr, vr) do { const bf16* Kp; int ld; \
        if ((s) < 2) { const int cc = dir ? 1 - (s) : (s); Kp = KVC + (size_t)(b * 256 + cc * 128) * 1024 + h * 128; ld = 1024; } \
        else { const int c = dir ? 17 - (s) : (s) - 2; Kp = PROJ + (size_t)(b * SEQ + c * 128) * PROJ_LD + PC_K + h * 128; ld = PROJ_LD; } \
        _Pragma("unroll") for (int i = 0; i < 4; ++i) { const int id = tid + 512 * i; kr[i] = *(const v4u*)(Kp + (size_t)(id >> 4) * ld + (id & 15) * 8); } \
        _Pragma("unroll") for (int i = 0; i < 2; ++i) { const int id = tid + 512 * i; vr[i] = *(const v4u*)(Kp + 512 + (size_t)(id >> 3) * ld + (8 * eh + (id & 7)) * 8); } } while (0)
#define ST_WRITE(buf, kr, vr) do { \
        _Pragma("unroll") for (int i = 0; i < 4; ++i) { const int id = tid + 512 * i; *(LAS v4u*)(lds + (buf) * 65536 + offb(id >> 4, id & 15)) = kr[i]; } \
        _Pragma("unroll") for (int i = 0; i < 2; ++i) { const int id = tid + 512 * i, m = id >> 3; const float wgt = exp2f((float)(dir ? m : 127 - m) * l2); \
            v4u o; o.x = pk2(bflo(vr[i].x) * wgt, bfhi(vr[i].x) * wgt); o.y = pk2(bflo(vr[i].y) * wgt, bfhi(vr[i].y) * wgt); \
            o.z = pk2(bflo(vr[i].z) * wgt, bfhi(vr[i].z) * wgt); o.w = pk2(bflo(vr[i].w) * wgt, bfhi(vr[i].w) * wgt); \
            *(LAS v4u*)(lds + (buf) * 65536 + 32768 + offb(m, 8 * eh + (id & 7))) = o; } } while (0)
#define ST_COMPUTE(s, buf) do { \
        asm volatile("s_waitcnt lgkmcnt(0)" ::: "memory"); \
        if ((s) >= 2) { \
            const int c = dir ? 17 - (s) : (s) - 2; \
            bf16* so = ST + ((size_t)(((b * 4 + h) * 16 + c) * 2 + dir)) * 16384 + (size_t)(64 * eh + 16 * et + fr) * 128; \
            _Pragma("unroll") for (int i = 0; i < 4; ++i) { v2u w; w.x = pk2(acc[i][0], acc[i][1]); w.y = pk2(acc[i][2], acc[i][3]); *(v2u*)(so + 16 * (dtb + i) + 4 * fq) = w; } \
        } \
        if ((s) < 17) { \
            LAS unsigned char* Kb = lds + (buf) * 65536; LAS unsigned char* Vb = Kb + 32768; \
            _Pragma("unroll") for (int i = 0; i < 4; ++i) acc[i] = acc[i] * cdec; \
            _Pragma("unroll") for (int ks = 0; ks < 4; ++ks) { \
                const unsigned r0 = 32 * ks + 8 * fq + q4; \
                const bf16x8 vb = cat8(tr_read(Vb + offb(r0, 2 * cb + (pp >> 1)) + 8 * (pp & 1)), tr_read(Vb + offb(r0 + 4, 2 * cb + (pp >> 1)) + 8 * (pp & 1))); \
                _Pragma("unroll") for (int i = 0; i < 4; ++i) { const int dt = dtb + i; \
                    const bf16x8 ka = cat8(tr_read(Kb + offb(r0, 2 * dt + (pp >> 1)) + 8 * (pp & 1)), tr_read(Kb + offb(r0 + 4, 2 * dt + (pp >> 1)) + 8 * (pp & 1))); \
                    acc[i] = MFMA16(ka, vb, acc[i]); } \
            } \
        } } while (0)
#define ST_LOAD_CTX(s, kr, vr) do { const int cc = dir ? 1 - (s) : (s); const bf16* Kp = KVCP + (size_t)(b * 256 + cc * 128) * 1024 + h * 128; \
        v4u t4[6][4]; \
        _Pragma("unroll") for (int i = 0; i < 6; ++i) { const int id = tid + 512 * (i < 4 ? i : i - 4); \
            const bf16* src = (i < 4) ? Kp + (size_t)(id >> 4) * 1024 + (id & 15) * 8 : Kp + 512 + (size_t)(id >> 3) * 1024 + (8 * eh + (id & 7)) * 8; \
            _Pragma("unroll") for (int kq = 0; kq < 4; ++kq) t4[i][kq] = *(const v4u*)(src + (size_t)kq * MCTX * 1024); } \
        _Pragma("unroll") for (int i = 0; i < 6; ++i) { float a[8]; _Pragma("unroll") for (int j = 0; j < 8; ++j) a[j] = 0.f; \
            _Pragma("unroll") for (int kq = 0; kq < 4; ++kq) { const v4u w4 = t4[i][kq]; \
                a[0] += bflo(w4.x); a[1] += bfhi(w4.x); a[2] += bflo(w4.y); a[3] += bfhi(w4.y); a[4] += bflo(w4.z); a[5] += bfhi(w4.z); a[6] += bflo(w4.w); a[7] += bfhi(w4.w); } \
            v4u o; o.x = pk2(a[0], a[1]); o.y = pk2(a[2], a[3]); o.z = pk2(a[4], a[5]); o.w = pk2(a[6], a[7]); \
            if (i < 4) kr[i < 4 ? i : 0] = o; else vr[i < 4 ? 0 : i - 4] = o; } } while (0)
    ST_LOAD_CTX(0, kr0, vr0); ST_LOAD_CTX(1, kr1, vr1);
#undef ST_LOAD_CTX
    ST_WRITE(0, kr0, vr0); __syncthreads(); ST_LOAD(2, kr0, vr0);
#pragma unroll 1
    for (int s = 0; s < 18; s += 2) {
        if (s + 1 < 17) { ST_WRITE(1, kr1, vr1); if (s + 3 < 17) ST_LOAD(s + 3, kr1, vr1); }
        ST_COMPUTE(s, 0);
        __syncthreads();
        if (s + 2 < 17) { ST_WRITE(0, kr0, vr0); if (s + 4 < 17) ST_LOAD(s + 4, kr0, vr0); }
        ST_COMPUTE(s + 1, 1);
        __syncthreads();
    }
#undef ST_WRITE
#undef ST_COMPUTE
#undef ST_LOAD
}

DI void ret_unit(const Params& p, LAS unsigned char* lds, int unit, int tid, int lane, int wave) {
    const bf16* PROJ = (const bf16*)(p.ws + WS_PROJ); const bf16* ST = (const bf16*)(p.ws + WS_ST); bf16* MIX = (bf16*)(p.ws + WS_MIX); const bf16* YT = (const bf16*)(p.ws + WS_YT);
    const int c = unit & 15, h = (unit >> 4) & 3, b = unit >> 6;
    const int fr = lane & 15, fq = lane >> 4, q4 = fr >> 2, pp = fr & 3;
    const size_t tok0 = (size_t)b * SEQ + c * 128;
    const float l2f = -log1pf(expf(-p.decay_logit[h])) * 1.4426950408889634f, l2b = -log1pf(expf(-p.decay_logit[4 + h])) * 1.4426950408889634f;
    LAS unsigned char* Kimg = lds; LAS unsigned char* Vimg = lds + 32768; LAS unsigned char* Simg = lds + 65536; LAS unsigned char* Ost = lds + 98304 + wave * 4352;
    const bf16* Kp = PROJ + tok0 * PROJ_LD + PC_K + h * 128; const bf16* Vp = PROJ + tok0 * PROJ_LD + PC_V + h * 128;
    const bf16* Sf = ST + ((size_t)(((b * 4 + h) * 16 + c) * 2)) * 16384; const bf16* Sb = Sf + 16384;
    v4u kr[4], vr[4], sr[4], sbr[4]; bf16x8 qf[4];
#pragma unroll
    for (int i = 0; i < 4; ++i) { const int id = tid + 512 * i, row = id >> 4, ch = id & 15;
        kr[i] = *(const v4u*)(Kp + (size_t)row * PROJ_LD + ch * 8); vr[i] = *(const v4u*)(Vp + (size_t)row * PROJ_LD + ch * 8);
        sr[i] = *(const v4u*)(Sf + row * 128 + ch * 8); sbr[i] = *(const v4u*)(Sb + row * 128 + ch * 8); }
    { const bf16* Qp = PROJ + (tok0 + 16 * wave + fr) * PROJ_LD + PC_Q + h * 128 + 8 * fq;
#pragma unroll
      for (int ks = 0; ks < 4; ++ks) qf[ks] = *(const bf16x8*)(Qp + 32 * ks); }
    __syncthreads();
#pragma unroll
    for (int i = 0; i < 4; ++i) { const int id = tid + 512 * i; const unsigned o = offb(id >> 4, id & 15);
        *(LAS v4u*)(Kimg + o) = kr[i]; *(LAS v4u*)(Vimg + o) = vr[i]; *(LAS v4u*)(Simg + o) = sr[i]; }
    __syncthreads();
    v4u yt[4];
#pragma unroll
    for (int i = 0; i < 4; ++i) { const int id = tid + 512 * i; yt[i] = *(const v4u*)(YT + ((size_t)(b * 512 + h * 128 + (id >> 4))) * SEQ + c * 128 + (id & 15) * 8); }
    const int nl = 16 * wave + fr;
    const float sf = exp2f((float)(nl + 1) * l2f), sbv = exp2f((float)(128 - nl) * l2b);
    f32x4 O[8];
#pragma unroll
    for (int et = 0; et < 8; ++et) { f32x4 a = (f32x4){0.f, 0.f, 0.f, 0.f};
#pragma unroll
        for (int ks = 0; ks < 4; ++ks) a = MFMA16(*(const LAS bf16x8*)(Simg + offb(16 * et + fr, 4 * ks + fq)), qf[ks], a);
        O[et] = a * sf; }
    bf16x8 pf[4];
#pragma unroll
    for (int k2 = 0; k2 < 4; ++k2) {
        v4u pw;
#pragma unroll
        for (int hf = 0; hf < 2; ++hf) { const int mt = 2 * k2 + hf; f32x4 sacc = (f32x4){0.f, 0.f, 0.f, 0.f};
#pragma unroll
            for (int ks = 0; ks < 4; ++ks) sacc = MFMA16(*(const LAS bf16x8*)(Kimg + offb(16 * mt + fr, 4 * ks + fq)), qf[ks], sacc);
#pragma unroll
            for (int j = 0; j < 4; ++j) { const int df = nl - (16 * mt + 4 * fq + j); sacc[j] *= (df >= 0) ? exp2f((float)df * l2f) : exp2f((float)(-df) * l2b); }
            if (hf == 0) { pw.x = pk2(sacc[0], sacc[1]); pw.y = pk2(sacc[2], sacc[3]); } else { pw.z = pk2(sacc[0], sacc[1]); pw.w = pk2(sacc[2], sacc[3]); } }
        pf[k2] = __builtin_bit_cast(bf16x8, pw);
    }
    asm volatile("s_waitcnt lgkmcnt(0)" ::: "memory");
#pragma unroll
    for (int et = 0; et < 8; ++et)
#pragma unroll
        for (int ks = 0; ks < 4; ++ks) { const unsigned r0 = 32 * ks + 4 * fq + q4;
            const bf16x8 va = cat8(tr_read(Vimg + offb(r0, 2 * et + (pp >> 1)) + 8 * (pp & 1)), tr_read(Vimg + offb(r0 + 16, 2 * et + (pp >> 1)) + 8 * (pp & 1)));
            O[et] = MFMA16(va, pf[ks], O[et]); }
    asm volatile("s_waitcnt lgkmcnt(0)" ::: "memory");
    __syncthreads();
#pragma unroll
    for (int i = 0; i < 4; ++i) { const int id = tid + 512 * i; const unsigned o = offb(id >> 4, id & 15); *(LAS v4u*)(Simg + o) = sbr[i]; *(LAS v4u*)(Kimg + o) = yt[i]; }
    __syncthreads();
    v4u gR[4], gG[4];
#pragma unroll
    for (int i = 0; i < 4; ++i) { const int id = lane + 64 * i; gR[i] = *(const v4u*)(PROJ + (tok0 + 16 * wave + (id >> 4)) * PROJ_LD + PC_R + h * 128 + (id & 15) * 8);
        gG[i] = *(const v4u*)(PROJ + (tok0 + 16 * wave + fr) * PROJ_LD + PC_G + h * 128 + 32 * i + 8 * fq); }
#pragma unroll
    for (int et = 0; et < 8; ++et) { f32x4 a = (f32x4){0.f, 0.f, 0.f, 0.f};
#pragma unroll
        for (int ks = 0; ks < 4; ++ks) a = MFMA16(*(const LAS bf16x8*)(Simg + offb(16 * et + fr, 4 * ks + fq)), qf[ks], a);
        O[et] = O[et] + a * sbv; }
    float s1 = 0.f;
#pragma unroll
    for (int et = 0; et < 8; ++et) s1 += (O[et][0] + O[et][1]) + (O[et][2] + O[et][3]);
    s1 += __shfl_xor(s1, 16); s1 += __shfl_xor(s1, 32);
    const float mu = s1 * (1.f / 128.f); float s2 = 0.f;
#pragma unroll
    for (int et = 0; et < 8; ++et) { O[et] = O[et] - mu; s2 += (O[et][0] * O[et][0] + O[et][1] * O[et][1]) + (O[et][2] * O[et][2] + O[et][3] * O[et][3]); }
    s2 += __shfl_xor(s2, 16); s2 += __shfl_xor(s2, 32);
    const float rstd = rsqrtf(s2 * (1.f / 128.f) + EPSV);
#pragma unroll
    for (int et = 0; et < 8; ++et) { v2u w; w.x = pk2(O[et][0] * rstd, O[et][1] * rstd); w.y = pk2(O[et][2] * rstd, O[et][3] * rstd); *(LAS v2u*)(Ost + fr * 272 + (16 * et + 4 * fq) * 2) = w; }
    asm volatile("s_waitcnt lgkmcnt(0)" ::: "memory");
#pragma unroll
    for (int i = 0; i < 4; ++i) { const int id = lane + 64 * i, row = id >> 4, ch = id & 15;
        const v4u on = *(const LAS v4u*)(Ost + row * 272 + ch * 16);
        const size_t tok = tok0 + 16 * wave + row;
        const v4u g = gR[i];
        const f32x4 g0 = *(const f32x4*)(p.gn_gain + h * 128 + ch * 8), g1 = *(const f32x4*)(p.gn_gain + h * 128 + ch * 8 + 4);
        v4u o;
        o.x = pk2(bflo(on.x) * g0[0] * bflo(g.x), bfhi(on.x) * g0[1] * bfhi(g.x)); o.y = pk2(bflo(on.y) * g0[2] * bflo(g.y), bfhi(on.y) * g0[3] * bfhi(g.y));
        o.z = pk2(bflo(on.z) * g1[0] * bflo(g.z), bfhi(on.z) * g1[1] * bfhi(g.z)); o.w = pk2(bflo(on.w) * g1[2] * bflo(g.w), bfhi(on.w) * g1[3] * bfhi(g.w));
        *(v4u*)(MIX + tok * 1024 + 512 + h * 128 + ch * 8) = o; }
    asm volatile("s_waitcnt lgkmcnt(0)" ::: "memory");
#pragma unroll
    for (int ks = 0; ks < 4; ++ks) { const unsigned r0 = 32 * ks + 8 * fq + q4; const size_t tok = tok0 + 16 * wave + fr;
        const v4u y = __builtin_bit_cast(v4u, cat8(tr_read(Kimg + offb(r0, 2 * wave + (pp >> 1)) + 8 * (pp & 1)), tr_read(Kimg + offb(r0 + 4, 2 * wave + (pp >> 1)) + 8 * (pp & 1))));
        const v4u g = gG[ks];
        v4u o; o.x = pk2(bflo(y.x) * bflo(g.x), bfhi(y.x) * bfhi(g.x)); o.y = pk2(bflo(y.y) * bflo(g.y), bfhi(y.y) * bfhi(g.y));
        o.z = pk2(bflo(y.z) * bflo(g.z), bfhi(y.z) * bfhi(g.z)); o.w = pk2(bflo(y.w) * bflo(g.w), bfhi(y.w) * bfhi(g.w));
        *(v4u*)(MIX + tok * 1024 + h * 128 + 32 * ks + 8 * fq) = o; }
}

constexpr int FFT_IN = 0, FFT_STG = 65536, FFT_A2 = 98304, FFT_TW = 114688;
DI void fft_setup(LAS unsigned char* lds, int tid, int lane, bf16x8 (&m1)[2][4]) {
    LAS float* ct = (LAS float*)(lds + FFT_IN);
    for (int i = tid; i < 2048; i += 512) ct[i] = cospif((float)i * (1.f / 1024.f));
    __syncthreads();
    const int fr = lane & 15, fq = lane >> 4;
#pragma unroll
    for (int pq = 0; pq < 2; ++pq)
#pragma unroll
        for (int c4 = 0; c4 < 4; ++c4) { const int ri = c4 >> 1, k1 = 16 * (c4 & 1) + fr; float v[8];
#pragma unroll
            for (int i = 0; i < 8; ++i) { const int l1 = 8 * fq + i, idx = ((k1 * l1) & 31) * 64; const float C = ct[idx], S = ct[(idx - 512) & 2047];
                v[i] = (pq == 0 && ri == 0) ? C : ((pq == 1 && ri == 1) ? -C : -S); }
            v4u w; w.x = pk2(v[0], v[1]); w.y = pk2(v[2], v[3]); w.z = pk2(v[4], v[5]); w.w = pk2(v[6], v[7]); m1[pq][c4] = __builtin_bit_cast(bf16x8, w); }
    for (int e = tid; e < 1024; e += 512) { const int ln = e & 63, fr2 = ln & 15, fq2 = ln >> 4, ks2 = (e >> 6) & 3, mt = e >> 8, ri = ks2 >> 1, base = 32 * (ks2 & 1), k2 = 16 * mt + fr2; float v[8];
#pragma unroll
        for (int i = 0; i < 8; ++i) { const int l2 = base + ((i < 4) ? 4 * fq2 + i : 16 + 4 * fq2 + (i - 4)), idx = ((k2 * l2) & 63) * 32; v[i] = ri ? ct[(idx - 512) & 2047] : ct[idx]; }
        v4u w; w.x = pk2(v[0], v[1]); w.y = pk2(v[2], v[3]); w.z = pk2(v[4], v[5]); w.w = pk2(v[6], v[7]); *(LAS v4u*)(lds + FFT_A2 + e * 16) = w; }
    for (int e = tid; e < 2048; e += 512) { const int ln = e & 63, fr2 = ln & 15, fq2 = ln >> 4, j = (e >> 6) & 3, kt = (e >> 8) & 1, rt = e >> 9;
        const int idx = (16 * kt + fr2) * (16 * rt + 4 * fq2 + j); typedef float f32x2 __attribute__((ext_vector_type(2)));
        *(LAS f32x2*)(lds + FFT_TW + e * 8) = (f32x2){ct[idx], ct[(idx - 512) & 2047]}; }
    __syncthreads();
}
DI void fft_decode(int v, int& b, int& g, int& s8) {
    const int i = v >> 8, w = v & 255, x = w & 7, j = w >> 3, bg = i * 16 + x * 2 + (j >> 4);
    s8 = j & 15; b = bg >> 2; g = bg & 3;
}
DI void fft_units(const Params& p, LAS unsigned char* lds, int tid, int lane, int wave, const bf16x8 (&m1)[2][4]) {
    const bf16* ZT = (const bf16*)(p.ws + WS_ZT); bf16* YT = (bf16*)(p.ws + WS_YT);
    const int fr = lane & 15, fq = lane >> 4, q4 = fr >> 2, pp = fr & 3;
    LAS unsigned char* img = lds + FFT_IN + wave * 8192;
    typedef float f32x2 __attribute__((ext_vector_type(2)));
    LAS unsigned char* stg = lds + FFT_STG;
    int v = blockIdx.x; if (v >= 1024) return;
    int b, g, s8; fft_decode(v, b, g, s8);
    v4u ld[8];
    { const bf16* src = ZT + ((size_t)b * 1024 + (g * 128 + 8 * s8) * 2) * SEQ;
#pragma unroll
      for (int i = 0; i < 8; ++i) ld[i] = *(const v4u*)(src + (size_t)(tid + 512 * i) * 8); }
#pragma unroll 1
    for (; v < 1024; v += gridDim.x) {
        __syncthreads();
#pragma unroll
        for (int i = 0; i < 8; ++i) *(LAS v4u*)(lds + FFT_IN + (tid + 512 * i) * 16) = ld[i];
        __syncthreads();
        const int cb = b, cg = g, cs8 = s8;
        if (v + (int)gridDim.x < 1024) { fft_decode(v + gridDim.x, b, g, s8);
            const bf16* src = ZT + ((size_t)b * 1024 + (g * 128 + 8 * s8) * 2) * SEQ;
#pragma unroll
            for (int i = 0; i < 8; ++i) ld[i] = *(const v4u*)(src + (size_t)(tid + 512 * i) * 8); }
        {
        f32x4 D1[4][4];
#pragma unroll
        for (int rt = 0; rt < 4; ++rt) {
            LAS unsigned char* a0 = img + (8 * fq + q4) * 128 + (16 * rt + 4 * pp) * 2;
            const bf16x8 ap = cat8(tr_read(a0), tr_read(a0 + 512)), aq = cat8(tr_read(a0 + 4096), tr_read(a0 + 4096 + 512));
#pragma unroll
            for (int c4 = 0; c4 < 4; ++c4) { f32x4 d = (f32x4){0.f, 0.f, 0.f, 0.f}; d = MFMA16(ap, m1[0][c4], d); d = MFMA16(aq, m1[1][c4], d); D1[rt][c4] = d; }
        }
        asm volatile("s_waitcnt lgkmcnt(0)" ::: "memory");
        bf16x8 b2[4][2];
#pragma unroll
        for (int kt = 0; kt < 2; ++kt)
#pragma unroll
            for (int hf = 0; hf < 2; ++hf) { v4u wre, wim;
#pragma unroll
                for (int hh = 0; hh < 2; ++hh) { const int rt = 2 * hf + hh; float re[4], im[4];
#pragma unroll
                    for (int j = 0; j < 4; ++j) { const f32x2 tw = *(const LAS f32x2*)(lds + FFT_TW + (((rt * 2 + kt) * 4 + j) * 64 + lane) * 8); const float c = tw.x, sn = tw.y;
                        const float tr = D1[rt][kt][j], ti = D1[rt][2 + kt][j]; re[j] = tr * c + ti * sn; im[j] = ti * c - tr * sn; }
                    if (hh == 0) { wre.x = pk2(re[0], re[1]); wre.y = pk2(re[2], re[3]); wim.x = pk2(im[0], im[1]); wim.y = pk2(im[2], im[3]); }
                    else { wre.z = pk2(re[0], re[1]); wre.w = pk2(re[2], re[3]); wim.z = pk2(im[0], im[1]); wim.w = pk2(im[2], im[3]); } }
                b2[hf][kt] = __builtin_bit_cast(bf16x8, wre); b2[2 + hf][kt] = __builtin_bit_cast(bf16x8, wim); }
#pragma unroll
        for (int mt = 0; mt < 4; ++mt) {
            bf16x8 a2[4];
#pragma unroll
            for (int ks2 = 0; ks2 < 4; ++ks2) a2[ks2] = *(const LAS bf16x8*)(lds + FFT_A2 + ((mt * 4 + ks2) * 64 + lane) * 16);
#pragma unroll
            for (int kt = 0; kt < 2; ++kt) { f32x4 d = (f32x4){0.f, 0.f, 0.f, 0.f};
#pragma unroll
                for (int ks2 = 0; ks2 < 4; ++ks2) d = MFMA16(a2[ks2], b2[ks2][kt], d);
#pragma unroll
                for (int j = 0; j < 4; ++j) { const int k = (16 * kt + fr) + 32 * (16 * mt + 4 * fq + j); *(LAS unsigned short*)(stg + wave * 4096 + k * 2) = (unsigned short)f2bf(d[j]); } }
        }
        }
        __syncthreads();
        { bf16* dst = YT + ((size_t)cb * 512 + cg * 128 + 8 * cs8) * SEQ;
#pragma unroll
          for (int i = 0; i < 4; ++i) { const int id = tid + 512 * i; *(v4u*)(dst + (size_t)id * 8) = *(const LAS v4u*)(stg + id * 16); } }
    }
}

template <int ENC> DI void phase6(const Params& p, int lane, int wave) {
    const float* ADA = (const float*)(p.ws + WS_ADA); const float* rowss = (const float*)(p.ws + WS_ROWSS); const bf16* Y = (const bf16*)(p.ws + WS_Y);
    const int gw = blockIdx.x * 8 + wave, NGW = gridDim.x * 8; int rpw = (MTOK + NGW - 1) / NGW; rpw = (rpw + RW - 1) / RW * RW;
    int r0 = gw * rpw, r1 = r0 + rpw; if (r1 > MTOK) r1 = MTOK;
    if (ENC) { if (gw != 0) return; r0 = 0; r1 = 16; }
    int vcur = -1; f32x4 gg[4];
    for (int r = r0; r < r1; r += RW) {
        const int v = r >> 11;
        float ssum = rowss[(size_t)r * 16 + lane];
        f32x4 xv[RW][4]; v2u yv[RW][4];
#pragma unroll
        for (int q = 0; q < RW; ++q)
#pragma unroll
            for (int j = 0; j < 4; ++j) { const int col = lane * 4 + 256 * j; xv[q][j] = *(const f32x4*)(p.x + (size_t)(r + q) * 1024 + col); yv[q][j] = *(const v2u*)(Y + (size_t)(r + q) * 1024 + col); }
        if (v != vcur) { vcur = v;
#pragma unroll
            for (int j = 0; j < 4; ++j) { const int col = lane * 4 + 256 * j; gg[j] = *(const f32x4*)(p.g_post + col) * *(const f32x4*)(ADA + v * 3072 + 2048 + col); } }
#pragma unroll
        for (int o = 1; o < 16; o <<= 1) ssum += __shfl_xor(ssum, o);
#pragma unroll
        for (int q = 0; q < RW; ++q) { const float rs = rsqrtf(__shfl(ssum, 16 * q) * (1.f / 1024.f) + EPSV);
#pragma unroll
            for (int j = 0; j < 4; ++j) { const int col = lane * 4 + 256 * j; const f32x4 xq = xv[q][j]; const v2u yq = yv[q][j];
                f32x4 o; o[0] = xq[0] + gg[j][0] * (bflo(yq.x) * rs); o[1] = xq[1] + gg[j][1] * (bfhi(yq.x) * rs); o[2] = xq[2] + gg[j][2] * (bflo(yq.y) * rs); o[3] = xq[3] + gg[j][3] * (bfhi(yq.y) * rs);
#if defined(TPROBE)
                if (ENC) { float X = 1000.f; if (TPROBE_LO >= 0) { const unsigned long long* st = (const unsigned long long*)(p.ws + 32768); X = (float)(st[TPROBE_HI] - st[TPROBE_LO]) * 0.01f; }
                    const float e = 0.1f * sqrtf(X * 0.001f); o = o + e; }
#endif
                *(f32x4*)(p.out + (size_t)(r + q) * 1024 + col) = o; } }
    }
}

#define XB_TMO      128
#define XB_XCNT(j)  (256  + 64 * (j))
#define XB_XSUB(j)  (1280 + 64 * (j))
#define XB_XGEN(j)  (2304 + 64 * (j))
#define XB_TOP      3328
#define XB_TOPGEN   3392
#define XCD_BAR_WORDS 3456
#define XB_SPIN_CAP (1u << 18)

__device__ __forceinline__ unsigned xb_ld(unsigned* p)              { return __hip_atomic_load(p, __ATOMIC_RELAXED, __HIP_MEMORY_SCOPE_AGENT); }
__device__ __forceinline__ unsigned xb_add(unsigned* p, unsigned v) { return __hip_atomic_fetch_add(p, v, __ATOMIC_RELAXED, __HIP_MEMORY_SCOPE_AGENT); }
__device__ __forceinline__ unsigned xb_xcc_id() { return (unsigned)__builtin_amdgcn_s_getreg((3 << 11) | 20) & 0xFu; }
#define XB_SPIN(cond, bar) do { unsigned _sp = 0; while (cond) { __builtin_amdgcn_s_sleep(1); \
    if ((++_sp & 255u) == 0u) { if (xb_ld(&(bar)[XB_TMO])) break; if (_sp > XB_SPIN_CAP) { atomicAdd(&(bar)[XB_TMO], 1u); break; } } } } while (0)

struct XcdBarrier {
    unsigned* bar; unsigned x;
    volatile LAS unsigned* st;
};

__device__ __forceinline__ XcdBarrier xcd_barrier_post(unsigned* bar, volatile LAS unsigned* st) {
    XcdBarrier b; b.bar = bar; b.x = xb_xcc_id(); b.st = st;
    if (threadIdx.x == 0) (void)xb_add(&bar[XB_XCNT(b.x)], 1u);
    return b;
}
__device__ __forceinline__ void xcd_barrier_complete(unsigned* bar, unsigned x, unsigned& nloc, unsigned& nx) {
    const unsigned G = gridDim.x * gridDim.y * gridDim.z;
    unsigned sum, cnt, mine, sp = 0u;
    for (;;) {
        sum = 0u; cnt = 0u; mine = 0u;
#pragma unroll
        for (unsigned j = 0; j < 16; ++j) { const unsigned c = xb_ld(&bar[XB_XCNT(j)]); sum += c; cnt += (c > 0u) ? 1u : 0u; mine = (j == x) ? c : mine; }
        if (sum == G) break;
        __builtin_amdgcn_s_sleep(1);
        if ((++sp & 255u) == 0u) { if (xb_ld(&bar[XB_TMO])) break; if (sp > XB_SPIN_CAP) { atomicAdd(&bar[XB_TMO], 1u); break; } }
    }
    nloc = mine > 0u ? mine : 1u; nx = cnt > 0u ? cnt : 1u;
}

__device__ __forceinline__ void xcd_barrier(const XcdBarrier& b) {
    asm volatile("s_waitcnt vmcnt(0)" ::: "memory");
    __syncthreads();
    if (threadIdx.x == 0) {
        unsigned* bar = b.bar;
        __builtin_amdgcn_s_waitcnt(0);
        unsigned nloc = b.st[0], nx = b.st[1];
        if (nloc == 0u) { xcd_barrier_complete(bar, b.x, nloc, nx); b.st[0] = nloc; b.st[1] = nx; }
        const unsigned old = xb_add(&bar[XB_XSUB(b.x)], 1u);
        const unsigned gen = old / nloc;
        if (old + 1u == (gen + 1u) * nloc) {
            __builtin_amdgcn_fence(__ATOMIC_RELEASE, "agent");
            asm volatile("s_waitcnt vmcnt(0)" ::: "memory");
            const unsigned og = xb_add(&bar[XB_TOP], 1u);
            const unsigned tg = og / nx;
            if (og + 1u == (tg + 1u) * nx) xb_add(&bar[XB_TOPGEN], 1u);
            else XB_SPIN(xb_ld(&bar[XB_TOPGEN]) == tg, bar);
            __builtin_amdgcn_fence(__ATOMIC_ACQUIRE, "agent");
            xb_add(&bar[XB_XGEN(b.x)], 1u);
            asm volatile("s_waitcnt vmcnt(0)" ::: "memory");
        } else {
            XB_SPIN(xb_ld(&bar[XB_XGEN(b.x)]) == gen, bar);
            __builtin_amdgcn_fence(__ATOMIC_ACQUIRE, "agent");
            asm volatile("s_waitcnt vmcnt(0)" ::: "memory");
        }
    }
    __syncthreads();
}


__global__ void __launch_bounds__(512, 2) hymba_fwd(Params p) {
    extern __shared__ __attribute__((aligned(16))) unsigned char lds_raw[];
    LAS unsigned char* lds = (LAS unsigned char*)lds_raw;
    cg::grid_group grid = cg::this_grid();
    const int tid = threadIdx.x, lane = tid & 63, wave = __builtin_amdgcn_readfirstlane(tid >> 6);
    const int lo = p.ph_lo, hi = p.ph_hi;
    volatile LAS unsigned* misc = (volatile LAS unsigned*)(lds + LDS_MISC);
    if (tid < 4) misc[tid] = 0u;
    __syncthreads();
    XcdBarrier bar = xcd_barrier_post((unsigned*)p.ws, misc);
#define IN(k) (lo <= (k) && (k) < hi)
#ifndef REP2
#define REP2 1
#endif
#ifndef REP3
#define REP3 1
#endif
#ifndef REP4
#define REP4 1
#endif
#if defined(TPROBE)
#define STAMP(k) do { if (blockIdx.x == 0 && tid == 0) ((unsigned long long*)(p.ws + 32768))[k] = __builtin_amdgcn_s_memrealtime(); } while (0)
#else
#define STAMP(k) do {} while (0)
#endif
#define SEAM(k) do { if (IN(k) && IN((k) + 1)) { if (p.use_cg) grid.sync(); else xcd_barrier(bar); } STAMP((k) + 1); } while (0)
    bf16* RA = (bf16*)(p.ws + WS_RA);
    STAMP(0);
    if (IN(0)) phase0(p, lds, tid, lane, wave);
#if defined(REP0)
    __syncthreads(); if (IN(0)) phase0(p, lds, tid, lane, wave);
#endif
    SEAM(0);
    if (IN(1)) phase1(p, lane, wave);
#if defined(REP1)
    if (IN(1)) phase1(p, lane, wave);
#endif
    SEAM(1);
    if (IN(2)) {
        pg8::Gemm g{RA, RA, RA_ROWS, RA_ROWS, 1024, 1024}; G1Order S{(int)gridDim.x, (int)blockIdx.x};
        EpiG1 E{(bf16*)(p.ws + WS_PROJ), (bf16*)(p.ws + WS_ZT), (bf16*)(p.ws + WS_KVC), (const float*)(p.ws + WS_ROPE)};
        pg8::gemm_phase<EpiG1, G1Order, true, true>(lds, g, S, E);
        if (blockIdx.x < 256) {
            const int v = blockIdx.x, tile = v >> 2, kq = v & 3;
            pg8::Gemm gc{RA + kq * 256, RA + kq * 256, RA_ROWS, RA_ROWS, 256, 1024}; OneUnit Sc{RT_CTX + (tile >> 2), RT_W + 4 + (tile & 3)};
            EpiCtx Ec{(bf16*)(p.ws + WS_KVCP) + (size_t)kq * MCTX * 1024};
            pg8::gemm_phase<EpiCtx, OneUnit, true, true>(lds, gc, Sc, Ec);
        }
    }
#if REP2 == 2
    __syncthreads();
    if (IN(2)) {
        pg8::Gemm g{RA, RA, RA_ROWS, RA_ROWS, 1024, 1024}; G1Order S{(int)gridDim.x, (int)blockIdx.x};
        EpiG1 E{(bf16*)(p.ws + WS_PROJ), (bf16*)(p.ws + WS_ZT), (bf16*)(p.ws + WS_KVC), (const float*)(p.ws + WS_ROPE)};
        pg8::gemm_phase<EpiG1, G1Order, true, true>(lds, g, S, E);
        if (blockIdx.x < 256) {
            const int v = blockIdx.x, tile = v >> 2, kq = v & 3;
            pg8::Gemm gc{RA + kq * 256, RA + kq * 256, RA_ROWS, RA_ROWS, 256, 1024}; OneUnit Sc{RT_CTX + (tile >> 2), RT_W + 4 + (tile & 3)};
            EpiCtx Ec{(bf16*)(p.ws + WS_KVCP) + (size_t)kq * MCTX * 1024};
            pg8::gemm_phase<EpiCtx, OneUnit, true, true>(lds, gc, Sc, Ec);
        }
    }
#endif
    SEAM(2);
    if (IN(3)) {
        for (int u = blockIdx.x; u < 256; u += gridDim.x) { state_unit(p, lds, u, tid, lane, wave); __syncthreads(); }
#if defined(REP3S)
        for (int u = blockIdx.x; u < 256; u += gridDim.x) { state_unit(p, lds, u, tid, lane, wave); __syncthreads(); }
#endif
        STAMP(13);
        { bf16x8 m1[2][4]; fft_setup(lds, tid, lane, m1);
          fft_units(p, lds, tid, lane, wave, m1);
#if defined(REP3F)
          fft_units(p, lds, tid, lane, wave, m1);
#endif
        }
    }
#if REP3 == 2
    __syncthreads();
    if (IN(3)) {
        for (int u = blockIdx.x; u < 256; u += gridDim.x) { state_unit(p, lds, u, tid, lane, wave); __syncthreads(); }
#if defined(REP3S)
        for (int u = blockIdx.x; u < 256; u += gridDim.x) { state_unit(p, lds, u, tid, lane, wave); __syncthreads(); }
#endif
        STAMP(13);
        { bf16x8 m1[2][4]; fft_setup(lds, tid, lane, m1);
          fft_units(p, lds, tid, lane, wave, m1);
#if defined(REP3F)
          fft_units(p, lds, tid, lane, wave, m1);
#endif
        }
    }
#endif
    SEAM(3);
    if (IN(4)) for (int rep = 0; rep < REP4; ++rep) { for (int u = blockIdx.x; u < 1024; u += gridDim.x) ret_unit(p, lds, u, tid, lane, wave); }
    SEAM(4);
#if defined(REPS)
    xcd_barrier(bar); xcd_barrier(bar); xcd_barrier(bar); xcd_barrier(bar);
#endif
    if (IN(5)) {
        __syncthreads();
        pg8::Gemm g{(const bf16*)(p.ws + WS_MIX), (const bf16*)(p.ws + WS_WOT), MTOK, 1024, 1024, 1024}; pg8::StaticOrder S; S.init(MTOK, 1024, (int)gridDim.x, (int)blockIdx.x);
        EpiOut E{(bf16*)(p.ws + WS_Y), (float*)(p.ws + WS_ROWSS)};
        pg8::gemm_phase<EpiOut, pg8::StaticOrder, true, true>(lds, g, S, E);
    }
#if defined(REP5)
    __syncthreads();
    if (IN(5)) {
        __syncthreads();
        pg8::Gemm g{(const bf16*)(p.ws + WS_MIX), (const bf16*)(p.ws + WS_WOT), MTOK, 1024, 1024, 1024}; pg8::StaticOrder S; S.init(MTOK, 1024, (int)gridDim.x, (int)blockIdx.x);
        EpiOut E{(bf16*)(p.ws + WS_Y), (float*)(p.ws + WS_ROWSS)};
        pg8::gemm_phase<EpiOut, pg8::StaticOrder, true, true>(lds, g, S, E);
    }
#endif
    SEAM(5);
    if (IN(6)) phase6<0>(p, lane, wave);
#if defined(TPROBE)
    xcd_barrier(bar); STAMP(7);
    phase6<1>(p, lane, wave);
#endif
#undef IN
#undef SEAM
}

#ifndef N_LAUNCHES
#define N_LAUNCHES 1
#endif
extern "C" void kernel_launch(void* const* d_in, const int* in_sizes, int n_in, void* d_out, int out_size, void* d_ws, size_t ws_size, hipStream_t stream) {
    static int grid = 0;
    if (grid == 0) {
        if (n_in != 13 || out_size != MTOK * DM || ws_size < WS_END) { fprintf(stderr, "kernel_launch: unexpected shapes (n_in %d out %d ws %zu)\n", n_in, out_size, ws_size); grid = -1; return; }
        int dev = 0, cus = 0, per_cu = 0;
        hipGetDevice(&dev); hipDeviceGetAttribute(&cus, hipDeviceAttributeMultiprocessorCount, dev);
        if (hipFuncSetAttribute((const void*)hymba_fwd, hipFuncAttributeMaxDynamicSharedMemorySize, LDS_BYTES) != hipSuccess) { fprintf(stderr, "kernel_launch: hipFuncSetAttribute failed\n"); grid = -1; return; }
        if (hipOccupancyMaxActiveBlocksPerMultiprocessor(&per_cu, (const void*)hymba_fwd, 512, LDS_BYTES) != hipSuccess || per_cu < 1) { fprintf(stderr, "kernel_launch: occupancy query says %d\n", per_cu); per_cu = 1; }
        (void)hipGetLastError();
        grid = 256;
        if (cus < 256) { fprintf(stderr, "kernel_launch: needs 256 CUs, device has %d\n", cus); grid = -1; return; }
    }
    if (grid < 0) return;
    Params p{};
    p.x = (const float*)d_in[0]; p.c = (const float*)d_in[1]; p.ctx = (const float*)d_in[2]; p.c_ctx = (const float*)d_in[3];
    p.w_ada = (const float*)d_in[4]; p.b_ada = (const float*)d_in[5]; p.g_pre = (const float*)d_in[6]; p.g_post = (const float*)d_in[7];
    p.w_in = (const float*)d_in[8]; p.w_fourier = (const float*)d_in[9]; p.decay_logit = (const float*)d_in[10]; p.gn_gain = (const float*)d_in[11]; p.w_out = (const float*)d_in[12];
    p.out = (float*)d_out; p.ws = (unsigned char*)d_ws;
    if (hipMemsetAsync(d_ws, 0, 16384, stream) != hipSuccess) { fprintf(stderr, "kernel_launch: memset failed\n"); return; }
    if (N_LAUNCHES == 1) {
        p.ph_lo = 0; p.ph_hi = 7; p.use_cg = 0;
        void* args[] = {&p};
        hipError_t e = hipLaunchCooperativeKernel((const void*)hymba_fwd, dim3(grid), dim3(512), args, LDS_BYTES, stream);
        if (e != hipSuccess) fprintf(stderr, "cooperative launch failed: %s (grid %d)\n", hipGetErrorString(e), grid);
    } else {
        for (int ph = 0; ph < 7; ++ph) { p.ph_lo = ph; p.ph_hi = ph + 1; hipLaunchKernelGGL(hymba_fwd, dim3(grid), dim3(512), LDS_BYTES, stream, p); }
    }
}
```
